# Optimizing an MI355X kernel written in HIP

```python
import jax, jax.numpy as jnp
from jax import lax
import numpy as np

D_MODEL = 4096
BATCH = 4
SEQ = 2048
DEPTH = 1
DEC_BATCH = 32
DEC_SEQ = 64
PAST_LEN = 1024

CHUNK = 64
N_HEADS = 16
HEAD_DIM = 128
W_ATT = N_HEADS * HEAD_DIM
W_CONV = D_MODEL // 2
CONV_WIDTH = 3
Q_BLOCK = 128
DN_ALPHA = (2.0 * DEPTH) ** 0.25
DN_BETA = (8.0 * DEPTH) ** -0.25
LN_EPS = 1e-5

kernel_name = 'stickbreak_shortconv_gated_hybrid_step'


def _split_sizes():
    sizes = [W_ATT] * 4 + [W_CONV] * 4 + [D_MODEL] * 2
    return [int(o) for o in np.cumsum(sizes)[:-1]]


def _layer_norm(x, g, b):
    xf = x.astype(jnp.float32)
    mu = jnp.mean(xf, axis=-1, keepdims=True)
    var = jnp.mean(jnp.square(xf - mu), axis=-1, keepdims=True)
    y = (xf - mu) * lax.rsqrt(var + LN_EPS) * g.astype(jnp.float32) + b.astype(jnp.float32)
    return y.astype(x.dtype)


def _stick_breaking(q, k, v, q_pos, k_pos):
    z = jnp.einsum('bqhd,bkhd->bhqk', q.astype(jnp.float32), k.astype(jnp.float32)) * (HEAD_DIM ** -0.5)
    causal = k_pos[None, :] < q_pos[:, None]
    log_keep = jnp.where(causal, jax.nn.log_sigmoid(-z), 0.0)
    after = lax.cumsum(log_keep, axis=3, reverse=True) - log_keep
    w = jnp.where(causal, jnp.exp(jax.nn.log_sigmoid(z) + after), 0.0)
    o = jnp.einsum('bhqk,bkhd->bqhd', w, v.astype(jnp.float32))
    return o.astype(v.dtype)


def _layer(x, past_k, past_v, past_conv, w_in, b_in, conv_w, conv_b, w_a, w_b, w_o, ln_g, ln_b):
    bsz, t_len, _ = x.shape
    proj = jnp.einsum('bsd,de->bse', x, w_in) + b_in
    q, k, v, z_a, b_g, c_g, h, z_b, g_a, g_b = jnp.split(proj, _split_sizes(), axis=-1)
    q = q.reshape(bsz, t_len, N_HEADS, HEAD_DIM)
    k = k.reshape(bsz, t_len, N_HEADS, HEAD_DIM)
    v = v.reshape(bsz, t_len, N_HEADS, HEAD_DIM)

    if past_k is None:
        blocks = []
        for i in range(t_len // Q_BLOCK):
            t0, t1 = i * Q_BLOCK, (i + 1) * Q_BLOCK
            blocks.append(_stick_breaking(q[:, t0:t1], k[:, :t1], v[:, :t1],
                                          jnp.arange(t0, t1), jnp.arange(t1)))
        o = jnp.concatenate(blocks, axis=1)
    else:
        p_len = past_k.shape[1]
        k_all = jnp.concatenate([past_k, k], axis=1)
        v_all = jnp.concatenate([past_v, v], axis=1)
        o = _stick_breaking(q, k_all, v_all, p_len + jnp.arange(t_len), jnp.arange(p_len + t_len))
    y_a = o.reshape(bsz, t_len, W_ATT) * jax.nn.silu(z_a)
    p_a = jnp.einsum('bsc,cd->bsd', y_a, w_a)

    u = c_g * h
    if past_conv is None:
        past_conv = jnp.zeros((bsz, CONV_WIDTH - 1, W_CONV), u.dtype)
    full = jnp.concatenate([past_conv, u], axis=1)
    conv = conv_b + sum(full[:, i:i + t_len] * conv_w[i] for i in range(CONV_WIDTH))
    new_conv = full[:, -(CONV_WIDTH - 1):]
    y_b = jax.nn.silu(z_b) * b_g * conv
    p_b = jnp.einsum('bsc,cd->bsd', y_b, w_b)

    merged = jax.nn.sigmoid(g_a) * p_a + jax.nn.sigmoid(g_b) * p_b
    sub = jnp.einsum('bsd,de->bse', merged, w_o)
    y = _layer_norm(DN_ALPHA * x + sub, ln_g, ln_b)
    return y, k, v, new_conv


def setup_inputs(seed: int = 0) -> dict:
    key = jax.random.key(seed)
    ks = jax.random.split(key, 14)
    n_in = 4 * W_ATT + 4 * W_CONV + 2 * D_MODEL
    f32 = jnp.float32
    return {
        'x_prompt': jax.random.normal(ks[0], (BATCH, SEQ, D_MODEL), f32),
        'x_sample': jax.random.normal(ks[1], (DEC_BATCH, DEC_SEQ, D_MODEL), f32),
        'cache_k': jax.random.normal(ks[2], (DEPTH, DEC_BATCH, PAST_LEN, N_HEADS, HEAD_DIM), f32),
        'cache_v': jax.random.normal(ks[3], (DEPTH, DEC_BATCH, PAST_LEN, N_HEADS, HEAD_DIM), f32),
        'state_conv': jax.random.normal(ks[4], (DEPTH, DEC_BATCH, CONV_WIDTH - 1, W_CONV), f32),
        'w_in': jax.random.normal(ks[5], (DEPTH, D_MODEL, n_in), f32) * D_MODEL ** -0.5,
        'b_in': jax.random.normal(ks[6], (DEPTH, n_in), f32) * 0.02,
        'conv_w': jax.random.normal(ks[7], (DEPTH, CONV_WIDTH, W_CONV), f32) * CONV_WIDTH ** -0.5,
        'conv_b': jax.random.normal(ks[8], (DEPTH, W_CONV), f32) * 0.02,
        'w_a': jax.random.normal(ks[9], (DEPTH, W_ATT, D_MODEL), f32) * (W_ATT ** -0.5 * DN_BETA),
        'w_b': jax.random.normal(ks[10], (DEPTH, W_CONV, D_MODEL), f32) * (W_CONV ** -0.5 * DN_BETA),
        'w_o': jax.random.normal(ks[11], (DEPTH, D_MODEL, D_MODEL), f32) * (D_MODEL ** -0.5 * DN_BETA),
        'ln_g': 1.0 + 0.02 * jax.random.normal(ks[12], (DEPTH, D_MODEL), f32),
        'ln_b': 0.02 * jax.random.normal(ks[13], (DEPTH, D_MODEL), f32),
    }


def reference(x_prompt, x_sample, cache_k, cache_v, state_conv, w_in, b_in, conv_w, conv_b,
              w_a, w_b, w_o, ln_g, ln_b):
    xp, xs = x_prompt, x_sample
    kp, vp, cp, kn, vn, cn = [], [], [], [], [], []
    for l in range(DEPTH):
        wts = (w_in[l], b_in[l], conv_w[l], conv_b[l], w_a[l], w_b[l], w_o[l], ln_g[l], ln_b[l])
        xp, k1, v1, c1 = _layer(xp, None, None, None, *wts)
        xs, k2, v2, c2 = _layer(xs, cache_k[l], cache_v[l], state_conv[l], *wts)
        kp.append(k1); vp.append(v1); cp.append(c1)
        kn.append(k2); vn.append(v2); cn.append(c2)
    return (xp, xs, jnp.stack(kp), jnp.stack(vp), jnp.stack(cp), jnp.stack(kn), jnp.stack(vn), jnp.stack(cn))
```

```cpp
#include <hip/hip_runtime.h>
#include <cstdio>
#include <cstdint>

#ifndef MK_N_LAUNCHES
#define MK_N_LAUNCHES 1
#endif
#ifndef SB_PRUNE
#define SB_PRUNE 1
#endif

namespace pg8 {
#define PG8_LAS __attribute__((address_space(3)))
typedef unsigned short bf16_t;
typedef short bf16x8 __attribute__((ext_vector_type(8)));
typedef float f32x4 __attribute__((ext_vector_type(4)));
typedef unsigned u32x4 __attribute__((ext_vector_type(4)));
constexpr int BM = 256, BK = 64, HALF = 128, HTB = HALF * BK * 2  , STAGE_BYTES = 8 * HTB, NXCD = 8, WGM = 8;

__host__ __device__ __forceinline__ int lds_byte(int r, int c) { const int st = (r >> 4) * 2 + (c >> 5), rr = r & 15, cc = c & 31, ob = rr * 64 + cc * 2; return st * 1024 + (ob ^ (((ob >> 9) & 1) << 5)); }
__host__ __device__ __forceinline__ void stage_rc(int b, int& R, int& C) { const int st = b / 1024, sb = b % 1024, swz = sb ^ (((sb >> 9) & 1) << 5); R = (st >> 1) * 16 + swz / 64; C = (st & 1) * 32 + (swz % 64) / 2; }
__host__ __device__ __forceinline__ int perm32(int rho) { const int n = rho >> 4, i = rho & 15; return 8 * (i >> 2) + 4 * n + (i & 3); }

struct Unit { int pm, pn, z; };

struct Sched {
    int nM, nN, nwg, G, c, zmode, pm0;
    int il;
    int rm, rho, xq;
    int nextra;
    int tail_c0;
    unsigned A0, A1, B0, B1, tstep;
    __device__ void init(int nM_, int nN_, int G_, int c_, int zmode_, int pm0_, size_t a0, size_t a1, size_t b0, size_t b1, int LDb) {
        nM = nM_; nN = nN_; nwg = nM * nN; G = G_; c = c_; zmode = zmode_; pm0 = pm0_; nextra = 0; tail_c0 = -1; rm = 0; rho = 0; xq = 0; il = 0; A0 = (unsigned)a0; A1 = (unsigned)a1; B0 = (unsigned)b0; B1 = (unsigned)b1; tstep = (unsigned)(BM * LDb); }
    __device__ bool next(int i, Unit& u) const {
        int ii = i, z = 0;
        if (zmode == 1) { ii = i >> 1; z = i & 1; }
        if (rm) {
            int p;
            if (rm == 1) { if (ii < 2) p = 32 * ii + rho; else if (ii == 2 && rho < 16) p = 64 + rho; else return false; }
            else if (rho >= 16) { if (ii > 2) return false; p = rho - 16 + 16 * ii; } else { if (ii > 1) return false; p = 48 + rho + 16 * ii; }
            return rm_at(p, u, z);
        }
        long L = (long)ii * G + c;
        if (tail_c0 >= 0) { const int full = nwg / G; if (ii >= full) { if (c < tail_c0) return false; const long idx = (long)(ii - full) * (G - tail_c0) + (c - tail_c0); if (idx >= nwg - (long)full * G) return false; L = (long)full * G + idx; } }
        return at(L, u, z);
    }
    __device__ bool rm_at(int p, Unit& u, int z) const {
        if (p < 64) { const int r = p >> 5, q = p & 31; u.pm = pm0 + 8 * (2 * r + (xq >> 2)) + (q & 7); u.pn = 4 * (xq & 3) + (q >> 3); }
        else { const int q = p - 64; u.pm = pm0 + 32 + (q & 7); u.pn = 2 * xq + (q >> 3); }
        u.z = z; return true;
    }
    __device__ bool at(long L, Unit& u, int z = 0) const {
        if (il) {
            const int k = (int)(L / NXCD), x = (int)(L % NXCD);
            if (k >= 400) return false;
            if (k < 384) { const int blk = 8 * (k >> 5) + x, q = k & 31, g = blk / 20, j = blk % 20; u.pm = pm0 + 8 * g + (q & 7); u.pn = 4 * j + (q >> 3); }
            else { const int q = k - 384; u.pm = pm0 + 32 + (q & 7); u.pn = 64 + 2 * x + (q >> 3); }
            u.z = z; return true;
        }
        if (L >= nwg) { if (L >= nwg + nextra) return false; u.pm = 0; u.pn = (int)(L - nwg); u.z = 1; return true; }
        int wgid = (int)L; { const int q = nwg / NXCD, r = nwg % NXCD, xcd = wgid % NXCD, off = wgid / NXCD; wgid = (xcd < r ? xcd * (q + 1) : r * (q + 1) + (xcd - r) * q) + off; }
        const int nig = WGM * nN, gid = wgid / nig, fm = gid * WGM, gsz = (nM - fm) < WGM ? (nM - fm) : WGM;
        u.pm = pm0 + fm + ((wgid % nig) % gsz); u.pn = (wgid % nig) / gsz; u.z = z; return true;
    }
    __device__ __forceinline__ unsigned ptrA(const Unit& u) const { return (u.z ? A1 : A0) + (unsigned)u.pm * tstep; }
    __device__ __forceinline__ unsigned ptrB(const Unit& u) const { return (u.z ? B1 : B0) + (unsigned)u.pn * tstep; }
};

typedef __bf16 bf16v2_t __attribute__((ext_vector_type(2)));
typedef float f32v2_t __attribute__((ext_vector_type(2)));
__device__ __forceinline__ unsigned cvt_pk_bf16(float lo, float hi) { const bf16v2_t r = __builtin_convertvector((f32v2_t){lo, hi}, bf16v2_t); return __builtin_bit_cast(unsigned, r); }
__device__ __forceinline__ u32x4 pack8(const f32x4 a, const f32x4 b) { u32x4 w; w.x = cvt_pk_bf16(a[0], a[1]); w.y = cvt_pk_bf16(a[2], a[3]); w.z = cvt_pk_bf16(b[0], b[1]); w.w = cvt_pk_bf16(b[2], b[3]); return w; }
__device__ __forceinline__ float bf_lo(unsigned w) { return __uint_as_float(w << 16); }
__device__ __forceinline__ float bf_hi(unsigned w) { return __uint_as_float(w & 0xffff0000u); }
__device__ __forceinline__ float sigmoid_f(float v) { return __builtin_amdgcn_rcpf(1.0f + __builtin_amdgcn_exp2f(-1.4426950408889634f * v)); }
__device__ __forceinline__ f32x4 sigmoid4(f32x4 v) { return (f32x4){sigmoid_f(v[0]), sigmoid_f(v[1]), sigmoid_f(v[2]), sigmoid_f(v[3])}; }
__device__ __forceinline__ f32x4 silu4(f32x4 v) { return v * sigmoid4(v); }


constexpr size_t OUT_Y = 0, OUT_KP = 41943040, OUT_VP = 58720256, OUT_CP = 75497472, OUT_KS = 75513856, OUT_VS = 79708160, OUT_CS = 83902464, OUT_TOTAL = 84033536;
constexpr float QSCALE = 0.08838834764831845f * 1.4426950408889634f;

typedef unsigned u32x2 __attribute__((ext_vector_type(2)));
__device__ __forceinline__ float clamp8(float v) { return __builtin_amdgcn_fmed3f(v, -448.0f, 448.0f); }
__device__ __forceinline__ unsigned cvt4_fp8(const f32x4 a) { unsigned w = __builtin_amdgcn_cvt_pk_fp8_f32(clamp8(a[0]), clamp8(a[1]), 0, false); return __builtin_amdgcn_cvt_pk_fp8_f32(clamp8(a[2]), clamp8(a[3]), w, true); }
__device__ __forceinline__ u32x2 pack8_fp8(const f32x4 a, const f32x4 b) { u32x2 w; w.x = cvt4_fp8(a); w.y = cvt4_fp8(b); return w; }
constexpr float SC_WIN = 64.f, SC_WAB = 64.f, SC_WO = 128.f, SC_Y = 4.f, SC_MG = 8.f;

struct EpiProjB {
    static constexpr bool PERM = true, AFTER_DRAIN = false;
    const float* bias;
    bf16_t *K, *V;
    float* out;
    unsigned* sig;
    __device__ __forceinline__ unsigned* sig_ptr(const Unit& u) const { return (sig != nullptr && u.z == 0 && u.pm < 32) ? sig + 16 * (u.pm >> 3) : nullptr; }
    __device__ __forceinline__ void operator()(const f32x4 (&acc)[2][2][4][2], const Unit& u, int wr, int wc, int fr, int fq) const {
        const int pn = u.pn, cl = wc * 32 + 8 * fq;
        if (u.z == 0) {
            const int row0 = u.pm * BM + wr * 64 + fr;
            const bool isv = pn >= 8; const int c0 = (pn & 7) * BM + cl;
            const float* bp = bias + (isv ? 4096 : 2048) + c0;
            f32x4 bv[2][2];
#pragma unroll
            for (int bj = 0; bj < 2; ++bj)
#pragma unroll
                for (int n = 0; n < 2; ++n) bv[bj][n] = *(const f32x4*)(bp + bj * HALF + 4 * n);
            bf16_t* B = isv ? V : K;
            float* O = (u.pm < 32) ? out + (isv ? OUT_VP : OUT_KP) : out + (isv ? OUT_VS : OUT_KS) - (size_t)8192 * 2048;
#pragma unroll
            for (int ai = 0; ai < 2; ++ai)
#pragma unroll
                for (int m = 0; m < 4; ++m) { const size_t ro = (size_t)(row0 + ai * HALF + m * 16) * 2048 + c0;
#pragma unroll
                    for (int bj = 0; bj < 2; ++bj) { const f32x4 v0 = acc[ai][bj][m][0] + bv[bj][0], v1 = acc[ai][bj][m][1] + bv[bj][1];
                        *(u32x4*)(B + ro + bj * HALF) = pack8(v0, v1); *(f32x4*)(O + ro + bj * HALF) = v0; *(f32x4*)(O + ro + bj * HALF + 4) = v1; } }
        } else {
            const int ch = pn * HALF + cl;
            f32x4 bc[2], bh[2];
#pragma unroll
            for (int n = 0; n < 2; ++n) { bc[n] = *(const f32x4*)(bias + 10240 + ch + 4 * n); bh[n] = *(const f32x4*)(bias + 12288 + ch + 4 * n); }
#pragma unroll
            for (int ai = 0; ai < 1; ++ai)
#pragma unroll
                for (int m = 0; m < 4; ++m) { const int row = wr * 64 + m * 16 + fr;
                    if (row < 72) { float* cp = (row < 8) ? out + OUT_CP + (size_t)row * 2048 + ch : out + OUT_CS + (size_t)(row - 8) * 2048 + ch;
                        *(f32x4*)cp = (acc[0][0][m][0] + bc[0]) * (acc[0][1][m][0] + bh[0]); *(f32x4*)(cp + 4) = (acc[0][0][m][1] + bc[1]) * (acc[0][1][m][1] + bh[1]); } }
        }
    }
};

struct EpiProj8 {
    static constexpr bool PERM = true, AFTER_DRAIN = false;
    const float* bias;
    bf16_t *Q, *SZA, *U, *GT, *SGA, *SGB;
    unsigned* sig;
    __device__ __forceinline__ unsigned* sig_ptr(const Unit& u) const { return (sig != nullptr && u.pn < 16 && u.pm < 32) ? sig + 16 * (u.pm >> 3) : nullptr; }
    __device__ __forceinline__ void operator()(const f32x4 (&acc)[2][2][4][2], const Unit& u, int wr, int wc, int fr, int fq) const {
        const int pn = u.pn, row0 = u.pm * BM + wr * 64 + fr, cl = wc * 32 + 8 * fq;
        constexpr float DS = 1.0f / SC_WIN;
        if (pn >= 16 && pn < 32) {
            const int ch = (pn - 16) * HALF + cl;
            f32x4 bc[2], bh[2];
#pragma unroll
            for (int n = 0; n < 2; ++n) { bc[n] = *(const f32x4*)(bias + 10240 + ch + 4 * n); bh[n] = *(const f32x4*)(bias + 12288 + ch + 4 * n); }
#pragma unroll
            for (int ai = 0; ai < 2; ++ai)
#pragma unroll
                for (int m = 0; m < 4; ++m) { const int row = row0 + ai * HALF + m * 16;
                    *(u32x4*)(U + (size_t)row * 2048 + ch) = pack8((acc[ai][0][m][0] * DS + bc[0]) * (acc[ai][1][m][0] * DS + bh[0]), (acc[ai][0][m][1] * DS + bc[1]) * (acc[ai][1][m][1] * DS + bh[1])); }
        } else if (pn >= 32 && pn < 48) {
            const int ch = (pn - 32) * HALF + cl;
            f32x4 bb[2], bz[2];
#pragma unroll
            for (int n = 0; n < 2; ++n) { bb[n] = *(const f32x4*)(bias + 8192 + ch + 4 * n); bz[n] = *(const f32x4*)(bias + 14336 + ch + 4 * n); }
#pragma unroll
            for (int ai = 0; ai < 2; ++ai)
#pragma unroll
                for (int m = 0; m < 4; ++m) { const int row = row0 + ai * HALF + m * 16;
                    const f32x4 g0 = (acc[ai][0][m][0] * DS + bb[0]) * silu4(acc[ai][1][m][0] * DS + bz[0]), g1 = (acc[ai][0][m][1] * DS + bb[1]) * silu4(acc[ai][1][m][1] * DS + bz[1]);
                    *(u32x4*)(GT + (size_t)row * 2048 + ch) = pack8(g0, g1); }
        } else {
            int kind, c0, ld, sb; bf16_t* B;
            if (pn < 8) { kind = 0; c0 = pn * BM + cl; sb = c0; ld = 2048; B = Q; }
            else if (pn < 16) { kind = 1; c0 = (pn - 8) * BM + cl; sb = 6144 + c0; ld = 2048; B = SZA; }
            else if (pn < 64) { kind = 2; c0 = (pn - 48) * BM + cl; sb = 16384 + c0; ld = 4096; B = SGA; }
            else { kind = 2; c0 = (pn - 64) * BM + cl; sb = 20480 + c0; ld = 4096; B = SGB; }
            f32x4 bv[2][2];
#pragma unroll
            for (int bj = 0; bj < 2; ++bj)
#pragma unroll
                for (int n = 0; n < 2; ++n) bv[bj][n] = *(const f32x4*)(bias + sb + bj * HALF + 4 * n);
#pragma unroll
            for (int ai = 0; ai < 2; ++ai)
#pragma unroll
                for (int m = 0; m < 4; ++m) { bf16_t* rowp = B + (size_t)(row0 + ai * HALF + m * 16) * ld + c0;
#pragma unroll
                    for (int bj = 0; bj < 2; ++bj) { f32x4 v0 = acc[ai][bj][m][0] * DS + bv[bj][0], v1 = acc[ai][bj][m][1] * DS + bv[bj][1];
                        if (kind == 0) { v0 = v0 * QSCALE; v1 = v1 * QSCALE; } else if (kind == 1) { v0 = silu4(v0); v1 = silu4(v1); } else { v0 = sigmoid4(v0); v1 = sigmoid4(v1); }
                        *(u32x4*)(rowp + bj * HALF) = pack8(v0, v1); } }
        }
    }
};

__device__ __forceinline__ f32x4 bf4_lo(const u32x4 w) { return (f32x4){bf_lo(w.x), bf_hi(w.x), bf_lo(w.y), bf_hi(w.y)}; }
__device__ __forceinline__ f32x4 bf4_hi(const u32x4 w) { return (f32x4){bf_lo(w.z), bf_hi(w.z), bf_lo(w.w), bf_hi(w.w)}; }
struct EpiMerge {
    static constexpr bool PERM = true, AFTER_DRAIN = false;
    const bf16_t *SGA, *SGB; bf16_t* M1; unsigned char* MG8; __amdgpu_buffer_rsrc_t wsr; unsigned offMG8;
    unsigned* sig;
    __device__ __forceinline__ unsigned* sig_ptr(const Unit& u) const { return (sig != nullptr && u.z == 1) ? sig + 16 * u.pm : nullptr; }
    __device__ __forceinline__ void operator()(const f32x4 (&acc)[2][2][4][2], const Unit& u, int wr, int wc, int fr, int fq) const {
        const int row0 = u.pm * BM + wr * 64 + fr, col0 = u.pn * BM + wc * 32 + 8 * fq;
        const bf16_t* SG = u.z ? SGB : SGA;
        constexpr float DS = 1.0f / (SC_Y * SC_WAB);
#pragma unroll
        for (int ai = 0; ai < 2; ++ai) {
            u32x4 g[4][2], mv[4][2];
#pragma unroll
            for (int m = 0; m < 4; ++m)
#pragma unroll
                for (int bj = 0; bj < 2; ++bj) { const size_t ro = (size_t)(row0 + ai * HALF + m * 16) * 4096 + col0 + bj * HALF;
                    g[m][bj] = *(const u32x4*)(SG + ro); if (u.z) mv[m][bj] = *(const u32x4*)(M1 + ro); }
#pragma unroll
            for (int m = 0; m < 4; ++m)
#pragma unroll
                for (int bj = 0; bj < 2; ++bj) { const size_t ro = (size_t)(row0 + ai * HALF + m * 16) * 4096 + col0 + bj * HALF;
                    f32x4 v0 = acc[ai][bj][m][0] * DS * bf4_lo(g[m][bj]), v1 = acc[ai][bj][m][1] * DS * bf4_hi(g[m][bj]);
                    if (u.z == 0) *(u32x4*)(M1 + ro) = pack8(v0, v1);
                    else { v0 = v0 + bf4_lo(mv[m][bj]); v1 = v1 + bf4_hi(mv[m][bj]); __builtin_amdgcn_raw_buffer_store_b64(pack8_fp8(v0 * SC_MG, v1 * SC_MG), wsr, (int)(offMG8 + (unsigned)ro), 0, 16  ); } }
        }
    }
};

struct EpiOut {
    static constexpr bool PERM = true, AFTER_DRAIN = false;
    const bf16_t* XB; bf16_t* PRE; float alpha;
    __device__ __forceinline__ void operator()(const f32x4 (&acc)[2][2][4][2], const Unit& u, int wr, int wc, int fr, int fq) const {
        const int row0 = u.pm * BM + wr * 64 + fr, col0 = u.pn * BM + wc * 32 + 8 * fq;
        constexpr float DS = 1.0f / (SC_MG * SC_WO);
#pragma unroll
        for (int ai = 0; ai < 2; ++ai) {
            u32x4 xv[4][2];
#pragma unroll
            for (int m = 0; m < 4; ++m)
#pragma unroll
                for (int bj = 0; bj < 2; ++bj) xv[m][bj] = *(const u32x4*)(XB + (size_t)(row0 + ai * HALF + m * 16) * 4096 + col0 + bj * HALF);
#pragma unroll
            for (int m = 0; m < 4; ++m)
#pragma unroll
                for (int bj = 0; bj < 2; ++bj) { const size_t ro = (size_t)(row0 + ai * HALF + m * 16) * 4096 + col0 + bj * HALF;
                    *(u32x4*)(PRE + ro) = pack8(bf4_lo(xv[m][bj]) * alpha + acc[ai][bj][m][0] * DS, bf4_hi(xv[m][bj]) * alpha + acc[ai][bj][m][1] * DS); }
        }
    }
};

typedef int v8i_t __attribute__((ext_vector_type(8)));
struct Dyn { unsigned* ctr; int x, first, base; volatile PG8_LAS unsigned* slot; unsigned* once; int once_k; };
template <class T> struct has_sig { static constexpr bool v = false; };
template <> struct has_sig<EpiMerge> { static constexpr bool v = true; };

template <class Epi, bool ALIGN_EPI = false, bool SP2 = false, bool F8 = false, bool DYN = false>
__device__ __forceinline__ void gemm_phase(PG8_LAS unsigned char* lds, const int wave_sgpr, const __amdgpu_buffer_rsrc_t rsrc, const int LDb, const int Kb, const Sched& S, const Epi& E, const Dyn D = Dyn{nullptr, 0, 0, 0, nullptr, nullptr, 0}) {
    int lane_ = (int)__builtin_amdgcn_mbcnt_hi(~0u, __builtin_amdgcn_mbcnt_lo(~0u, 0u)); asm volatile("" : "+v"(lane_));
    const int wid = wave_sgpr, lane = lane_, tid = wid * 64 + lane, wr = wid >> 2, wc = wid & 3, fr = lane & 15, fq = lane >> 4;
    const int nt = Kb / 128;
    unsigned voffA[2], voffB[2];
#pragma unroll
    for (int i = 0; i < 2; ++i) { int R, C; stage_rc(tid * 16 + i * 8192, R, C); const int Rb = Epi::PERM ? ((R & ~31) + perm32(R & 31)) : R;
        voffA[i] = (unsigned)(R * LDb + C * 2); voffB[i] = (unsigned)(Rb * LDb + C * 2); }
    const unsigned kstep = 128u;
    const unsigned hstep = (unsigned)(HALF * LDb);
    const unsigned ldsw = (unsigned)wid * 1024u;
    constexpr int KOFF = 1024;
    const int aoff = lds_byte(wr * 64 + fr, fq * 8), boff = lds_byte(wc * 32 + fr, fq * 8);
#define PG8_SA(b, h) (((b) * 2 + (h)) * HTB)
#define PG8_SB(b, h) ((4 + (b) * 2 + (h)) * HTB)
#define PG8_STAGE(bufoff, gbase, voff) do { _Pragma("unroll") for (int _i = 0; _i < 2; ++_i) \
        __builtin_amdgcn_raw_ptr_buffer_load_lds(rsrc, (PG8_LAS void*)(lds + (bufoff) + ldsw + _i * 8192), 16, (int)(voff)[_i], (int)(gbase), 0, 0); } while (0)
#define PG8_LDA(dst, b, h) do { _Pragma("unroll") for (int m = 0; m < 4; ++m) _Pragma("unroll") for (int k = 0; k < 2; ++k) dst[m][k] = *(const PG8_LAS bf16x8*)(lds + PG8_SA(b, h) + aoff + m * 2048 + k * KOFF); } while (0)
#define PG8_LDB(dst, b, h) do { _Pragma("unroll") for (int n = 0; n < 2; ++n) _Pragma("unroll") for (int k = 0; k < 2; ++k) dst[n][k] = *(const PG8_LAS bf16x8*)(lds + PG8_SB(b, h) + boff + n * 2048 + k * KOFF); } while (0)
#define PG8_MMA(ai, bj, At, Bt) do { __builtin_amdgcn_s_setprio(1); _Pragma("unroll") for (int m = 0; m < 4; ++m) _Pragma("unroll") for (int n = 0; n < 2; ++n) { \
        if constexpr (F8) { typedef int v4i_t __attribute__((ext_vector_type(4))); \
            const v8i_t pa = __builtin_shufflevector(__builtin_bit_cast(v4i_t, At[m][0]), __builtin_bit_cast(v4i_t, At[m][1]), 0, 1, 2, 3, 4, 5, 6, 7); \
            const v8i_t pb = __builtin_shufflevector(__builtin_bit_cast(v4i_t, Bt[n][0]), __builtin_bit_cast(v4i_t, Bt[n][1]), 0, 1, 2, 3, 4, 5, 6, 7); \
            acc[ai][bj][m][n] = __builtin_amdgcn_mfma_scale_f32_16x16x128_f8f6f4(pb, pa, acc[ai][bj][m][n], 0, 0, 0, 0, 0, 0); } \
        else { _Pragma("unroll") for (int k = 0; k < 2; ++k) acc[ai][bj][m][n] = __builtin_amdgcn_mfma_f32_16x16x32_bf16(Bt[n][k], At[m][k], acc[ai][bj][m][n], 0, 0, 0); } } \
        __builtin_amdgcn_s_setprio(0); } while (0)
#define PG8_WAIT_V(n) asm volatile("s_waitcnt vmcnt(" #n ")" ::: "memory")
#define PG8_WAIT_L(n) asm volatile("s_waitcnt lgkmcnt(" #n ")" ::: "memory")
#define PG8_BAR __builtin_amdgcn_s_barrier()
#define PG8_SCHED __builtin_amdgcn_sched_barrier(0)
    Unit cur, nxt; int ui = 0; bool once_done = false;
    if constexpr (DYN) {
        if (!S.at((long)D.first * NXCD + D.x, cur)) return;
        if (wid == 0) { if (lane == 0) { const unsigned t = __hip_atomic_fetch_add(D.ctr, 1u, __ATOMIC_RELAXED, __HIP_MEMORY_SCOPE_AGENT) + (unsigned)D.base; *D.slot = t; } asm volatile("s_waitcnt lgkmcnt(0)" ::: "memory"); }
        __builtin_amdgcn_s_barrier();
    } else { if (!S.next(0, cur)) return; }
    f32x4 acc[2][2][4][2];
#pragma unroll
    for (int a = 0; a < 2; ++a)
#pragma unroll
        for (int b = 0; b < 2; ++b)
#pragma unroll
            for (int m = 0; m < 4; ++m)
#pragma unroll
                for (int n = 0; n < 2; ++n) acc[a][b][m][n] = (f32x4){0.f, 0.f, 0.f, 0.f};
    bf16x8 At[4][2], B0[2][2], B1[2][2];
    unsigned cA = S.ptrA(cur), cB = S.ptrB(cur);
    if constexpr (SP2) {
        PG8_STAGE(PG8_SB(0, 0), cB, voffB); PG8_STAGE(PG8_SB(0, 1), cB + hstep, voffB); PG8_STAGE(PG8_SA(0, 0), cA, voffA); PG8_STAGE(PG8_SA(0, 1), cA + hstep, voffA);
        if (wr == 1) PG8_BAR;
        PG8_WAIT_V(2); PG8_BAR;
        PG8_STAGE(PG8_SB(1, 0), cB + kstep, voffB); PG8_STAGE(PG8_SA(1, 0), cA + kstep, voffA); PG8_STAGE(PG8_SB(1, 1), cB + hstep + kstep, voffB);
        PG8_WAIT_V(6); PG8_BAR;
    } else {
        PG8_STAGE(PG8_SB(0, 0), cB, voffB); PG8_STAGE(PG8_SA(0, 0), cA, voffA); PG8_STAGE(PG8_SB(0, 1), cB + hstep, voffB); PG8_STAGE(PG8_SA(0, 1), cA + hstep, voffA);
        if (wr == 1) PG8_BAR;
        PG8_WAIT_V(4); PG8_BAR;
        PG8_STAGE(PG8_SB(1, 0), cB + kstep, voffB); PG8_STAGE(PG8_SA(1, 0), cA + kstep, voffA); PG8_STAGE(PG8_SB(1, 1), cB + hstep + kstep, voffB);
        PG8_WAIT_V(6); PG8_BAR;
    }
    for (;;) {
        bool has_next;
        unsigned tn = 0;
        if constexpr (DYN) { tn = (unsigned)__builtin_amdgcn_readfirstlane((int)*D.slot); has_next = S.at((long)tn * NXCD + D.x, nxt); }
        else has_next = S.next(ui + 1, nxt);
        const unsigned nA = has_next ? S.ptrA(nxt) : cA, nB = has_next ? S.ptrB(nxt) : cB;
        for (int t = 0; t < nt; t += 2) {
            const bool last = (t == nt - 2);
            const unsigned a1 = cA + (unsigned)(t + 1) * kstep;
            const unsigned a2 = last ? nA : cA + (unsigned)(t + 2) * kstep, b2 = last ? nB : cB + (unsigned)(t + 2) * kstep;
            const unsigned a3 = a2 + kstep, b3 = b2 + kstep;
            if constexpr (SP2) {
            PG8_LDB(B0, 0, 0); PG8_LDB(B1, 0, 1); PG8_SCHED; PG8_LDA(At, 0, 0); PG8_STAGE(PG8_SA(1, 1), a1 + hstep, voffA);
            PG8_WAIT_V(8); PG8_WAIT_L(0); PG8_BAR; PG8_MMA(0, 0, At, B0); PG8_MMA(0, 1, At, B1); PG8_BAR; PG8_SCHED;
            PG8_LDA(At, 0, 1); PG8_STAGE(PG8_SB(0, 0), b2, voffB); PG8_STAGE(PG8_SB(0, 1), b2 + hstep, voffB); PG8_STAGE(PG8_SA(0, 0), a2, voffA);
            PG8_WAIT_V(8); PG8_WAIT_L(0); PG8_BAR; PG8_MMA(1, 0, At, B0); PG8_MMA(1, 1, At, B1); PG8_BAR; PG8_SCHED;
            PG8_LDB(B0, 1, 0); PG8_LDB(B1, 1, 1); PG8_SCHED; PG8_LDA(At, 1, 0); PG8_STAGE(PG8_SA(0, 1), a2 + hstep, voffA);
            PG8_WAIT_V(8); PG8_WAIT_L(0); PG8_BAR; PG8_MMA(0, 0, At, B0); PG8_MMA(0, 1, At, B1); PG8_BAR; PG8_SCHED;
            PG8_LDA(At, 1, 1); PG8_STAGE(PG8_SB(1, 0), b3, voffB); PG8_STAGE(PG8_SB(1, 1), b3 + hstep, voffB); PG8_STAGE(PG8_SA(1, 0), a3, voffA);
            PG8_WAIT_V(8); PG8_WAIT_L(0); PG8_BAR; PG8_MMA(1, 0, At, B0); PG8_MMA(1, 1, At, B1); PG8_BAR; PG8_SCHED;
            } else {
            PG8_LDB(B0, 0, 0); PG8_SCHED; PG8_LDA(At, 0, 0); PG8_STAGE(PG8_SA(1, 1), a1 + hstep, voffA);
            PG8_WAIT_L(8); PG8_BAR; PG8_WAIT_L(0); PG8_MMA(0, 0, At, B0); PG8_BAR; PG8_SCHED;
            PG8_LDB(B1, 0, 1); PG8_STAGE(PG8_SB(0, 0), b2, voffB);
            PG8_BAR; PG8_WAIT_L(0); PG8_MMA(0, 1, At, B1); PG8_BAR;
            PG8_LDA(At, 0, 1); PG8_STAGE(PG8_SA(0, 0), a2, voffA);
            PG8_BAR; PG8_WAIT_L(0); PG8_MMA(1, 0, At, B0); PG8_BAR; PG8_SCHED;
            PG8_STAGE(PG8_SB(0, 1), b2 + hstep, voffB);
            PG8_WAIT_V(6); PG8_BAR; PG8_MMA(1, 1, At, B1); PG8_BAR;
            PG8_LDB(B0, 1, 0); PG8_SCHED; PG8_LDA(At, 1, 0); PG8_STAGE(PG8_SA(0, 1), a2 + hstep, voffA);
            PG8_WAIT_L(8); PG8_BAR; PG8_WAIT_L(0); PG8_MMA(0, 0, At, B0); PG8_BAR; PG8_SCHED;
            PG8_LDB(B1, 1, 1); PG8_STAGE(PG8_SB(1, 0), b3, voffB);
            PG8_BAR; PG8_WAIT_L(0); PG8_MMA(0, 1, At, B1); PG8_BAR;
            PG8_LDA(At, 1, 1); PG8_STAGE(PG8_SA(1, 0), a3, voffA);
            PG8_BAR; PG8_WAIT_L(0); PG8_MMA(1, 0, At, B0); PG8_BAR; PG8_SCHED;
            PG8_STAGE(PG8_SB(1, 1), b3 + hstep, voffB);
            PG8_WAIT_V(6); PG8_BAR; PG8_MMA(1, 1, At, B1); PG8_BAR;
            }
        }
        if constexpr (ALIGN_EPI) { if (wr == 0) PG8_BAR; }
        { int lz = (int)__builtin_amdgcn_mbcnt_hi(~0u, __builtin_amdgcn_mbcnt_lo(~0u, 0u)); asm volatile("" : "+v"(lz));
          unsigned tk2 = 0x7fffffffu;
          if constexpr (DYN) { if (has_next && wid == 0 && lz == 0) tk2 = __hip_atomic_fetch_add(D.ctr, 1u, __ATOMIC_RELAXED, __HIP_MEMORY_SCOPE_AGENT) + (unsigned)D.base; }
          E(acc, cur, wr, wc, lz & 15, lz >> 4);
          __builtin_amdgcn_s_waitcnt(0x0F70);
          if constexpr (DYN) { if (wid == 0) { int l2 = (int)__builtin_amdgcn_mbcnt_hi(~0u, __builtin_amdgcn_mbcnt_lo(~0u, 0u)); asm volatile("" : "+v"(l2)); if (l2 == 0) *D.slot = tk2; asm volatile("s_waitcnt lgkmcnt(0)" ::: "memory"); } } }
        if constexpr (DYN) {
            if (D.once != nullptr && !once_done && (!has_next || tn >= (unsigned)D.once_k)) {
                once_done = true;
                PG8_BAR;
                if (wid == 0) { int l4 = (int)__builtin_amdgcn_mbcnt_hi(~0u, __builtin_amdgcn_mbcnt_lo(~0u, 0u)); asm volatile("" : "+v"(l4));
                    if (l4 == 0) { __builtin_amdgcn_fence(__ATOMIC_RELEASE, "agent"); (void)__hip_atomic_fetch_add(D.once, 1u, __ATOMIC_RELAXED, __HIP_MEMORY_SCOPE_AGENT); } }
            }
        }
        if constexpr (has_sig<Epi>::v) {
            unsigned* const sp = E.sig_ptr(cur);
            if (sp != nullptr) {
                PG8_BAR;
                if (wid == 0) { int l3 = (int)__builtin_amdgcn_mbcnt_hi(~0u, __builtin_amdgcn_mbcnt_lo(~0u, 0u)); asm volatile("" : "+v"(l3));
                    if (l3 == 0) (void)__hip_atomic_fetch_add(sp, 1u, __ATOMIC_RELAXED, __HIP_MEMORY_SCOPE_AGENT); }
            }
        }
        if (!has_next) break;
#pragma unroll
        for (int a = 0; a < 2; ++a)
#pragma unroll
            for (int b = 0; b < 2; ++b)
#pragma unroll
                for (int m = 0; m < 4; ++m)
#pragma unroll
                    for (int n = 0; n < 2; ++n) acc[a][b][m][n] = (f32x4){0.f, 0.f, 0.f, 0.f};
        cur = nxt; cA = nA; cB = nB; ++ui;
        if constexpr (DYN) PG8_BAR;
        if constexpr (ALIGN_EPI) { if (wr == 1) PG8_BAR; }
    }
    PG8_WAIT_V(0);
    if constexpr (!ALIGN_EPI) { if (wr == 0) PG8_BAR; }
    PG8_BAR;
#undef PG8_SA
#undef PG8_SB
#undef PG8_STAGE
#undef PG8_LDA
#undef PG8_LDB
#undef PG8_MMA
#undef PG8_WAIT_V
#undef PG8_WAIT_L
#undef PG8_BAR
#undef PG8_SCHED
}
}

#ifndef PG8_SP2
#define PG8_SP2 true
#endif
#ifndef PG8_ALIGN
#define PG8_ALIGN true
#endif

namespace sbk {
#define SB_LAS __attribute__((address_space(3)))
typedef unsigned short bf16;
typedef short bf16x8 __attribute__((ext_vector_type(8)));
typedef short s16x4 __attribute__((ext_vector_type(4)));
typedef float f32x16 __attribute__((ext_vector_type(16)));
typedef float f32x4 __attribute__((ext_vector_type(4)));
typedef unsigned u32x4 __attribute__((ext_vector_type(4)));
constexpr int WAVE_LDS = 16384;
#define SB_KSWZ(row, colB) ((row) * 256 + ((colB) ^ (((row) & 7) << 4)))
__device__ __forceinline__ int v_st(int k, int c) { const int kk = (k & ~0xC) | ((k & 4) << 1) | ((k & 8) >> 1); return ((kk >> 3) * 4 + (c >> 5)) * 512 + ((kk & 7) * 32 + (c & 31)) * 2; }
__device__ __forceinline__ int v_rd_base(int lane) { return ((lane & 3) << 3) | (((lane >> 2) & 3) << 6) | (((lane >> 4) & 1) << 5) | (((lane >> 5) & 1) << 8); }
__device__ __forceinline__ int crow(int r, int hi) { return (r & 3) + 8 * (r >> 2) + 4 * hi; }
__device__ __forceinline__ unsigned cvtpk(float lo, float hi) { return pg8::cvt_pk_bf16(lo, hi); }
__device__ __forceinline__ bf16x8 pack8(f32x4 a, f32x4 b) { u32x4 w = {cvtpk(a[0], a[1]), cvtpk(a[2], a[3]), cvtpk(b[0], b[1]), cvtpk(b[2], b[3])}; return __builtin_bit_cast(bf16x8, w); }

struct Args { const bf16 *Q, *K, *V, *SZA; unsigned char* YA8; const float *ck, *cv; unsigned* queue; };

__device__ __forceinline__ void tile_compute(SB_LAS char* wl, const bf16x8 (&qr)[8], f32x16 (&o)[4], float& R, const bool diag, const int r32, const int hi, const unsigned vb0) {
    f32x16 p = {};
    { const SB_LAS char* kb[4];
#pragma unroll
      for (int dd = 0; dd < 4; ++dd) kb[dd] = wl + SB_KSWZ(r32, (dd * 16 + hi * 8) * 2);
#pragma unroll
      for (int d0 = 0; d0 < 8; ++d0) { const bf16x8 kf = *(const SB_LAS bf16x8*)(kb[d0 & 3] + (d0 >> 2) * 128); p = __builtin_amdgcn_mfma_f32_32x32x16_bf16(kf, qr[d0], p, 0, 0, 0); } }
    if (diag) {
        const float NEG = -__builtin_inff();
#pragma unroll
        for (int r = 0; r < 16; ++r) if (crow(r, hi) >= r32) p[r] = NEG;
    }
    float s[16];
#pragma unroll
    for (int r = 0; r < 16; ++r) { const float z = p[r]; s[r] = fmaxf(z, 0.f) + __builtin_amdgcn_logf(1.0f + __builtin_amdgcn_exp2f(-__builtin_fabsf(z))); }
#pragma unroll
    for (int g = 0; g < 4; ++g) { s[4 * g + 2] += s[4 * g + 3]; s[4 * g + 1] += s[4 * g + 2]; s[4 * g] += s[4 * g + 1]; }
    float E[4], O[4];
#pragma unroll
    for (int g = 0; g < 4; ++g) { auto rr = __builtin_amdgcn_permlane32_swap(__float_as_uint(s[4 * g]), __float_as_uint(s[4 * g]), false, false); E[g] = __uint_as_float(rr[0]); O[g] = __uint_as_float(rr[1]); }
    float T[8]; T[7] = 0.f; T[6] = O[3]; T[5] = T[6] + E[3]; T[4] = T[5] + O[2]; T[3] = T[4] + E[2]; T[2] = T[3] + O[1]; T[1] = T[2] + E[1]; T[0] = T[1] + O[0];
    const float total = T[0] + E[0];
#pragma unroll
    for (int g = 0; g < 4; ++g) { const float base = R + (hi ? T[2 * g + 1] : T[2 * g]);
#pragma unroll
        for (int j = 0; j < 4; ++j) { const int r = 4 * g + j; p[r] = __builtin_amdgcn_exp2f(p[r] - (base + s[r])); } }
    R += total;
    bf16x8 pa0, pa1;
#define SB_PK4(P, B_, OUT) do { unsigned a0 = cvtpk(P[B_+0], P[B_+1]), a1 = cvtpk(P[B_+2], P[B_+3]); unsigned b0 = cvtpk(P[B_+4], P[B_+5]), b1 = cvtpk(P[B_+6], P[B_+7]); \
        auto r0 = __builtin_amdgcn_permlane32_swap(a0, b0, false, false); auto r1 = __builtin_amdgcn_permlane32_swap(a1, b1, false, false); \
        u32x4 w = {r0[0], r1[0], r0[1], r1[1]}; OUT = __builtin_bit_cast(bf16x8, w); } while (0)
    SB_PK4(p, 0, pa0); SB_PK4(p, 8, pa1);
#undef SB_PK4
#define SB_TRRD(dst, off) asm volatile("ds_read_b64_tr_b16 %0, %1 offset:%2" : "=&v"(dst) : "v"(vb0), "i"(off) : "memory")
#pragma unroll
    for (int d0 = 0; d0 < 4; ++d0) {
        s16x4 l0, h0, l1, h1;
        if (d0 == 0) { SB_TRRD(l0, 0); SB_TRRD(h0, 2048); SB_TRRD(l1, 4096); SB_TRRD(h1, 6144); }
        else if (d0 == 1) { SB_TRRD(l0, 512); SB_TRRD(h0, 512 + 2048); SB_TRRD(l1, 512 + 4096); SB_TRRD(h1, 512 + 6144); }
        else if (d0 == 2) { SB_TRRD(l0, 1024); SB_TRRD(h0, 1024 + 2048); SB_TRRD(l1, 1024 + 4096); SB_TRRD(h1, 1024 + 6144); }
        else { SB_TRRD(l0, 1536); SB_TRRD(h0, 1536 + 2048); SB_TRRD(l1, 1536 + 4096); SB_TRRD(h1, 1536 + 6144); }
        asm volatile("s_waitcnt lgkmcnt(0)" ::: "memory"); __builtin_amdgcn_sched_barrier(0);
        o[d0] = __builtin_amdgcn_mfma_f32_32x32x16_bf16(pa0, (bf16x8){l0[0], l0[1], l0[2], l0[3], h0[0], h0[1], h0[2], h0[3]}, o[d0], 0, 0, 0);
        o[d0] = __builtin_amdgcn_mfma_f32_32x32x16_bf16(pa1, (bf16x8){l1[0], l1[1], l1[2], l1[3], h1[0], h1[1], h1[2], h1[3]}, o[d0], 0, 0, 0);
    }
#undef SB_TRRD
}

constexpr int N_SAMPLE_UNITS = 32 * 16 * 2, N_PROMPT_UNITS = 4 * 16 * 64, N_UNITS = N_SAMPLE_UNITS + N_PROMPT_UNITS;
constexpr float PRUNE_LOG2 = 160.0f;

__device__ __forceinline__ void unit(const Args& A, const int id, SB_LAS char* wl, const int lane_in) {
    int lane = lane_in; asm volatile("" : "+v"(lane));
    const int r32 = lane & 31, hi = lane >> 5;
    const unsigned vb0 = (unsigned)(size_t)(wl + 8192) + (unsigned)v_rd_base(lane);
    int qrow0, h, nt_new, nt_cache, b; int krow0;
    if (id < N_SAMPLE_UNITS) { b = id >> 5; h = (id >> 1) & 15; const int half = id & 1; qrow0 = 8192 + b * 64 + half * 32; krow0 = 8192 + b * 64; nt_new = half + 1; nt_cache = 32; }
    else { const int j = id - N_SAMPLE_UNITS; const int g = 7 - (j >> 9), bh = (j & 511) >> 3, qb = g * 8 + (j & 7); b = bh >> 4; h = bh & 15; qrow0 = b * 2048 + qb * 32; krow0 = b * 2048; nt_new = qb + 1; nt_cache = 0; }
    bf16x8 qr[8];
#pragma unroll
    for (int d0 = 0; d0 < 8; ++d0) qr[d0] = *(const bf16x8*)(A.Q + (size_t)(qrow0 + r32) * 2048 + h * 128 + d0 * 16 + hi * 8);
    f32x16 o[4] = {}; float R = 0.f;
    const int NT = nt_new + nt_cache, srow = lane >> 4, sch = lane & 15;
    f32x4 raw[16];
    const unsigned lb16 = (unsigned)(srow * 2048 + sch * 8) * 2u, lb32 = lb16 * 2u;
    SB_LAS char* const kst0 = wl + SB_KSWZ(srow, sch * 16);
    SB_LAS char* const kst1 = wl + SB_KSWZ(4 + srow, sch * 16);
    SB_LAS char* const vst = wl + 8192 + ((sch * 8) >> 5) * 512 + srow * 64 + ((sch * 8) & 31) * 2;
#define SB_VOFF(i) ((((i) & 1) * 2048) + (((i) >> 2) * 4096) + ((((i) >> 1) & 1) * 256))
#define SB_KV_BF16(idx_) ((size_t)(krow0 + 32 * (nt_new - 1 - (idx_))) * 2048 + h * 128)
#define SB_KV_F32(idx_) (((size_t)(b * 1024 + 32 * (nt_cache - 1 - ((idx_) - nt_new))) * 16 + h) * 128)
#define SB_LD_BF16(idx_) do { const char* kt_ = (const char*)(A.K + SB_KV_BF16(idx_)); const char* vt_ = (const char*)(A.V + SB_KV_BF16(idx_)); _Pragma("unroll") for (int i = 0; i < 8; ++i) { \
        raw[i] = *(const f32x4*)(kt_ + (size_t)i * 16384 + lb16); raw[8 + i] = *(const f32x4*)(vt_ + (size_t)i * 16384 + lb16); } } while (0)
#define SB_LD_F32(P_, idx_) do { const char* t_ = (const char*)((P_) + SB_KV_F32(idx_)); _Pragma("unroll") for (int i = 0; i < 8; ++i) { \
        raw[2 * i] = *(const f32x4*)(t_ + (size_t)i * 32768 + lb32); raw[2 * i + 1] = *(const f32x4*)(t_ + (size_t)i * 32768 + lb32 + 16); } } while (0)
    bool live = true;
    if (live) SB_LD_BF16(0);
#pragma clang loop unroll(disable)
    for (int idx = 0; idx < NT && live; ++idx) {
        if (idx < nt_new) {
#pragma unroll
            for (int i = 0; i < 8; ++i) { *(SB_LAS f32x4*)(((i & 1) ? kst1 : kst0) + (i & ~1) * 1024) = raw[i]; *(SB_LAS f32x4*)(vst + SB_VOFF(i)) = raw[8 + i]; }
        } else {
#pragma unroll
            for (int i = 0; i < 8; ++i) *(SB_LAS bf16x8*)(((i & 1) ? kst1 : kst0) + (i & ~1) * 1024) = pack8(raw[2 * i], raw[2 * i + 1]);
            SB_LD_F32(A.cv, idx);
#pragma unroll
            for (int i = 0; i < 8; ++i) *(SB_LAS bf16x8*)(vst + SB_VOFF(i)) = pack8(raw[2 * i], raw[2 * i + 1]);
        }
        if (idx + 1 < NT) { if (idx + 1 < nt_new) SB_LD_BF16(idx + 1); else SB_LD_F32(A.ck, idx + 1); }
        tile_compute(wl, qr, o, R, idx == 0, r32, hi, vb0);
        if (SB_PRUNE) live = !__all(R > PRUNE_LOG2);
    }
#undef SB_VOFF
#undef SB_KV_BF16
#undef SB_KV_F32
#undef SB_LD_BF16
#undef SB_LD_F32
    asm volatile("s_waitcnt lgkmcnt(0)" ::: "memory");
    int lz = lane; asm volatile("" : "+v"(lz));
    { SB_LAS char* ob = wl + ((lz >> 5) * 4 * 128 + (lz & 31)) * 4;
#pragma unroll
      for (int d0 = 0; d0 < 4; ++d0)
#pragma unroll
        for (int r = 0; r < 16; ++r) *(SB_LAS float*)(ob + (((r & 3) + 8 * (r >> 2)) * 128 + d0 * 32) * 4) = o[d0][r]; }
    asm volatile("s_waitcnt lgkmcnt(0)" ::: "memory");
    const int rr = lz >> 4, ch = lz & 15;
#pragma unroll
    for (int i = 0; i < 8; ++i) { const int q = 4 * i + rr;
        const f32x4 a = *(const SB_LAS f32x4*)(wl + (q * 128 + ch * 8) * 4), c = *(const SB_LAS f32x4*)(wl + (q * 128 + ch * 8 + 4) * 4);
        const size_t go = (size_t)(qrow0 + q) * 2048 + h * 128 + ch * 8;
        const u32x4 z = *(const u32x4*)(A.SZA + go);
        const f32x4 ya = a * (f32x4){pg8::bf_lo(z.x), pg8::bf_hi(z.x), pg8::bf_lo(z.y), pg8::bf_hi(z.y)}, yc = c * (f32x4){pg8::bf_lo(z.z), pg8::bf_hi(z.z), pg8::bf_lo(z.w), pg8::bf_hi(z.w)};
        *(pg8::u32x2*)(A.YA8 + go) = pg8::pack8_fp8(ya * pg8::SC_Y, yc * pg8::SC_Y); }
    asm volatile("s_waitcnt lgkmcnt(0)" ::: "memory");
}

__device__ __forceinline__ void attn_phase(const Args& A, SB_LAS char* lds, const int wave, const int lane, unsigned* queue, const int id0, const int n) {
    SB_LAS char* wl = lds + wave * WAVE_LDS;
    for (;;) {
        unsigned id = 0;
        if (lane == 0) id = __hip_atomic_fetch_add(queue, 1u, __ATOMIC_RELAXED, __HIP_MEMORY_SCOPE_AGENT);
        id = (unsigned)__builtin_amdgcn_readfirstlane((int)id);
        if (id >= (unsigned)n) break;
        unit(A, id0 + (int)id, wl, lane);
    }
}
}

constexpr int NWAVES = 8;
constexpr int N_LAUNCHES = MK_N_LAUNCHES;
constexpr int PER_PHASE = 6;

constexpr int DM = 4096, NIN = 24576, WB = 2048;
constexpr int MP = 8192, MS = 2048, M = MP + MS;
constexpr int NB16 = 4096, NF8 = 20480;
constexpr float LN_EPS = 1e-5f;
constexpr float DN_ALPHA = 1.189207115002721f;

constexpr size_t MiB = 1u << 20;
constexpr size_t WS_CTL = 0, CTL_ZERO_BYTES = 1 * MiB;
constexpr size_t WS_WINB = 1 * MiB;
constexpr size_t WS_WCH = WS_WINB + 32 * MiB;
constexpr size_t WS_XG = WS_WCH + 32 * MiB;
constexpr size_t WS_WIN8 = WS_XG + 2 * MiB;
constexpr size_t WS_WA8 = WS_WIN8 + 80 * MiB;
constexpr size_t WS_WB8 = WS_WA8 + 8 * MiB;
constexpr size_t WS_WO8 = WS_WB8 + 8 * MiB;
constexpr size_t WS_XB = WS_WO8 + 16 * MiB;
constexpr size_t WS_X8 = WS_XB + 80 * MiB;
constexpr size_t WS_Q = WS_X8 + 40 * MiB, WS_K = WS_Q + 40 * MiB, WS_V = WS_K + 40 * MiB, WS_SZA = WS_V + 40 * MiB, WS_U = WS_SZA + 40 * MiB, WS_GT = WS_U + 40 * MiB;
constexpr size_t WS_SGA = WS_GT + 40 * MiB, WS_SGB = WS_SGA + 80 * MiB;
constexpr size_t WS_YA8 = WS_SGB + 80 * MiB, WS_YB8 = WS_YA8 + 20 * MiB;
constexpr size_t WS_M1 = WS_YB8 + 20 * MiB;
constexpr size_t WS_MG8 = WS_M1 + 80 * MiB;
constexpr size_t WS_PRE = WS_MG8 + 40 * MiB;
constexpr size_t WS_END = WS_PRE + 80 * MiB;
static_assert(WS_END < (size_t)0x7fffffff, "every GEMM operand must be addressable as a 31-bit byte offset from the workspace base");
constexpr int CW_TMO = 0, CW_CODE = 1, CW_QUEUE = 64;
constexpr int CW_P1A = 1024, CW_P1B = 1536, CW_P0B = 2048, CW_PM = 2112, CW_QZ = 2752, CW_KV = 2816, CW_CONVQ = 128;
constexpr int CW_BAR = 4096;

constexpr int RING_OFF = 0, RING_BYTES = 131072;
constexpr int LDS_BYTES = 147456;
constexpr int LDSCTL_OFF = LDS_BYTES - 512, MISC_OFF = LDSCTL_OFF + 320;
constexpr int P0_WAVE_LDS = 128 * 33 * 4;
static_assert(8 * P0_WAVE_LDS <= LDSCTL_OFF, "LDS map");
static_assert(MISC_OFF + 128 <= LDS_BYTES, "LDS map");

#define GAS __attribute__((address_space(1)))
#define LAS __attribute__((address_space(3)))
typedef unsigned short bf16;
typedef unsigned v4u __attribute__((ext_vector_type(4)));
typedef unsigned v2u __attribute__((ext_vector_type(2)));
typedef float f32x4 __attribute__((ext_vector_type(4)));
typedef GAS unsigned gu32;
#define RLX_AGENT __ATOMIC_RELAXED, __HIP_MEMORY_SCOPE_AGENT
#define LDS_WAIT() asm volatile("s_waitcnt lgkmcnt(0)" ::: "memory")
#define VM_WAIT() asm volatile("s_waitcnt vmcnt(0)" ::: "memory")

#define XB_TMO      128
#define XB_XCNT(j)  (256  + 64 * (j))
#define XB_XSUB(j)  (1280 + 64 * (j))
#define XB_XGEN(j)  (2304 + 64 * (j))
#define XB_TOP      3328
#define XB_TOPGEN   3392
#define XCD_BAR_WORDS 3456
#define XB_SPIN_CAP (1u << 18)

__device__ __forceinline__ unsigned xb_ld(unsigned* p)              { return __hip_atomic_load(p, __ATOMIC_RELAXED, __HIP_MEMORY_SCOPE_AGENT); }
__device__ __forceinline__ unsigned xb_add(unsigned* p, unsigned v) { return __hip_atomic_fetch_add(p, v, __ATOMIC_RELAXED, __HIP_MEMORY_SCOPE_AGENT); }
__device__ __forceinline__ unsigned xb_xcc_id() { return (unsigned)__builtin_amdgcn_s_getreg((3 << 11) | 20) & 0xFu; }
#define XB_SPIN(cond, bar) do { unsigned _sp = 0; while (cond) { __builtin_amdgcn_s_sleep(1); \
    if ((++_sp & 255u) == 0u) { if (xb_ld(&(bar)[XB_TMO])) break; if (_sp > XB_SPIN_CAP) { atomicAdd(&(bar)[XB_TMO], 1u); break; } } } } while (0)

struct XcdBarrier {
    unsigned* bar; unsigned x;
    volatile LAS unsigned* st;
};
__device__ __forceinline__ XcdBarrier xcd_barrier_post(unsigned* bar, volatile LAS unsigned* st) {
    XcdBarrier b; b.bar = bar; b.x = xb_xcc_id(); b.st = st;
    if (threadIdx.x == 0) (void)xb_add(&bar[XB_XCNT(b.x)], 1u);
    return b;
}
__device__ __forceinline__ void xcd_barrier_complete(unsigned* bar, unsigned x, unsigned& nloc, unsigned& nx) {
    const unsigned G = gridDim.x * gridDim.y * gridDim.z;
    unsigned sum, cnt, mine, sp = 0u;
    for (;;) {
        sum = 0u; cnt = 0u; mine = 0u;
#pragma unroll
        for (unsigned j = 0; j < 16; ++j) { const unsigned c = xb_ld(&bar[XB_XCNT(j)]); sum += c; cnt += (c > 0u) ? 1u : 0u; mine = (j == x) ? c : mine; }
        if (sum == G) break;
        __builtin_amdgcn_s_sleep(1);
        if ((++sp & 255u) == 0u) { if (xb_ld(&bar[XB_TMO])) break; if (sp > XB_SPIN_CAP) { atomicAdd(&bar[XB_TMO], 1u); break; } }
    }
    nloc = mine > 0u ? mine : 1u; nx = cnt > 0u ? cnt : 1u;
}
__device__ __forceinline__ void xcd_barrier(const XcdBarrier& b) {
    asm volatile("s_waitcnt vmcnt(0)" ::: "memory");
    __syncthreads();
    if (threadIdx.x == 0) {
        unsigned* bar = b.bar;
        __builtin_amdgcn_s_waitcnt(0);
        unsigned nloc = b.st[0], nx = b.st[1];
        if (nloc == 0u) { xcd_barrier_complete(bar, b.x, nloc, nx); b.st[0] = nloc; b.st[1] = nx; }
        const unsigned old = xb_add(&bar[XB_XSUB(b.x)], 1u);
        const unsigned gen = old / nloc;
        if (old + 1u == (gen + 1u) * nloc) {
            __builtin_amdgcn_fence(__ATOMIC_RELEASE, "agent");
            asm volatile("s_waitcnt vmcnt(0)" ::: "memory");
            const unsigned og = xb_add(&bar[XB_TOP], 1u);
            const unsigned tg = og / nx;
            if (og + 1u == (tg + 1u) * nx) xb_add(&bar[XB_TOPGEN], 1u);
            else XB_SPIN(xb_ld(&bar[XB_TOPGEN]) == tg, bar);
            __builtin_amdgcn_fence(__ATOMIC_ACQUIRE, "agent");
            xb_add(&bar[XB_XGEN(b.x)], 1u);
            asm volatile("s_waitcnt vmcnt(0)" ::: "memory");
        } else {
            XB_SPIN(xb_ld(&bar[XB_XGEN(b.x)]) == gen, bar);
            __builtin_amdgcn_fence(__ATOMIC_ACQUIRE, "agent");
            asm volatile("s_waitcnt vmcnt(0)" ::: "memory");
        }
    }
    __syncthreads();
}

__device__ __forceinline__ float wave_sum(float v) {
#pragma unroll
    for (int o = 1; o < 64; o <<= 1) v += __shfl_xor(v, o);
    return v;
}
__device__ __forceinline__ void win_dest_row(int n, int& r8, int& r16, int& which) {
    r8 = -1; r16 = -1; which = 0;
    if (n < 2048) { r8 = n; return; }
    if (n < 4096) { r16 = n - 2048; return; }
    if (n < 6144) { r16 = 2048 + (n - 4096); return; }
    if (n < 8192) { r8 = 2048 + (n - 6144); return; }
    if (n < 16384) { const int sg = (n - 8192) >> 11, ch = (n - 8192) & 2047, i = ch >> 7, o = ch & 127;
        if (sg == 1 || sg == 2) { const int r = i * 256 + ((sg == 2) ? 128 : 0) + o; r8 = 4096 + r; r16 = r; which = 1; }
        else r8 = 8192 + i * 256 + ((sg == 3) ? 128 : 0) + o;
        return; }
    r8 = 12288 + (n - 16384);
}
struct P0Item { const float* src; int N, K, k0, n0, mode; unsigned char* dst; unsigned char* dstch; unsigned char* dst8; float scale; };
__device__ __forceinline__ void p0_load(const P0Item& d, f32x4 (&v)[16], int lane) {
    const int kr = lane >> 3, nq = lane & 7;
    const float* p = d.src + (size_t)(d.k0 + kr) * d.N + d.n0 + 4 * nq;
#pragma unroll
    for (int i = 0; i < 16; ++i) v[i] = __builtin_nontemporal_load((const f32x4*)(p + (size_t)(8 * i) * d.N));
}
__device__ __forceinline__ void p0_store(const P0Item& d, const f32x4 (&v)[16], LAS float* scr, int lane) {
    const int kr = lane >> 3, nq = lane & 7;
#pragma unroll
    for (int i = 0; i < 16; ++i) { LAS float* q = scr + (8 * i + kr) * 33 + 4 * nq; q[0] = v[i].x; q[1] = v[i].y; q[2] = v[i].z; q[3] = v[i].w; }
    LDS_WAIT(); asm volatile("" ::: "memory");
    const int c = lane & 15;
    int r8 = d.n0, r16 = -1, which = 0;
    if (d.mode == 2) win_dest_row(d.n0, r8, r16, which);
    bf16* const d16 = (bf16*)(which ? d.dstch : d.dst);
#pragma unroll
    for (int j = 0; j < 8; ++j) { const int n = (lane >> 4) + 4 * j; const LAS float* s = scr + (8 * c) * 33 + n;
        const f32x4 a = {s[0 * 33], s[1 * 33], s[2 * 33], s[3 * 33]}, b = {s[4 * 33], s[5 * 33], s[6 * 33], s[7 * 33]};
        if (r8 >= 0) *(GAS v2u*)(d.dst8 + (size_t)(r8 + n) * d.K + d.k0 + 8 * c) = pg8::pack8_fp8(a * d.scale, b * d.scale);
        if (r16 >= 0) *(GAS v4u*)(d16 + (size_t)(r16 + n) * d.K + d.k0 + 8 * c) = pg8::pack8(a, b); }
    LDS_WAIT(); asm volatile("" ::: "memory");
}

struct KArgs { const float* in[14]; float* out; unsigned char* ws; int ph_lo, ph_hi; };
typedef const KArgs __attribute__((address_space(4))) * KArgsPtr;
template <int SET> __device__ __forceinline__ P0Item p0_decode(int it, const float* w_in, const float* w_a, const float* w_b, const float* w_o, unsigned char* ws) {
    constexpr int KB = DM / 128, I_A = (WB / 128) * (DM / 32);
    P0Item d; int r = it, nb;
    d.src = w_in; d.N = NIN; d.K = DM; d.mode = 2; d.dst = ws + WS_WINB; d.dstch = ws + WS_WCH; d.dst8 = ws + WS_WIN8; d.scale = pg8::SC_WIN;
    if (SET == 0) { nb = r % 256; nb = nb < 128 ? 64 + nb : 320 + (nb - 128); d.k0 = 128 * (r / 256); d.n0 = 32 * nb; return d; }
    if (r < KB * 512) { nb = r % 512; nb = nb < 64 ? nb : nb < 192 ? 192 + (nb - 64) : 448 + (nb - 192); d.k0 = 128 * (r / 512); d.n0 = 32 * nb; return d; }
    r -= KB * 512; d.mode = 1; d.dst = nullptr; d.dstch = nullptr; d.N = DM;
    if (r < I_A) { d.src = w_a; d.K = WB; d.dst8 = ws + WS_WA8; d.scale = pg8::SC_WAB; }
    else if ((r -= I_A) < I_A) { d.src = w_b; d.K = WB; d.dst8 = ws + WS_WB8; d.scale = pg8::SC_WAB; }
    else { r -= I_A; d.src = w_o; d.K = DM; d.dst8 = ws + WS_WO8; d.scale = pg8::SC_WO; }
    d.k0 = 128 * (r / (DM / 32)); d.n0 = 32 * (r % (DM / 32)); return d;
}
template <int SET> __device__ __forceinline__ void p0_weights(KArgsPtr ap, unsigned char* ws, LAS float* scr, int lane, int w0, int wn) {
    constexpr int NITEMS = SET == 0 ? (DM / 128) * 256 : (DM / 128) * 512 + 2 * (WB / 128) * (DM / 32) + (DM / 128) * (DM / 32);
    const float *w_in = ap->in[5], *w_a = ap->in[9], *w_b = ap->in[10], *w_o = ap->in[11];
    f32x4 cur[16], nxt[16];
    int it = w0;
    if (it < NITEMS) { const P0Item d = p0_decode<SET>(it, w_in, w_a, w_b, w_o, ws); p0_load(d, cur, lane); }
    while (it < NITEMS) {
        const int itn = it + wn;
        if (itn < NITEMS) { const P0Item dn = p0_decode<SET>(itn, w_in, w_a, w_b, w_o, ws); p0_load(dn, nxt, lane); }
        { const P0Item d = p0_decode<SET>(it, w_in, w_a, w_b, w_o, ws); p0_store(d, cur, scr, lane); }
#pragma unroll
        for (int i = 0; i < 16; ++i) cur[i] = nxt[i];
        it = itn;
    }
}
template <int WHICH> __device__ __forceinline__ void p0_x(KArgsPtr ap, unsigned char* ws, size_t gt, size_t NT) {
    const float *x = ap->in[0], *xs = ap->in[1];
    const size_t NX = (size_t)M * DM / 16;
    for (size_t i0 = gt; i0 < NX; i0 += 4 * NT) {
        f32x4 a[4], b[4], c[4], d[4];
#pragma unroll
        for (int u = 0; u < 4; ++u) { const size_t i = i0 + u * NT; if (i < NX) { const size_t e = i * 16; const float* src = (e < (size_t)MP * DM) ? x + e : xs + (e - (size_t)MP * DM);
            a[u] = __builtin_nontemporal_load((const f32x4*)src); b[u] = __builtin_nontemporal_load((const f32x4*)(src + 4)); c[u] = __builtin_nontemporal_load((const f32x4*)(src + 8)); d[u] = __builtin_nontemporal_load((const f32x4*)(src + 12)); } }
#pragma unroll
        for (int u = 0; u < 4; ++u) { const size_t i = i0 + u * NT; if (i < NX) { const size_t e = i * 16;
            if (WHICH & 1) { *(pg8::u32x4*)((bf16*)(ws + WS_XB) + e) = pg8::pack8(a[u], b[u]); *(pg8::u32x4*)((bf16*)(ws + WS_XB) + e + 8) = pg8::pack8(c[u], d[u]); }
            if (WHICH & 2) { const pg8::u32x2 p = pg8::pack8_fp8(a[u], b[u]), q = pg8::pack8_fp8(c[u], d[u]); *(pg8::u32x4*)(ws + WS_X8 + e) = (pg8::u32x4){p.x, p.y, q.x, q.y}; } } }
    }
    if (WHICH & 1) {
        for (size_t i = gt; i < (size_t)256 * (DM / 8); i += NT) {
            const int row = (int)(i >> 9), c8 = (int)(i & 511) * 8;
            pg8::u32x4 w = {0u, 0u, 0u, 0u};
            if (row < 72) { const float* src = (row < 8) ? x + ((size_t)((row >> 1) * 2048 + 2046 + (row & 1))) * DM + c8 : xs + ((size_t)(((row - 8) >> 1) * 64 + 62 + (row & 1))) * DM + c8;
                w = pg8::pack8(*(const f32x4*)src, *(const f32x4*)(src + 4)); }
            *(pg8::u32x4*)((bf16*)(ws + WS_XG) + (size_t)row * DM + c8) = w;
        }
    }
}
#define PHASE_ARGS() KArgsPtr ap = (KArgsPtr)__builtin_amdgcn_kernarg_segment_ptr(); asm volatile("" : "+s"(ap)); unsigned char* const ws = ap->ws; \
    const __amdgpu_buffer_rsrc_t rsrc = __builtin_amdgcn_make_buffer_rsrc((void*)ws, 0, 0x7fffffff, 0x00020000)

__global__ void __launch_bounds__(NWAVES * 64, 2) mk_fwd(const KArgs args) {
    extern __shared__ __attribute__((aligned(16))) unsigned char lds_raw[];
    LAS unsigned char* const lds = (LAS unsigned char*)lds_raw;
    volatile LAS unsigned* const MISC = (volatile LAS unsigned*)(lds + MISC_OFF);
    const int wave = __builtin_amdgcn_readfirstlane((int)threadIdx.x >> 6);
#define LANE_TID() int lane = (int)__builtin_amdgcn_mbcnt_hi(~0u, __builtin_amdgcn_mbcnt_lo(~0u, 0u)); asm volatile("" : "+v"(lane)); const int tid = wave * 64 + lane; (void)tid
    int tid0 = threadIdx.x;
    const int G = gridDim.x, vcu = (G % 8 == 0) ? ((int)blockIdx.x % 8) * (G / 8) + (int)blockIdx.x / 8 : (int)blockIdx.x;
    gu32* const ctl = (gu32*)(args.ws + WS_CTL);
    for (int u = tid0; u < (LDS_BYTES - LDSCTL_OFF) / 4; u += NWAVES * 64) ((LAS unsigned*)(lds + LDSCTL_OFF))[u] = 0u;
    __syncthreads();
    XcdBarrier bar; bar.bar = (unsigned*)(ctl + CW_BAR); bar.x = 0; bar.st = nullptr;
    if (N_LAUNCHES != PER_PHASE) bar = xcd_barrier_post((unsigned*)(ctl + CW_BAR), MISC + 8);
#define GRID_BAR(seam) do { if (N_LAUNCHES == PER_PHASE) { if (threadIdx.x == 0) __hip_atomic_store(ctl + CW_TMO, 0xBADBA0u | (unsigned)(seam), RLX_AGENT); } else { xcd_barrier(bar); } } while (0)
    const int lo = args.ph_lo, hi = args.ph_hi;
#define IN(k) (lo <= (k) && (k) < hi)
#define BOTH(k) (IN(k) && IN((k) + 1))
    const int gw = vcu * NWAVES + wave, NGW = G * NWAVES;

    constexpr int NCX = 8;
    const bool dynp1 = (G == 32 * pg8::NXCD);
    const bool early_attn = dynp1 && (lo <= 1 && 2 < hi);
    if (IN(0)) {
        PHASE_ARGS(); (void)rsrc; LANE_TID();
        LAS float* scr = (LAS float*)(lds + wave * P0_WAVE_LDS);
        p0_weights<0>(ap, ws, scr, lane, gw, NGW);
        p0_x<3>(ap, ws, (size_t)blockIdx.x * (NWAVES * 64) + tid, (size_t)G * NWAVES * 64);
        if (!dynp1) p0_weights<1>(ap, ws, scr, lane, gw, NGW);
        if (BOTH(0)) GRID_BAR(0);
    }

    if (IN(1)) {
        if (dynp1) {
            const int xq = (int)blockIdx.x % pg8::NXCD, rho = (int)blockIdx.x / pg8::NXCD, NGX = 32 - NCX;
            gu32* const done = ctl + CW_P0B;
            if (rho >= NGX) {
                { PHASE_ARGS(); (void)rsrc; LANE_TID();
                  LAS float* scr = (LAS float*)(lds + wave * P0_WAVE_LDS);
                  const int cb = (rho - NGX) * pg8::NXCD + xq;
                  p0_weights<1>(ap, ws, scr, lane, cb * NWAVES + wave, NCX * pg8::NXCD * NWAVES); }
                asm volatile("s_waitcnt vmcnt(0)" ::: "memory");
                __syncthreads();
                { LANE_TID(); if (wave == 0 && lane == 0) { __builtin_amdgcn_fence(__ATOMIC_RELEASE, "agent"); asm volatile("s_waitcnt vmcnt(0)" ::: "memory"); (void)__hip_atomic_fetch_add(done, 1u, RLX_AGENT); } }
            } else {
                PHASE_ARGS();
                pg8::Sched S; S.init(M / 256, NB16 / 256, G, (int)blockIdx.x, 0, 0, WS_XB, WS_XG, WS_WINB, WS_WCH, DM * 2); S.nextra = 16;
                pg8::EpiProjB E{ap->in[6], (bf16*)(ws + WS_K), (bf16*)(ws + WS_V), ap->out, nullptr};
                const pg8::Dyn D{(unsigned*)(ctl + CW_P1A + 64 * xq), xq, rho, NGX, MISC + 16, nullptr, 0};
                pg8::gemm_phase<pg8::EpiProjB, PG8_ALIGN, PG8_SP2, false, true>(lds + RING_OFF, wave, rsrc, DM * 2, DM * 2, S, E, D);
            }
            { LANE_TID(); if (wave == 0 && lane == 0) { unsigned sp = 0; while (__hip_atomic_load(done, RLX_AGENT) < (unsigned)(NCX * pg8::NXCD)) { __builtin_amdgcn_s_sleep(4); if (++sp > (1u << 22)) break; }
                  __builtin_amdgcn_fence(__ATOMIC_ACQUIRE, "agent"); } }
            __syncthreads();
            { PHASE_ARGS();
              pg8::Sched S; S.init(M / 256, NF8 / 256, G, (int)blockIdx.x, 0, 0, WS_X8, WS_X8, WS_WIN8, WS_WIN8, DM);
              S.il = 1;
              pg8::EpiProj8 E{ap->in[6], (bf16*)(ws + WS_Q), (bf16*)(ws + WS_SZA), (bf16*)(ws + WS_U), (bf16*)(ws + WS_GT), (bf16*)(ws + WS_SGA), (bf16*)(ws + WS_SGB), nullptr};
              const pg8::Dyn D{(unsigned*)(ctl + CW_P1B + 64 * xq), xq, rho, 32, MISC + 16, early_attn ? (unsigned*)(ctl + CW_QZ) : nullptr, 320};
              pg8::gemm_phase<pg8::EpiProj8, PG8_ALIGN, PG8_SP2, true, true>(lds + RING_OFF, wave, rsrc, DM, DM, S, E, D); }
            if (early_attn) { LANE_TID(); if (wave == 0 && lane == 0) { unsigned sp = 0;
                  while (__hip_atomic_load(ctl + CW_QZ, RLX_AGENT) < (unsigned)G) { __builtin_amdgcn_s_sleep(4); if (++sp > (1u << 22)) break; }
                  __builtin_amdgcn_fence(__ATOMIC_ACQUIRE, "agent"); } }
            __syncthreads();

        } else {
            { PHASE_ARGS();
              pg8::Sched S; S.init(M / 256, NB16 / 256, G, (int)blockIdx.x, 0, 0, WS_XB, WS_XG, WS_WINB, WS_WCH, DM * 2); S.nextra = 16;
              pg8::EpiProjB E{ap->in[6], (bf16*)(ws + WS_K), (bf16*)(ws + WS_V), ap->out, nullptr};
              pg8::gemm_phase<pg8::EpiProjB, PG8_ALIGN, PG8_SP2, false>(lds + RING_OFF, wave, rsrc, DM * 2, DM * 2, S, E); }
            { PHASE_ARGS();
              pg8::Sched S; S.init(M / 256, NF8 / 256, G, (int)blockIdx.x, 0, 0, WS_X8, WS_X8, WS_WIN8, WS_WIN8, DM);
              pg8::EpiProj8 E{ap->in[6], (bf16*)(ws + WS_Q), (bf16*)(ws + WS_SZA), (bf16*)(ws + WS_U), (bf16*)(ws + WS_GT), (bf16*)(ws + WS_SGA), (bf16*)(ws + WS_SGB), nullptr};
              pg8::gemm_phase<pg8::EpiProj8, PG8_ALIGN, PG8_SP2, true>(lds + RING_OFF, wave, rsrc, DM, DM, S, E); }
        }
        if (BOTH(1) && !early_attn) GRID_BAR(1);
    }

    if (IN(2)) {
        PHASE_ARGS(); (void)rsrc; LANE_TID();
        const sbk::Args A{(const bf16*)(ws + WS_Q), (const bf16*)(ws + WS_K), (const bf16*)(ws + WS_V), (const bf16*)(ws + WS_SZA), ws + WS_YA8, ap->in[2], ap->in[3], (unsigned*)(ctl + CW_QUEUE)};
        SB_LAS char* wl = (LAS char*)(lds + RING_OFF) + wave * sbk::WAVE_LDS;
        constexpr unsigned T_PC = sbk::N_PROMPT_UNITS, T_SA = T_PC + MP / 4, T_SC = T_SA + sbk::N_SAMPLE_UNITS, T_END = T_SC + MS / 4;
        bool passed = !early_attn;
        for (;;) {
            unsigned t = 0;
            if (lane == 0) t = __hip_atomic_fetch_add(A.queue, 1u, __ATOMIC_RELAXED, __HIP_MEMORY_SCOPE_AGENT);
            t = (unsigned)__builtin_amdgcn_readfirstlane((int)t);
            if (t >= T_SA && !passed) { GRID_BAR(1); passed = true; }
            if (t >= T_END) break;
            if (t < T_PC) { sbk::unit(A, sbk::N_SAMPLE_UNITS + (int)t, wl, lane); continue; }
            if (t >= T_SA && t < T_SC) { sbk::unit(A, (int)(t - T_SA), wl, lane); continue; }
            const unsigned cq = t < T_SA ? t - T_PC : (unsigned)(MP / 4) + (t - T_SC);
            const float *state_conv = ap->in[4], *conv_w = ap->in[7], *conv_b = ap->in[8];
            const bf16 *Ub = (const bf16*)(ws + WS_U), *GT = (const bf16*)(ws + WS_GT);
#pragma clang loop unroll(disable)
            for (int kk = 0; kk < 16; ++kk) {
            const size_t i = (size_t)cq * 1024 + (size_t)kk * 64 + lane;
            const int row = (int)(i >> 8), c = (int)(i & 255) * 8;
            int tt, sb = 0; const bool samp = row >= MP;
            if (samp) { tt = (row - MP) & 63; sb = (row - MP) >> 6; } else tt = row & 2047;
            const pg8::u32x4 u2 = *(const pg8::u32x4*)(Ub + (size_t)row * WB + c), gg = *(const pg8::u32x4*)(GT + (size_t)row * WB + c);
            float xm1[8], xm2[8], x0[8], g[8];
            const unsigned uw[4] = {u2.x, u2.y, u2.z, u2.w}, gw4[4] = {gg.x, gg.y, gg.z, gg.w};
#pragma unroll
            for (int k = 0; k < 4; ++k) { x0[2 * k] = pg8::bf_lo(uw[k]); x0[2 * k + 1] = pg8::bf_hi(uw[k]); g[2 * k] = pg8::bf_lo(gw4[k]); g[2 * k + 1] = pg8::bf_hi(gw4[k]); }
            if (tt >= 1) { const pg8::u32x4 v = *(const pg8::u32x4*)(Ub + (size_t)(row - 1) * WB + c); const unsigned w[4] = {v.x, v.y, v.z, v.w};
#pragma unroll
                for (int k = 0; k < 4; ++k) { xm1[2 * k] = pg8::bf_lo(w[k]); xm1[2 * k + 1] = pg8::bf_hi(w[k]); } }
            else {
#pragma unroll
                for (int k = 0; k < 8; ++k) xm1[k] = samp ? state_conv[(size_t)(sb * 2 + 1) * WB + c + k] : 0.f; }
            if (tt >= 2) { const pg8::u32x4 v = *(const pg8::u32x4*)(Ub + (size_t)(row - 2) * WB + c); const unsigned w[4] = {v.x, v.y, v.z, v.w};
#pragma unroll
                for (int k = 0; k < 4; ++k) { xm2[2 * k] = pg8::bf_lo(w[k]); xm2[2 * k + 1] = pg8::bf_hi(w[k]); } }
            else {
#pragma unroll
                for (int k = 0; k < 8; ++k) xm2[k] = samp ? state_conv[(size_t)(sb * 2 + tt) * WB + c + k] : 0.f; }
            float y[8];
#pragma unroll
            for (int k = 0; k < 8; ++k) y[k] = pg8::SC_Y * g[k] * (conv_b[c + k] + conv_w[c + k] * xm2[k] + conv_w[WB + c + k] * xm1[k] + conv_w[2 * WB + c + k] * x0[k]);
            *(pg8::u32x2*)(ws + WS_YB8 + (size_t)row * WB + c) = pg8::pack8_fp8((f32x4){y[0], y[1], y[2], y[3]}, (f32x4){y[4], y[5], y[6], y[7]});
            }
        }
        if (BOTH(2)) GRID_BAR(2);
    }

    const bool rm34 = dynp1 && BOTH(3);
    if (IN(3)) {
        PHASE_ARGS();
        pg8::Sched S; S.init(M / 256, DM / 256, G, (int)blockIdx.x, 1, 0, WS_YA8, WS_YB8, WS_WA8, WS_WB8, WB);
        if (rm34) { S.rm = 1; S.rho = (int)blockIdx.x / pg8::NXCD; S.xq = (int)blockIdx.x % pg8::NXCD; }
        pg8::EpiMerge E{(const bf16*)(ws + WS_SGA), (const bf16*)(ws + WS_SGB), (bf16*)(ws + WS_M1), ws + WS_MG8, rsrc, (unsigned)WS_MG8, rm34 ? (unsigned*)(ctl + CW_PM) : nullptr};
        pg8::gemm_phase<pg8::EpiMerge, PG8_ALIGN, PG8_SP2, true>(lds + RING_OFF, wave, rsrc, WB, WB, S, E);
        if (BOTH(3) && !rm34) GRID_BAR(3);
    }

    if (IN(4)) {
        PHASE_ARGS();
        pg8::Sched S; S.init(M / 256, DM / 256, G, (int)blockIdx.x, 0, 0, WS_MG8, WS_MG8, WS_WO8, WS_WO8, DM);
        if (rm34) {
            S.rm = 2; S.rho = (int)blockIdx.x / pg8::NXCD; S.xq = (int)blockIdx.x % pg8::NXCD;
            { LANE_TID(); if (wave == 0 && lane == 0) {
                  const int rho = (int)blockIdx.x / pg8::NXCD, xq = (int)blockIdx.x % pg8::NXCD, nu = rho >= 16 ? 3 : 2, p0 = rho >= 16 ? rho - 16 : 48 + rho;
                  for (int k = 0; k < nu; ++k) { const int pp = p0 + 16 * k, pm = pp < 64 ? 8 * (2 * (pp >> 5) + (xq >> 2)) + (pp & 7) : 32 + ((pp - 64) & 7); unsigned sp = 0;
                      while (__hip_atomic_load(ctl + CW_PM + 16 * pm, RLX_AGENT) < 16u) { __builtin_amdgcn_s_sleep(4); if (++sp > (1u << 22)) break; } }
                  __builtin_amdgcn_fence(__ATOMIC_ACQUIRE, "agent"); } }
            __syncthreads();
        }
        pg8::EpiOut E{(const bf16*)(ws + WS_XB), (bf16*)(ws + WS_PRE), DN_ALPHA};
        pg8::gemm_phase<pg8::EpiOut, PG8_ALIGN, PG8_SP2, true>(lds + RING_OFF, wave, rsrc, DM, DM, S, E);
        if (BOTH(4)) GRID_BAR(4);
    }

    if (IN(5)) {
        PHASE_ARGS(); (void)rsrc; LANE_TID();
        const float *ln_g = ap->in[12], *ln_b = ap->in[13]; float* out = ap->out;
        for (int m = gw; m < M; m += NGW) {
            const pg8::u32x4* rp = (const pg8::u32x4*)((const bf16*)(ws + WS_PRE) + (size_t)m * DM) + lane;
            f32x4 v[16]; float s = 0.f;
#pragma unroll
            for (int j = 0; j < 8; ++j) { const pg8::u32x4 w = rp[64 * j]; v[2 * j] = pg8::bf4_lo(w); v[2 * j + 1] = pg8::bf4_hi(w); }
#pragma unroll
            for (int j = 0; j < 16; ++j) s += (v[j].x + v[j].y) + (v[j].z + v[j].w);
            const float mean = wave_sum(s) * (1.f / DM); float s2 = 0.f;
#pragma unroll
            for (int j = 0; j < 16; ++j) { v[j] = v[j] - mean; s2 += (v[j].x * v[j].x + v[j].y * v[j].y) + (v[j].z * v[j].z + v[j].w * v[j].w); }
            const float rstd = 1.f / sqrtf(wave_sum(s2) * (1.f / DM) + LN_EPS);
            float* orow = out + pg8::OUT_Y + (size_t)m * DM;
#pragma unroll
            for (int j = 0; j < 16; ++j) { const int e = ((j >> 1) * 64 + lane) * 8 + (j & 1) * 4;
                const f32x4 g = *(const f32x4*)(ln_g + e), bb = *(const f32x4*)(ln_b + e); *(GAS f32x4*)(orow + e) = v[j] * rstd * g + bb; }
        }
    }
#undef IN
#undef BOTH
}

extern "C" void kernel_launch(void* const* d_in, const int* in_sizes, int n_in, void* d_out, int out_size, void* d_ws, size_t ws_size, hipStream_t stream) {
    static int grid = 0;
    if (grid == 0) {
        if (n_in != 14 || (size_t)out_size != pg8::OUT_TOTAL || ws_size < WS_END) { fprintf(stderr, "kernel_launch: unexpected problem (n_in %d, out %d, ws %zu; need ws >= %zu); nothing launched\n", n_in, out_size, ws_size, (size_t)WS_END); grid = -1; return; }
        int dev = 0, cus = 0, per_cu = 0;
        if (hipGetDevice(&dev) != hipSuccess || hipDeviceGetAttribute(&cus, hipDeviceAttributeMultiprocessorCount, dev) != hipSuccess) { fprintf(stderr, "kernel_launch: device query failed\n"); grid = -1; return; }
        if (hipFuncSetAttribute((const void*)mk_fwd, hipFuncAttributeMaxDynamicSharedMemorySize, LDS_BYTES) != hipSuccess) { fprintf(stderr, "kernel_launch: hipFuncSetAttribute failed\n"); grid = -1; return; }
        if (hipOccupancyMaxActiveBlocksPerMultiprocessor(&per_cu, (const void*)mk_fwd, NWAVES * 64, LDS_BYTES) != hipSuccess || per_cu < 1) { fprintf(stderr, "kernel_launch: occupancy query reports %d workgroups per CU\n", per_cu); }
        (void)hipGetLastError();
        grid = cus;
    }
    if (grid < 0) return;
    if (hipMemsetAsync((char*)d_ws + WS_CTL, 0, CTL_ZERO_BYTES, stream) != hipSuccess) { fprintf(stderr, "kernel_launch: hipMemsetAsync failed\n"); return; }
    KArgs a{};
    for (int i = 0; i < 14; ++i) a.in[i] = (const float*)d_in[i];
    a.out = (float*)d_out; a.ws = (unsigned char*)d_ws;
    if (N_LAUNCHES == 1) {
        a.ph_lo = 0; a.ph_hi = PER_PHASE;
        hipLaunchKernelGGL(mk_fwd, dim3(grid), dim3(NWAVES * 64), LDS_BYTES, stream, a);
    } else {
        for (int li = 0; li < PER_PHASE; ++li) { a.ph_lo = li; a.ph_hi = li + 1; hipLaunchKernelGGL(mk_fwd, dim3(grid), dim3(NWAVES * 64), LDS_BYTES, stream, a); }
    }
    const hipError_t le = hipPeekAtLastError();
    if (le != hipSuccess) fprintf(stderr, "kernel_launch: launch failed: %s\n", hipGetErrorName(le));
}
```

```cpp
#include <hip/hip_runtime.h>
#include <cstdio>
#include <cstdint>

#ifndef MK_N_LAUNCHES
#define MK_N_LAUNCHES 1
#endif
#ifndef SB_PRUNE
#define SB_PRUNE 1
#endif

namespace pg8 {
#define PG8_LAS __attribute__((address_space(3)))
typedef unsigned short bf16_t;
typedef short bf16x8 __attribute__((ext_vector_type(8)));
typedef float f32x4 __attribute__((ext_vector_type(4)));
typedef unsigned u32x4 __attribute__((ext_vector_type(4)));
constexpr int BM = 256, BK = 64, HALF = 128, HTB = HALF * BK * 2  , STAGE_BYTES = 8 * HTB, NXCD = 8, WGM = 8;

__host__ __device__ __forceinline__ int lds_byte(int r, int c) { const int st = (r >> 4) * 2 + (c >> 5), rr = r & 15, cc = c & 31, ob = rr * 64 + cc * 2; return st * 1024 + (ob ^ (((ob >> 9) & 1) << 5)); }
__host__ __device__ __forceinline__ void stage_rc(int b, int& R, int& C) { const int st = b / 1024, sb = b % 1024, swz = sb ^ (((sb >> 9) & 1) << 5); R = (st >> 1) * 16 + swz / 64; C = (st & 1) * 32 + (swz % 64) / 2; }
__host__ __device__ __forceinline__ int perm32(int rho) { const int n = rho >> 4, i = rho & 15; return 8 * (i >> 2) + 4 * n + (i & 3); }

struct Unit { int pm, pn, z; };

struct Sched {
    int nM, nN, nwg, G, c, zmode, pm0;
    int il;
    int rm, rho, xq;
    int nextra;
    int tail_c0;
    unsigned A0, A1, B0, B1, tstep;
    __device__ void init(int nM_, int nN_, int G_, int c_, int zmode_, int pm0_, size_t a0, size_t a1, size_t b0, size_t b1, int LDb) {
        nM = nM_; nN = nN_; nwg = nM * nN; G = G_; c = c_; zmode = zmode_; pm0 = pm0_; nextra = 0; tail_c0 = -1; rm = 0; rho = 0; xq = 0; il = 0; A0 = (unsigned)a0; A1 = (unsigned)a1; B0 = (unsigned)b0; B1 = (unsigned)b1; tstep = (unsigned)(BM * LDb); }
    __device__ bool next(int i, Unit& u) const {
        int ii = i, z = 0;
        if (zmode == 1) { ii = i >> 1; z = i & 1; }
        if (rm) {
            int p;
            if (rm == 1) { if (ii < 2) p = 32 * ii + rho; else if (ii == 2 && rho < 16) p = 64 + rho; else return false; }
            else if (rho >= 16) { if (ii > 2) return false; p = rho - 16 + 16 * ii; } else { if (ii > 1) return false; p = 48 + rho + 16 * ii; }
            return rm_at(p, u, z);
        }
        long L = (long)ii * G + c;
        if (tail_c0 >= 0) { const int full = nwg / G; if (ii >= full) { if (c < tail_c0) return false; const long idx = (long)(ii - full) * (G - tail_c0) + (c - tail_c0); if (idx >= nwg - (long)full * G) return false; L = (long)full * G + idx; } }
        return at(L, u, z);
    }
    __device__ bool rm_at(int p, Unit& u, int z) const {
        if (p < 64) { const int r = p >> 5, q = p & 31; u.pm = pm0 + 8 * (2 * r + (xq >> 2)) + (q & 7); u.pn = 4 * (xq & 3) + (q >> 3); }
        else { const int q = p - 64; u.pm = pm0 + 32 + (q & 7); u.pn = 2 * xq + (q >> 3); }
        u.z = z; return true;
    }
    __device__ bool at(long L, Unit& u, int z = 0) const {
        if (il) {
            const int k = (int)(L / NXCD), x = (int)(L % NXCD);
            if (k >= 400) return false;
            if (k < 384) { const int blk = 8 * (k >> 5) + x, q = k & 31, g = blk / 20, j = blk % 20; u.pm = pm0 + 8 * g + (q & 7); u.pn = 4 * j + (q >> 3); }
            else { const int q = k - 384; u.pm = pm0 + 32 + (q & 7); u.pn = 64 + 2 * x + (q >> 3); }
            u.z = z; return true;
        }
        if (L >= nwg) { if (L >= nwg + nextra) return false; u.pm = 0; u.pn = (int)(L - nwg); u.z = 1; return true; }
        int wgid = (int)L; { const int q = nwg / NXCD, r = nwg % NXCD, xcd = wgid % NXCD, off = wgid / NXCD; wgid = (xcd < r ? xcd * (q + 1) : r * (q + 1) + (xcd - r) * q) + off; }
        const int nig = WGM * nN, gid = wgid / nig, fm = gid * WGM, gsz = (nM - fm) < WGM ? (nM - fm) : WGM;
        u.pm = pm0 + fm + ((wgid % nig) % gsz); u.pn = (wgid % nig) / gsz; u.z = z; return true;
    }
    __device__ __forceinline__ unsigned ptrA(const Unit& u) const { return (u.z ? A1 : A0) + (unsigned)u.pm * tstep; }
    __device__ __forceinline__ unsigned ptrB(const Unit& u) const { return (u.z ? B1 : B0) + (unsigned)u.pn * tstep; }
};

typedef __bf16 bf16v2_t __attribute__((ext_vector_type(2)));
typedef float f32v2_t __attribute__((ext_vector_type(2)));
__device__ __forceinline__ unsigned cvt_pk_bf16(float lo, float hi) { const bf16v2_t r = __builtin_convertvector((f32v2_t){lo, hi}, bf16v2_t); return __builtin_bit_cast(unsigned, r); }
__device__ __forceinline__ u32x4 pack8(const f32x4 a, const f32x4 b) { u32x4 w; w.x = cvt_pk_bf16(a[0], a[1]); w.y = cvt_pk_bf16(a[2], a[3]); w.z = cvt_pk_bf16(b[0], b[1]); w.w = cvt_pk_bf16(b[2], b[3]); return w; }
__device__ __forceinline__ float bf_lo(unsigned w) { return __uint_as_float(w << 16); }
__device__ __forceinline__ float bf_hi(unsigned w) { return __uint_as_float(w & 0xffff0000u); }
__device__ __forceinline__ float sigmoid_f(float v) { return __builtin_amdgcn_rcpf(1.0f + __builtin_amdgcn_exp2f(-1.4426950408889634f * v)); }
__device__ __forceinline__ f32x4 sigmoid4(f32x4 v) { return (f32x4){sigmoid_f(v[0]), sigmoid_f(v[1]), sigmoid_f(v[2]), sigmoid_f(v[3])}; }
__device__ __forceinline__ f32x4 silu4(f32x4 v) { return v * sigmoid4(v); }


constexpr size_t OUT_Y = 0, OUT_KP = 41943040, OUT_VP = 58720256, OUT_CP = 75497472, OUT_KS = 75513856, OUT_VS = 79708160, OUT_CS = 83902464, OUT_TOTAL = 84033536;
constexpr float QSCALE = 0.08838834764831845f * 1.4426950408889634f;

typedef unsigned u32x2 __attribute__((ext_vector_type(2)));
__device__ __forceinline__ float clamp8(float v) { return __builtin_amdgcn_fmed3f(v, -448.0f, 448.0f); }
__device__ __forceinline__ unsigned cvt4_fp8(const f32x4 a) { unsigned w = __builtin_amdgcn_cvt_pk_fp8_f32(clamp8(a[0]), clamp8(a[1]), 0, false); return __builtin_amdgcn_cvt_pk_fp8_f32(clamp8(a[2]), clamp8(a[3]), w, true); }
__device__ __forceinline__ u32x2 pack8_fp8(const f32x4 a, const f32x4 b) { u32x2 w; w.x = cvt4_fp8(a); w.y = cvt4_fp8(b); return w; }
constexpr float SC_WIN = 64.f, SC_WAB = 64.f, SC_WO = 128.f, SC_Y = 4.f, SC_MG = 8.f;

struct EpiProjB {
    static constexpr bool PERM = true, AFTER_DRAIN = false;
    const float* bias;
    bf16_t *K, *V;
    float* out;
    unsigned* sig;
    __device__ __forceinline__ unsigned* sig_ptr(const Unit& u) const { return (sig != nullptr && u.z == 0 && u.pm < 32) ? sig + 16 * (u.pm >> 3) : nullptr; }
    __device__ __forceinline__ void operator()(const f32x4 (&acc)[2][2][4][2], const Unit& u, int wr, int wc, int fr, int fq) const {
        const int pn = u.pn, cl = wc * 32 + 8 * fq;
        if (u.z == 0) {
            const int row0 = u.pm * BM + wr * 64 + fr;
            const bool isv = pn >= 8; const int c0 = (pn & 7) * BM + cl;
            const float* bp = bias + (isv ? 4096 : 2048) + c0;
            f32x4 bv[2][2];
#pragma unroll
            for (int bj = 0; bj < 2; ++bj)
#pragma unroll
                for (int n = 0; n < 2; ++n) bv[bj][n] = *(const f32x4*)(bp + bj * HALF + 4 * n);
            bf16_t* B = isv ? V : K;
            float* O = (u.pm < 32) ? out + (isv ? OUT_VP : OUT_KP) : out + (isv ? OUT_VS : OUT_KS) - (size_t)8192 * 2048;
#pragma unroll
            for (int ai = 0; ai < 2; ++ai)
#pragma unroll
                for (int m = 0; m < 4; ++m) { const size_t ro = (size_t)(row0 + ai * HALF + m * 16) * 2048 + c0;
#pragma unroll
                    for (int bj = 0; bj < 2; ++bj) { const f32x4 v0 = acc[ai][bj][m][0] + bv[bj][0], v1 = acc[ai][bj][m][1] + bv[bj][1];
                        *(u32x4*)(B + ro + bj * HALF) = pack8(v0, v1); *(f32x4*)(O + ro + bj * HALF) = v0; *(f32x4*)(O + ro + bj * HALF + 4) = v1; } }
        } else {
            const int ch = pn * HALF + cl;
            f32x4 bc[2], bh[2];
#pragma unroll
            for (int n = 0; n < 2; ++n) { bc[n] = *(const f32x4*)(bias + 10240 + ch + 4 * n); bh[n] = *(const f32x4*)(bias + 12288 + ch + 4 * n); }
#pragma unroll
            for (int ai = 0; ai < 1; ++ai)
#pragma unroll
                for (int m = 0; m < 4; ++m) { const int row = wr * 64 + m * 16 + fr;
                    if (row < 72) { float* cp = (row < 8) ? out + OUT_CP + (size_t)row * 2048 + ch : out + OUT_CS + (size_t)(row - 8) * 2048 + ch;
                        *(f32x4*)cp = (acc[0][0][m][0] + bc[0]) * (acc[0][1][m][0] + bh[0]); *(f32x4*)(cp + 4) = (acc[0][0][m][1] + bc[1]) * (acc[0][1][m][1] + bh[1]); } }
        }
    }
};

struct EpiProj8 {
    static constexpr bool PERM = true, AFTER_DRAIN = false;
    const float* bias;
    bf16_t *Q, *SZA, *U, *GT, *SGA, *SGB;
    unsigned* sig;
    __device__ __forceinline__ unsigned* sig_ptr(const Unit& u) const { return (sig != nullptr && u.pn < 16 && u.pm < 32) ? sig + 16 * (u.pm >> 3) : nullptr; }
    __device__ __forceinline__ void operator()(const f32x4 (&acc)[2][2][4][2], const Unit& u, int wr, int wc, int fr, int fq) const {
        const int pn = u.pn, row0 = u.pm * BM + wr * 64 + fr, cl = wc * 32 + 8 * fq;
        constexpr float DS = 1.0f / SC_WIN;
        if (pn >= 16 && pn < 32) {
            const int ch = (pn - 16) * HALF + cl;
            f32x4 bc[2], bh[2];
#pragma unroll
            for (int n = 0; n < 2; ++n) { bc[n] = *(const f32x4*)(bias + 10240 + ch + 4 * n); bh[n] = *(const f32x4*)(bias + 12288 + ch + 4 * n); }
#pragma unroll
            for (int ai = 0; ai < 2; ++ai)
#pragma unroll
                for (int m = 0; m < 4; ++m) { const int row = row0 + ai * HALF + m * 16;
                    *(u32x4*)(U + (size_t)row * 2048 + ch) = pack8((acc[ai][0][m][0] * DS + bc[0]) * (acc[ai][1][m][0] * DS + bh[0]), (acc[ai][0][m][1] * DS + bc[1]) * (acc[ai][1][m][1] * DS + bh[1])); }
        } else if (pn >= 32 && pn < 48) {
            const int ch = (pn - 32) * HALF + cl;
            f32x4 bb[2], bz[2];
#pragma unroll
            for (int n = 0; n < 2; ++n) { bb[n] = *(const f32x4*)(bias + 8192 + ch + 4 * n); bz[n] = *(const f32x4*)(bias + 14336 + ch + 4 * n); }
#pragma unroll
            for (int ai = 0; ai < 2; ++ai)
#pragma unroll
                for (int m = 0; m < 4; ++m) { const int row = row0 + ai * HALF + m * 16;
                    const f32x4 g0 = (acc[ai][0][m][0] * DS + bb[0]) * silu4(acc[ai][1][m][0] * DS + bz[0]), g1 = (acc[ai][0][m][1] * DS + bb[1]) * silu4(acc[ai][1][m][1] * DS + bz[1]);
                    *(u32x4*)(GT + (size_t)row * 2048 + ch) = pack8(g0, g1); }
        } else {
            int kind, c0, ld, sb; bf16_t* B;
            if (pn < 8) { kind = 0; c0 = pn * BM + cl; sb = c0; ld = 2048; B = Q; }
            else if (pn < 16) { kind = 1; c0 = (pn - 8) * BM + cl; sb = 6144 + c0; ld = 2048; B = SZA; }
            else if (pn < 64) { kind = 2; c0 = (pn - 48) * BM + cl; sb = 16384 + c0; ld = 4096; B = SGA; }
            else { kind = 2; c0 = (pn - 64) * BM + cl; sb = 20480 + c0; ld = 4096; B = SGB; }
            f32x4 bv[2][2];
#pragma unroll
            for (int bj = 0; bj < 2; ++bj)
#pragma unroll
                for (int n = 0; n < 2; ++n) bv[bj][n] = *(const f32x4*)(bias + sb + bj * HALF + 4 * n);
#pragma unroll
            for (int ai = 0; ai < 2; ++ai)
#pragma unroll
                for (int m = 0; m < 4; ++m) { bf16_t* rowp = B + (size_t)(row0 + ai * HALF + m * 16) * ld + c0;
#pragma unroll
                    for (int bj = 0; bj < 2; ++bj) { f32x4 v0 = acc[ai][bj][m][0] * DS + bv[bj][0], v1 = acc[ai][bj][m][1] * DS + bv[bj][1];
                        if (kind == 0) { v0 = v0 * QSCALE; v1 = v1 * QSCALE; } else if (kind == 1) { v0 = silu4(v0); v1 = silu4(v1); } else { v0 = sigmoid4(v0); v1 = sigmoid4(v1); }
                        *(u32x4*)(rowp + bj * HALF) = pack8(v0, v1); } }
        }
    }
};

__device__ __forceinline__ f32x4 bf4_lo(const u32x4 w) { return (f32x4){bf_lo(w.x), bf_hi(w.x), bf_lo(w.y), bf_hi(w.y)}; }
__device__ __forceinline__ f32x4 bf4_hi(const u32x4 w) { return (f32x4){bf_lo(w.z), bf_hi(w.z), bf_lo(w.w), bf_hi(w.w)}; }
struct EpiMerge {
    static constexpr bool PERM = true, AFTER_DRAIN = false;
    const bf16_t *SGA, *SGB; bf16_t* M1; unsigned char* MG8; __amdgpu_buffer_rsrc_t wsr; unsigned offMG8;
    unsigned* sig;
    __device__ __forceinline__ unsigned* sig_ptr(const Unit& u) const { return (sig != nullptr && u.z == 1) ? sig + 16 * u.pm : nullptr; }
    __device__ __forceinline__ void operator()(const f32x4 (&acc)[2][2][4][2], const Unit& u, int wr, int wc, int fr, int fq) const {
        const int row0 = u.pm * BM + wr * 64 + fr, col0 = u.pn * BM + wc * 32 + 8 * fq;
        const bf16_t* SG = u.z ? SGB : SGA;
        constexpr float DS = 1.0f / (SC_Y * SC_WAB);
#pragma unroll
        for (int ai = 0; ai < 2; ++ai) {
            u32x4 g[4][2], mv[4][2];
#pragma unroll
            for (int m = 0; m < 4; ++m)
#pragma unroll
                for (int bj = 0; bj < 2; ++bj) { const size_t ro = (size_t)(row0 + ai * HALF + m * 16) * 4096 + col0 + bj * HALF;
                    g[m][bj] = *(const u32x4*)(SG + ro); if (u.z) mv[m][bj] = *(const u32x4*)(M1 + ro); }
#pragma unroll
            for (int m = 0; m < 4; ++m)
#pragma unroll
                for (int bj = 0; bj < 2; ++bj) { const size_t ro = (size_t)(row0 + ai * HALF + m * 16) * 4096 + col0 + bj * HALF;
                    f32x4 v0 = acc[ai][bj][m][0] * DS * bf4_lo(g[m][bj]), v1 = acc[ai][bj][m][1] * DS * bf4_hi(g[m][bj]);
                    if (u.z == 0) *(u32x4*)(M1 + ro) = pack8(v0, v1);
                    else { v0 = v0 + bf4_lo(mv[m][bj]); v1 = v1 + bf4_hi(mv[m][bj]); __builtin_amdgcn_raw_buffer_store_b64(pack8_fp8(v0 * SC_MG, v1 * SC_MG), wsr, (int)(offMG8 + (unsigned)ro), 0, 16  ); } }
        }
    }
};

struct EpiOut {
    static constexpr bool PERM = true, AFTER_DRAIN = false;
    const bf16_t* XB; bf16_t* PRE; float alpha;
    __device__ __forceinline__ void operator()(const f32x4 (&acc)[2][2][4][2], const Unit& u, int wr, int wc, int fr, int fq) const {
        const int row0 = u.pm * BM + wr * 64 + fr, col0 = u.pn * BM + wc * 32 + 8 * fq;
        constexpr float DS = 1.0f / (SC_MG * SC_WO);
#pragma unroll
        for (int ai = 0; ai < 2; ++ai) {
            u32x4 xv[4][2];
#pragma unroll
            for (int m = 0; m < 4; ++m)
#pragma unroll
                for (int bj = 0; bj < 2; ++bj) xv[m][bj] = *(const u32x4*)(XB + (size_t)(row0 + ai * HALF + m * 16) * 4096 + col0 + bj * HALF);
#pragma unroll
            for (int m = 0; m < 4; ++m)
#pragma unroll
                for (int bj = 0; bj < 2; ++bj) { const size_t ro = (size_t)(row0 + ai * HALF + m * 16) * 4096 + col0 + bj * HALF;
                    *(u32x4*)(PRE + ro) = pack8(bf4_lo(xv[m][bj]) * alpha + acc[ai][bj][m][0] * DS, bf4_hi(xv[m][bj]) * alpha + acc[ai][bj][m][1] * DS); }
        }
    }
};

typedef int v8i_t __attribute__((ext_vector_type(8)));
struct Dyn { unsigned* ctr; int x, first, base; volatile PG8_LAS unsigned* slot; unsigned* once; int once_k; };
template <class T> struct has_sig { static constexpr bool v = false; };
template <> struct has_sig<EpiMerge> { static constexpr bool v = true; };

template <class Epi, bool ALIGN_EPI = false, bool SP2 = false, bool F8 = false, bool DYN = false>
__device__ __forceinline__ void gemm_phase(PG8_LAS unsigned char* lds, const int wave_sgpr, const __amdgpu_buffer_rsrc_t rsrc, const int LDb, const int Kb, const Sched& S, const Epi& E, const Dyn D = Dyn{nullptr, 0, 0, 0, nullptr, nullptr, 0}) {
    int lane_ = (int)__builtin_amdgcn_mbcnt_hi(~0u, __builtin_amdgcn_mbcnt_lo(~0u, 0u)); asm volatile("" : "+v"(lane_));
    const int wid = wave_sgpr, lane = lane_, tid = wid * 64 + lane, wr = wid >> 2, wc = wid & 3, fr = lane & 15, fq = lane >> 4;
    const int nt = Kb / 128;
    unsigned voffA[2], voffB[2];
#pragma unroll
    for (int i = 0; i < 2; ++i) { int R, C; stage_rc(tid * 16 + i * 8192, R, C); const int Rb = Epi::PERM ? ((R & ~31) + perm32(R & 31)) : R;
        voffA[i] = (unsigned)(R * LDb + C * 2); voffB[i] = (unsigned)(Rb * LDb + C * 2); }
    const unsigned kstep = 128u;
    const unsigned hstep = (unsigned)(HALF * LDb);
    const unsigned ldsw = (unsigned)wid * 1024u;
    constexpr int KOFF = 1024;
    const int aoff = lds_byte(wr * 64 + fr, fq * 8), boff = lds_byte(wc * 32 + fr, fq * 8);
#define PG8_SA(b, h) (((b) * 2 + (h)) * HTB)
#define PG8_SB(b, h) ((4 + (b) * 2 + (h)) * HTB)
#define PG8_STAGE(bufoff, gbase, voff) do { _Pragma("unroll") for (int _i = 0; _i < 2; ++_i) \
        __builtin_amdgcn_raw_ptr_buffer_load_lds(rsrc, (PG8_LAS void*)(lds + (bufoff) + ldsw + _i * 8192), 16, (int)(voff)[_i], (int)(gbase), 0, 0); } while (0)
#define PG8_LDA(dst, b, h) do { _Pragma("unroll") for (int m = 0; m < 4; ++m) _Pragma("unroll") for (int k = 0; k < 2; ++k) dst[m][k] = *(const PG8_LAS bf16x8*)(lds + PG8_SA(b, h) + aoff + m * 2048 + k * KOFF); } while (0)
#define PG8_LDB(dst, b, h) do { _Pragma("unroll") for (int n = 0; n < 2; ++n) _Pragma("unroll") for (int k = 0; k < 2; ++k) dst[n][k] = *(const PG8_LAS bf16x8*)(lds + PG8_SB(b, h) + boff + n * 2048 + k * KOFF); } while (0)
#define PG8_MMA(ai, bj, At, Bt) do { __builtin_amdgcn_s_setprio(1); _Pragma("unroll") for (int m = 0; m < 4; ++m) _Pragma("unroll") for (int n = 0; n < 2; ++n) { \
        if constexpr (F8) { typedef int v4i_t __attribute__((ext_vector_type(4))); \
            const v8i_t pa = __builtin_shufflevector(__builtin_bit_cast(v4i_t, At[m][0]), __builtin_bit_cast(v4i_t, At[m][1]), 0, 1, 2, 3, 4, 5, 6, 7); \
            const v8i_t pb = __builtin_shufflevector(__builtin_bit_cast(v4i_t, Bt[n][0]), __builtin_bit_cast(v4i_t, Bt[n][1]), 0, 1, 2, 3, 4, 5, 6, 7); \
            acc[ai][bj][m][n] = __builtin_amdgcn_mfma_scale_f32_16x16x128_f8f6f4(pb, pa, acc[ai][bj][m][n], 0, 0, 0, 0, 0, 0); } \
        else { _Pragma("unroll") for (int k = 0; k < 2; ++k) acc[ai][bj][m][n] = __builtin_amdgcn_mfma_f32_16x16x32_bf16(Bt[n][k], At[m][k], acc[ai][bj][m][n], 0, 0, 0); } } \
        __builtin_amdgcn_s_setprio(0); } while (0)
#define PG8_WAIT_V(n) asm volatile("s_waitcnt vmcnt(" #n ")" ::: "memory")
#define PG8_WAIT_L(n) asm volatile("s_waitcnt lgkmcnt(" #n ")" ::: "memory")
#define PG8_BAR __builtin_amdgcn_s_barrier()
#define PG8_SCHED __builtin_amdgcn_sched_barrier(0)
    Unit cur, nxt; int ui = 0; bool once_done = false;
    if constexpr (DYN) {
        if (!S.at((long)D.first * NXCD + D.x, cur)) return;
        if (wid == 0) { if (lane == 0) { const unsigned t = __hip_atomic_fetch_add(D.ctr, 1u, __ATOMIC_RELAXED, __HIP_MEMORY_SCOPE_AGENT) + (unsigned)D.base; *D.slot = t; } asm volatile("s_waitcnt lgkmcnt(0)" ::: "memory"); }
        __builtin_amdgcn_s_barrier();
    } else { if (!S.next(0, cur)) return; }
    f32x4 acc[2][2][4][2];
#pragma unroll
    for (int a = 0; a < 2; ++a)
#pragma unroll
        for (int b = 0; b < 2; ++b)
#pragma unroll
            for (int m = 0; m < 4; ++m)
#pragma unroll
                for (int n = 0; n < 2; ++n) acc[a][b][m][n] = (f32x4){0.f, 0.f, 0.f, 0.f};
    bf16x8 At[4][2], B0[2][2], B1[2][2];
    unsigned cA = S.ptrA(cur), cB = S.ptrB(cur);
    if constexpr (SP2) {
        PG8_STAGE(PG8_SB(0, 0), cB, voffB); PG8_STAGE(PG8_SB(0, 1), cB + hstep, voffB); PG8_STAGE(PG8_SA(0, 0), cA, voffA); PG8_STAGE(PG8_SA(0, 1), cA + hstep, voffA);
        if (wr == 1) PG8_BAR;
        PG8_WAIT_V(2); PG8_BAR;
        PG8_STAGE(PG8_SB(1, 0), cB + kstep, voffB); PG8_STAGE(PG8_SA(1, 0), cA + kstep, voffA); PG8_STAGE(PG8_SB(1, 1), cB + hstep + kstep, voffB);
        PG8_WAIT_V(6); PG8_BAR;
    } else {
        PG8_STAGE(PG8_SB(0, 0), cB, voffB); PG8_STAGE(PG8_SA(0, 0), cA, voffA); PG8_STAGE(PG8_SB(0, 1), cB + hstep, voffB); PG8_STAGE(PG8_SA(0, 1), cA + hstep, voffA);
        if (wr == 1) PG8_BAR;
        PG8_WAIT_V(4); PG8_BAR;
        PG8_STAGE(PG8_SB(1, 0), cB + kstep, voffB); PG8_STAGE(PG8_SA(1, 0), cA + kstep, voffA); PG8_STAGE(PG8_SB(1, 1), cB + hstep + kstep, voffB);
        PG8_WAIT_V(6); PG8_BAR;
    }
    for (;;) {
        bool has_next;
        unsigned tn = 0;
        if constexpr (DYN) { tn = (unsigned)__builtin_amdgcn_readfirstlane((int)*D.slot); has_next = S.at((long)tn * NXCD + D.x, nxt); }
        else has_next = S.next(ui + 1, nxt);
        const unsigned nA = has_next ? S.ptrA(nxt) : cA, nB = has_next ? S.ptrB(nxt) : cB;
        for (int t = 0; t < nt; t += 2) {
            const bool last = (t == nt - 2);
            const unsigned a1 = cA + (unsigned)(t + 1) * kstep;
            const unsigned a2 = last ? nA : cA + (unsigned)(t + 2) * kstep, b2 = last ? nB : cB + (unsigned)(t + 2) * kstep;
            const unsigned a3 = a2 + kstep, b3 = b2 + kstep;
            if constexpr (SP2) {
            PG8_LDB(B0, 0, 0); PG8_LDB(B1, 0, 1); PG8_SCHED; PG8_LDA(At, 0, 0); PG8_STAGE(PG8_SA(1, 1), a1 + hstep, voffA);
            PG8_WAIT_V(8); PG8_WAIT_L(0); PG8_BAR; PG8_MMA(0, 0, At, B0); PG8_MMA(0, 1, At, B1); PG8_BAR; PG8_SCHED;
            PG8_LDA(At, 0, 1); PG8_STAGE(PG8_SB(0, 0), b2, voffB); PG8_STAGE(PG8_SB(0, 1), b2 + hstep, voffB); PG8_STAGE(PG8_SA(0, 0), a2, voffA);
            PG8_WAIT_V(8); PG8_WAIT_L(0); PG8_BAR; PG8_MMA(1, 0, At, B0); PG8_MMA(1, 1, At, B1); PG8_BAR; PG8_SCHED;
            PG8_LDB(B0, 1, 0); PG8_LDB(B1, 1, 1); PG8_SCHED; PG8_LDA(At, 1, 0); PG8_STAGE(PG8_SA(0, 1), a2 + hstep, voffA);
            PG8_WAIT_V(8); PG8_WAIT_L(0); PG8_BAR; PG8_MMA(0, 0, At, B0); PG8_MMA(0, 1, At, B1); PG8_BAR; PG8_SCHED;
            PG8_LDA(At, 1, 1); PG8_STAGE(PG8_SB(1, 0), b3, voffB); PG8_STAGE(PG8_SB(1, 1), b3 + hstep, voffB); PG8_STAGE(PG8_SA(1, 0), a3, voffA);
            PG8_WAIT_V(8); PG8_WAIT_L(0); PG8_BAR; PG8_MMA(1, 0, At, B0); PG8_MMA(1, 1, At, B1); PG8_BAR; PG8_SCHED;
            } else {
            PG8_LDB(B0, 0, 0); PG8_SCHED; PG8_LDA(At, 0, 0); PG8_STAGE(PG8_SA(1, 1), a1 + hstep, voffA);
            PG8_WAIT_L(8); PG8_BAR; PG8_WAIT_L(0); PG8_MMA(0, 0, At, B0); PG8_BAR; PG8_SCHED;
            PG8_LDB(B1, 0, 1); PG8_STAGE(PG8_SB(0, 0), b2, voffB);
            PG8_BAR; PG8_WAIT_L(0); PG8_MMA(0, 1, At, B1); PG8_BAR;
            PG8_LDA(At, 0, 1); PG8_STAGE(PG8_SA(0, 0), a2, voffA);
            PG8_BAR; PG8_WAIT_L(0); PG8_MMA(1, 0, At, B0); PG8_BAR; PG8_SCHED;
            PG8_STAGE(PG8_SB(0, 1), b2 + hstep, voffB);
            PG8_WAIT_V(6); PG8_BAR; PG8_MMA(1, 1, At, B1); PG8_BAR;
            PG8_LDB(B0, 1, 0); PG8_SCHED; PG8_LDA(At, 1, 0); PG8_STAGE(PG8_SA(0, 1), a2 + hstep, voffA);
            PG8_WAIT_L(8); PG8_BAR; PG8_WAIT_L(0); PG8_MMA(0, 0, At, B0); PG8_BAR; PG8_SCHED;
            PG8_LDB(B1, 1, 1); PG8_STAGE(PG8_SB(1, 0), b3, voffB);
            PG8_BAR; PG8_WAIT_L(0); PG8_MMA(0, 1, At, B1); PG8_BAR;
            PG8_LDA(At, 1, 1); PG8_STAGE(PG8_SA(1, 0), a3, voffA);
            PG8_BAR; PG8_WAIT_L(0); PG8_MMA(1, 0, At, B0); PG8_BAR; PG8_SCHED;
            PG8_STAGE(PG8_SB(1, 1), b3 + hstep, voffB);
            PG8_WAIT_V(6); PG8_BAR; PG8_MMA(1, 1, At, B1); PG8_BAR;
            }
        }
        if constexpr (ALIGN_EPI) { if (wr == 0) PG8_BAR; }
        { int lz = (int)__builtin_amdgcn_mbcnt_hi(~0u, __builtin_amdgcn_mbcnt_lo(~0u, 0u)); asm volatile("" : "+v"(lz));
          unsigned tk2 = 0x7fffffffu;
          if constexpr (DYN) { if (has_next && wid == 0 && lz == 0) tk2 = __hip_atomic_fetch_add(D.ctr, 1u, __ATOMIC_RELAXED, __HIP_MEMORY_SCOPE_AGENT) + (unsigned)D.base; }
          E(acc, cur, wr, wc, lz & 15, lz >> 4);
          __builtin_amdgcn_s_waitcnt(0x0F70);
          if constexpr (DYN) { if (wid == 0) { int l2 = (int)__builtin_amdgcn_mbcnt_hi(~0u, __builtin_amdgcn_mbcnt_lo(~0u, 0u)); asm volatile("" : "+v"(l2)); if (l2 == 0) *D.slot = tk2; asm volatile("s_waitcnt lgkmcnt(0)" ::: "memory"); } } }
        if constexpr (DYN) {
            if (D.once != nullptr && !once_done && (!has_next || tn >= (unsigned)D.once_k)) {
                once_done = true;
                PG8_BAR;
                if (wid == 0) { int l4 = (int)__builtin_amdgcn_mbcnt_hi(~0u, __builtin_amdgcn_mbcnt_lo(~0u, 0u)); asm volatile("" : "+v"(l4));
                    if (l4 == 0) { __builtin_amdgcn_fence(__ATOMIC_RELEASE, "agent"); (void)__hip_atomic_fetch_add(D.once, 1u, __ATOMIC_RELAXED, __HIP_MEMORY_SCOPE_AGENT); } }
            }
        }
        if constexpr (has_sig<Epi>::v) {
            unsigned* const sp = E.sig_ptr(cur);
            if (sp != nullptr) {
                PG8_BAR;
                if (wid == 0) { int l3 = (int)__builtin_amdgcn_mbcnt_hi(~0u, __builtin_amdgcn_mbcnt_lo(~0u, 0u)); asm volatile("" : "+v"(l3));
                    if (l3 == 0) (void)__hip_atomic_fetch_add(sp, 1u, __ATOMIC_RELAXED, __HIP_MEMORY_SCOPE_AGENT); }
            }
        }
        if (!has_next) break;
#pragma unroll
        for (int a = 0; a < 2; ++a)
#pragma unroll
            for (int b = 0; b < 2; ++b)
#pragma unroll
                for (int m = 0; m < 4; ++m)
#pragma unroll
                    for (int n = 0; n < 2; ++n) acc[a][b][m][n] = (f32x4){0.f, 0.f, 0.f, 0.f};
        cur = nxt; cA = nA; cB = nB; ++ui;
        if constexpr (DYN) PG8_BAR;
        if constexpr (ALIGN_EPI) { if (wr == 1) PG8_BAR; }
    }
    PG8_WAIT_V(0);
    if constexpr (!ALIGN_EPI) { if (wr == 0) PG8_BAR; }
    PG8_BAR;
#undef PG8_SA
#undef PG8_SB
#undef PG8_STAGE
#undef PG8_LDA
#undef PG8_LDB
#undef PG8_MMA
#undef PG8_WAIT_V
#undef PG8_WAIT_L
#undef PG8_BAR
#undef PG8_SCHED
}
}

#ifndef PG8_SP2
#define PG8_SP2 true
#endif
#ifndef PG8_ALIGN
#define PG8_ALIGN true
#endif

namespace sbk {
#define SB_LAS __attribute__((address_space(3)))
typedef unsigned short bf16;
typedef short bf16x8 __attribute__((ext_vector_type(8)));
typedef short s16x4 __attribute__((ext_vector_type(4)));
typedef float f32x16 __attribute__((ext_vector_type(16)));
typedef float f32x4 __attribute__((ext_vector_type(4)));
typedef unsigned u32x4 __attribute__((ext_vector_type(4)));
constexpr int WAVE_LDS = 16384;
#define SB_KSWZ(row, colB) ((row) * 256 + ((colB) ^ (((row) & 7) << 4)))
__device__ __forceinline__ int v_st(int k, int c) { const int kk = (k & ~0xC) | ((k & 4) << 1) | ((k & 8) >> 1); return ((kk >> 3) * 4 + (c >> 5)) * 512 + ((kk & 7) * 32 + (c & 31)) * 2; }
__device__ __forceinline__ int v_rd_base(int lane) { return ((lane & 3) << 3) | (((lane >> 2) & 3) << 6) | (((lane >> 4) & 1) << 5) | (((lane >> 5) & 1) << 8); }
__device__ __forceinline__ int crow(int r, int hi) { return (r & 3) + 8 * (r >> 2) + 4 * hi; }
__device__ __forceinline__ unsigned cvtpk(float lo, float hi) { return pg8::cvt_pk_bf16(lo, hi); }
__device__ __forceinline__ bf16x8 pack8(f32x4 a, f32x4 b) { u32x4 w = {cvtpk(a[0], a[1]), cvtpk(a[2], a[3]), cvtpk(b[0], b[1]), cvtpk(b[2], b[3])}; return __builtin_bit_cast(bf16x8, w); }

struct Args { const bf16 *Q, *K, *V, *SZA; unsigned char* YA8; const float *ck, *cv; unsigned* queue; };

__device__ __forceinline__ void tile_compute(SB_LAS char* wl, const bf16x8 (&qr)[8], f32x16 (&o)[4], float& R, const bool diag, const int r32, const int hi, const unsigned vb0) {
    f32x16 p = {};
    { const SB_LAS char* kb[4];
#pragma unroll
      for (int dd = 0; dd < 4; ++dd) kb[dd] = wl + SB_KSWZ(r32, (dd * 16 + hi * 8) * 2);
#pragma unroll
      for (int d0 = 0; d0 < 8; ++d0) { const bf16x8 kf = *(const SB_LAS bf16x8*)(kb[d0 & 3] + (d0 >> 2) * 128); p = __builtin_amdgcn_mfma_f32_32x32x16_bf16(kf, qr[d0], p, 0, 0, 0); } }
    if (diag) {
        const float NEG = -__builtin_inff();
#pragma unroll
        for (int r = 0; r < 16; ++r) if (crow(r, hi) >= r32) p[r] = NEG;
    }
    float s[16];
#pragma unroll
    for (int r = 0; r < 16; ++r) { const float z = p[r]; s[r] = fmaxf(z, 0.f) + __builtin_amdgcn_logf(1.0f + __builtin_amdgcn_exp2f(-__builtin_fabsf(z))); }
#pragma unroll
    for (int g = 0; g < 4; ++g) { s[4 * g + 2] += s[4 * g + 3]; s[4 * g + 1] += s[4 * g + 2]; s[4 * g] += s[4 * g + 1]; }
    float E[4], O[4];
#pragma unroll
    for (int g = 0; g < 4; ++g) { auto rr = __builtin_amdgcn_permlane32_swap(__float_as_uint(s[4 * g]), __float_as_uint(s[4 * g]), false, false); E[g] = __uint_as_float(rr[0]); O[g] = __uint_as_float(rr[1]); }
    float T[8]; T[7] = 0.f; T[6] = O[3]; T[5] = T[6] + E[3]; T[4] = T[5] + O[2]; T[3] = T[4] + E[2]; T[2] = T[3] + O[1]; T[1] = T[2] + E[1]; T[0] = T[1] + O[0];
    const float total = T[0] + E[0];
#pragma unroll
    for (int g = 0; g < 4; ++g) { const float base = R + (hi ? T[2 * g + 1] : T[2 * g]);
#pragma unroll
        for (int j = 0; j < 4; ++j) { const int r = 4 * g + j; p[r] = __builtin_amdgcn_exp2f(p[r] - (base + s[r])); } }
    R += total;
    bf16x8 pa0, pa1;
#define SB_PK4(P, B_, OUT) do { unsigned a0 = cvtpk(P[B_+0], P[B_+1]), a1 = cvtpk(P[B_+2], P[B_+3]); unsigned b0 = cvtpk(P[B_+4], P[B_+5]), b1 = cvtpk(P[B_+6], P[B_+7]); \
        auto r0 = __builtin_amdgcn_permlane32_swap(a0, b0, false, false); auto r1 = __builtin_amdgcn_permlane32_swap(a1, b1, false, false); \
        u32x4 w = {r0[0], r1[0], r0[1], r1[1]}; OUT = __builtin_bit_cast(bf16x8, w); } while (0)
    SB_PK4(p, 0, pa0); SB_PK4(p, 8, pa1);
#undef SB_PK4
#define SB_TRRD(dst, off) asm volatile("ds_read_b64_tr_b16 %0, %1 offset:%2" : "=&v"(dst) : "v"(vb0), "i"(off) : "memory")
#pragma unroll
    for (int d0 = 0; d0 < 4; ++d0) {
        s16x4 l0, h0, l1, h1;
        if (d0 == 0) { SB_TRRD(l0, 0); SB_TRRD(h0, 2048); SB_TRRD(l1, 4096); SB_TRRD(h1, 6144); }
        else if (d0 == 1) { SB_TRRD(l0, 512); SB_TRRD(h0, 512 + 2048); SB_TRRD(l1, 512 + 4096); SB_TRRD(h1, 512 + 6144); }
        else if (d0 == 2) { SB_TRRD(l0, 1024); SB_TRRD(h0, 1024 + 2048); SB_TRRD(l1, 1024 + 4096); SB_TRRD(h1, 1024 + 6144); }
        else { SB_TRRD(l0, 1536); SB_TRRD(h0, 1536 + 2048); SB_TRRD(l1, 1536 + 4096); SB_TRRD(h1, 1536 + 6144); }
        asm volatile("s_waitcnt lgkmcnt(0)" ::: "memory"); __builtin_amdgcn_sched_barrier(0);
        o[d0] = __builtin_amdgcn_mfma_f32_32x32x16_bf16(pa0, (bf16x8){l0[0], l0[1], l0[2], l0[3], h0[0], h0[1], h0[2], h0[3]}, o[d0], 0, 0, 0);
        o[d0] = __builtin_amdgcn_mfma_f32_32x32x16_bf16(pa1, (bf16x8){l1[0], l1[1], l1[2], l1[3], h1[0], h1[1], h1[2], h1[3]}, o[d0], 0, 0, 0);
    }
#undef SB_TRRD
}

constexpr int N_SAMPLE_UNITS = 32 * 16 * 2, N_PROMPT_UNITS = 4 * 16 * 64, N_UNITS = N_SAMPLE_UNITS + N_PROMPT_UNITS;
constexpr float PRUNE_LOG2 = 160.0f;

__device__ __forceinline__ void unit(const Args& A, const int id, SB_LAS char* wl, const int lane_in) {
    int lane = lane_in; asm volatile("" : "+v"(lane));
    const int r32 = lane & 31, hi = lane >> 5;
    const unsigned vb0 = (unsigned)(size_t)(wl + 8192) + (unsigned)v_rd_base(lane);
    int qrow0, h, nt_new, nt_cache, b; int krow0;
    if (id < N_SAMPLE_UNITS) { b = id >> 5; h = (id >> 1) & 15; const int half = id & 1; qrow0 = 8192 + b * 64 + half * 32; krow0 = 8192 + b * 64; nt_new = half + 1; nt_cache = 32; }
    else { const int j = id - N_SAMPLE_UNITS; const int g = 7 - (j >> 9), bh = (j & 511) >> 3, qb = g * 8 + (j & 7); b = bh >> 4; h = bh & 15; qrow0 = b * 2048 + qb * 32; krow0 = b * 2048; nt_new = qb + 1; nt_cache = 0; }
    bf16x8 qr[8];
#pragma unroll
    for (int d0 = 0; d0 < 8; ++d0) qr[d0] = *(const bf16x8*)(A.Q + (size_t)(qrow0 + r32) * 2048 + h * 128 + d0 * 16 + hi * 8);
    f32x16 o[4] = {}; float R = 0.f;
    const int NT = nt_new + nt_cache, srow = lane >> 4, sch = lane & 15;
    f32x4 raw[16];
    const unsigned lb16 = (unsigned)(srow * 2048 + sch * 8) * 2u, lb32 = lb16 * 2u;
    SB_LAS char* const kst0 = wl + SB_KSWZ(srow, sch * 16);
    SB_LAS char* const kst1 = wl + SB_KSWZ(4 + srow, sch * 16);
    SB_LAS char* const vst = wl + 8192 + ((sch * 8) >> 5) * 512 + srow * 64 + ((sch * 8) & 31) * 2;
#define SB_VOFF(i) ((((i) & 1) * 2048) + (((i) >> 2) * 4096) + ((((i) >> 1) & 1) * 256))
#define SB_KV_BF16(idx_) ((size_t)(krow0 + 32 * (nt_new - 1 - (idx_))) * 2048 + h * 128)
#define SB_KV_F32(idx_) (((size_t)(b * 1024 + 32 * (nt_cache - 1 - ((idx_) - nt_new))) * 16 + h) * 128)
#define SB_LD_BF16(idx_) do { const char* kt_ = (const char*)(A.K + SB_KV_BF16(idx_)); const char* vt_ = (const char*)(A.V + SB_KV_BF16(idx_)); _Pragma("unroll") for (int i = 0; i < 8; ++i) { \
        raw[i] = *(const f32x4*)(kt_ + (size_t)i * 16384 + lb16); raw[8 + i] = *(const f32x4*)(vt_ + (size_t)i * 16384 + lb16); } } while (0)
#define SB_LD_F32(P_, idx_) do { const char* t_ = (const char*)((P_) + SB_KV_F32(idx_)); _Pragma("unroll") for (int i = 0; i < 8; ++i) { \
        raw[2 * i] = *(const f32x4*)(t_ + (size_t)i * 32768 + lb32); raw[2 * i + 1] = *(const f32x4*)(t_ + (size_t)i * 32768 + lb32 + 16); } } while (0)
    bool live = true;
    if (live) SB_LD_BF16(0);
#pragma clang loop unroll(disable)
    for (int idx = 0; idx < NT && live; ++idx) {
        if (idx < nt_new) {
#pragma unroll
            for (int i = 0; i < 8; ++i) { *(SB_LAS f32x4*)(((i & 1) ? kst1 : kst0) + (i & ~1) * 1024) = raw[i]; *(SB_LAS f32x4*)(vst + SB_VOFF(i)) = raw[8 + i]; }
        } else {
#pragma unroll
            for (int i = 0; i < 8; ++i) *(SB_LAS bf16x8*)(((i & 1) ? kst1 : kst0) + (i & ~1) * 1024) = pack8(raw[2 * i], raw[2 * i + 1]);
            SB_LD_F32(A.cv, idx);
#pragma unroll
            for (int i = 0; i < 8; ++i) *(SB_LAS bf16x8*)(vst + SB_VOFF(i)) = pack8(raw[2 * i], raw[2 * i + 1]);
        }
        if (idx + 1 < NT) { if (idx + 1 < nt_new) SB_LD_BF16(idx + 1); else SB_LD_F32(A.ck, idx + 1); }
        tile_compute(wl, qr, o, R, idx == 0, r32, hi, vb0);
        if (SB_PRUNE) live = !__all(R > PRUNE_LOG2);
    }
#undef SB_VOFF
#undef SB_KV_BF16
#undef SB_KV_F32
#undef SB_LD_BF16
#undef SB_LD_F32
    asm volatile("s_waitcnt lgkmcnt(0)" ::: "memory");
    int lz = lane; asm volatile("" : "+v"(lz));
    { SB_LAS char* ob = wl + ((lz >> 5) * 4 * 128 + (lz & 31)) * 4;
#pragma unroll
      for (int d0 = 0; d0 < 4; ++d0)
#pragma unroll
        for (int r = 0; r < 16; ++r) *(SB_LAS float*)(ob + (((r & 3) + 8 * (r >> 2)) * 128 + d0 * 32) * 4) = o[d0][r]; }
    asm volatile("s_waitcnt lgkmcnt(0)" ::: "memory");
    const int rr = lz >> 4, ch = lz & 15;
#pragma unroll
    for (int i = 0; i < 8; ++i) { const int q = 4 * i + rr;
        const f32x4 a = *(const SB_LAS f32x4*)(wl + (q * 128 + ch * 8) * 4), c = *(const SB_LAS f32x4*)(wl + (q * 128 + ch * 8 + 4) * 4);
        const size_t go = (size_t)(qrow0 + q) * 2048 + h * 128 + ch * 8;
        const u32x4 z = *(const u32x4*)(A.SZA + go);
        const f32x4 ya = a * (f32x4){pg8::bf_lo(z.x), pg8::bf_hi(z.x), pg8::bf_lo(z.y), pg8::bf_hi(z.y)}, yc = c * (f32x4){pg8::bf_lo(z.z), pg8::bf_hi(z.z), pg8::bf_lo(z.w), pg8::bf_hi(z.w)};
        *(pg8::u32x2*)(A.YA8 + go) = pg8::pack8_fp8(ya * pg8::SC_Y, yc * pg8::SC_Y); }
    asm volatile("s_waitcnt lgkmcnt(0)" ::: "memory");
}

__device__ __forceinline__ void attn_phase(const Args& A, SB_LAS char* lds, const int wave, const int lane, unsigned* queue, const int id0, const int n) {
    SB_LAS char* wl = lds + wave * WAVE_LDS;
    for (;;) {
        unsigned id = 0;
        if (lane == 0) id = __hip_atomic_fetch_add(queue, 1u, __ATOMIC_RELAXED, __HIP_MEMORY_SCOPE_AGENT);
        id = (unsigned)__builtin_amdgcn_readfirstlane((int)id);
        if (id >= (unsigned)n) break;
        unit(A, id0 + (int)id, wl, lane);
    }
}
}

constexpr int NWAVES = 8;
constexpr int N_LAUNCHES = MK_N_LAUNCHES;
constexpr int PER_PHASE = 6;

constexpr int DM = 4096, NIN = 24576, WB = 2048;
constexpr int MP = 8192, MS = 2048, M = MP + MS;
constexpr int NB16 = 4096, NF8 = 20480;
constexpr float LN_EPS = 1e-5f;
constexpr float DN_ALPHA = 1.189207115002721f;

constexpr size_t MiB = 1u << 20;
constexpr size_t WS_CTL = 0, CTL_ZERO_BYTES = 1 * MiB;
constexpr size_t WS_WINB = 1 * MiB;
constexpr size_t WS_WCH = WS_WINB + 32 * MiB;
constexpr size_t WS_XG = WS_WCH + 32 * MiB;
constexpr size_t WS_WIN8 = WS_XG + 2 * MiB;
constexpr size_t WS_WA8 = WS_WIN8 + 80 * MiB;
constexpr size_t WS_WB8 = WS_WA8 + 8 * MiB;
constexpr size_t WS_WO8 = WS_WB8 + 8 * MiB;
constexpr size_t WS_XB = WS_WO8 + 16 * MiB;
constexpr size_t WS_X8 = WS_XB + 80 * MiB;
constexpr size_t WS_Q = WS_X8 + 40 * MiB, WS_K = WS_Q + 40 * MiB, WS_V = WS_K + 40 * MiB, WS_SZA = WS_V + 40 * MiB, WS_U = WS_SZA + 40 * MiB, WS_GT = WS_U + 40 * MiB;
constexpr size_t WS_SGA = WS_GT + 40 * MiB, WS_SGB = WS_SGA + 80 * MiB;
constexpr size_t WS_YA8 = WS_SGB + 80 * MiB, WS_YB8 = WS_YA8 + 20 * MiB;
constexpr size_t WS_M1 = WS_YB8 + 20 * MiB;
constexpr size_t WS_MG8 = WS_M1 + 80 * MiB;
constexpr size_t WS_PRE = WS_MG8 + 40 * MiB;
constexpr size_t WS_END = WS_PRE + 80 * MiB;
static_assert(WS_END < (size_t)0x7fffffff, "every GEMM operand must be addressable as a 31-bit byte offset from the workspace base");
constexpr int CW_TMO = 0, CW_CODE = 1, CW_QUEUE = 64;
constexpr int CW_P1A = 1024, CW_P1B = 1536, CW_P0B = 2048, CW_PM = 2112, CW_QZ = 2752, CW_KV = 2816, CW_CONVQ = 128;
constexpr int CW_BAR = 4096;

constexpr int RING_OFF = 0, RING_BYTES = 131072;
constexpr int LDS_BYTES = 147456;
constexpr int LDSCTL_OFF = LDS_BYTES - 512, MISC_OFF = LDSCTL_OFF + 320;
constexpr int P0_WAVE_LDS = 128 * 33 * 4;
static_assert(8 * P0_WAVE_LDS <= LDSCTL_OFF, "LDS map");
static_assert(MISC_OFF + 128 <= LDS_BYTES, "LDS map");

#define GAS __attribute__((address_space(1)))
#define LAS __attribute__((address_space(3)))
typedef unsigned short bf16;
typedef unsigned v4u __attribute__((ext_vector_type(4)));
typedef unsigned v2u __attribute__((ext_vector_type(2)));
typedef float f32x4 __attribute__((ext_vector_type(4)));
typedef GAS unsigned gu32;
#define RLX_AGENT __ATOMIC_RELAXED, __HIP_MEMORY_SCOPE_AGENT
#define LDS_WAIT() asm volatile("s_waitcnt lgkmcnt(0)" ::: "memory")
#define VM_WAIT() asm volatile("s_waitcnt vmcnt(0)" ::: "memory")

#define XB_TMO      128
#define XB_XCNT(j)  (256  + 64 * (j))
#define XB_XSUB(j)  (1280 + 64 * (j))
#define XB_XGEN(j)  (2304 + 64 * (j))
#define XB_TOP      3328
#define XB_TOPGEN   3392
#define XCD_BAR_WORDS 3456
#define XB_SPIN_CAP (1u << 18)

__device__ __forceinline__ unsigned xb_ld(unsigned* p)              { return __hip_atomic_load(p, __ATOMIC_RELAXED, __HIP_MEMORY_SCOPE_AGENT); }
__device__ __forceinline__ unsigned xb_add(unsigned* p, unsigned v) { return __hip_atomic_fetch_add(p, v, __ATOMIC_RELAXED, __HIP_MEMORY_SCOPE_AGENT); }
__device__ __forceinline__ unsigned xb_xcc_id() { return (unsigned)__builtin_amdgcn_s_getreg((3 << 11) | 20) & 0xFu; }
#define XB_SPIN(cond, bar) do { unsigned _sp = 0; while (cond) { __builtin_amdgcn_s_sleep(1); \
    if ((++_sp & 255u) == 0u) { if (xb_ld(&(bar)[XB_TMO])) break; if (_sp > XB_SPIN_CAP) { atomicAdd(&(bar)[XB_TMO], 1u); break; } } } } while (0)

struct XcdBarrier {
    unsigned* bar; unsigned x;
    volatile LAS unsigned* st;
};
__device__ __forceinline__ XcdBarrier xcd_barrier_post(unsigned* bar, volatile LAS unsigned* st) {
    XcdBarrier b; b.bar = bar; b.x = xb_xcc_id(); b.st = st;
    if (threadIdx.x == 0) (void)xb_add(&bar[XB_XCNT(b.x)], 1u);
    return b;
}
__device__ __forceinline__ void xcd_barrier_complete(unsigned* bar, unsigned x, unsigned& nloc, unsigned& nx) {
    const unsigned G = gridDim.x * gridDim.y * gridDim.z;
    unsigned sum, cnt, mine, sp = 0u;
    for (;;) {
        sum = 0u; cnt = 0u; mine = 0u;
#pragma unroll
        for (unsigned j = 0; j < 16; ++j) { const unsigned c = xb_ld(&bar[XB_XCNT(j)]); sum += c; cnt += (c > 0u) ? 1u : 0u; mine = (j == x) ? c : mine; }
        if (sum == G) break;
        __builtin_amdgcn_s_sleep(1);
        if ((++sp & 255u) == 0u) { if (xb_ld(&bar[XB_TMO])) break; if (sp > XB_SPIN_CAP) { atomicAdd(&bar[XB_TMO], 1u); break; } }
    }
    nloc = mine > 0u ? mine : 1u; nx = cnt > 0u ? cnt : 1u;
}
__device__ __forceinline__ void xcd_barrier(const XcdBarrier& b) {
    asm volatile("s_waitcnt vmcnt(0)" ::: "memory");
    __syncthreads();
    if (threadIdx.x == 0) {
        unsigned* bar = b.bar;
        __builtin_amdgcn_s_waitcnt(0);
        unsigned nloc = b.st[0], nx = b.st[1];
        if (nloc == 0u) { xcd_barrier_complete(bar, b.x, nloc, nx); b.st[0] = nloc; b.st[1] = nx; }
        const unsigned old = xb_add(&bar[XB_XSUB(b.x)], 1u);
        const unsigned gen = old / nloc;
        if (old + 1u == (gen + 1u) * nloc) {
            __builtin_amdgcn_fence(__ATOMIC_RELEASE, "agent");
            asm volatile("s_waitcnt vmcnt(0)" ::: "memory");
            const unsigned og = xb_add(&bar[XB_TOP], 1u);
            const unsigned tg = og / nx;
            if (og + 1u == (tg + 1u) * nx) xb_add(&bar[XB_TOPGEN], 1u);
            else XB_SPIN(xb_ld(&bar[XB_TOPGEN]) == tg, bar);
            __builtin_amdgcn_fence(__ATOMIC_ACQUIRE, "agent");
            xb_add(&bar[XB_XGEN(b.x)], 1u);
            asm volatile("s_waitcnt vmcnt(0)" ::: "memory");
        } else {
            XB_SPIN(xb_ld(&bar[XB_XGEN(b.x)]) == gen, bar);
            __builtin_amdgcn_fence(__ATOMIC_ACQUIRE, "agent");
            asm volatile("s_waitcnt vmcnt(0)" ::: "memory");
        }
    }
    __syncthreads();
}

__device__ __forceinline__ float wave_sum(float v) {
#pragma unroll
    for (int o = 1; o < 64; o <<= 1) v += __shfl_xor(v, o);
    return v;
}
__device__ __forceinline__ void win_dest_row(int n, int& r8, int& r16, int& which) {
    r8 = -1; r16 = -1; which = 0;
    if (n < 2048) { r8 = n; return; }
    if (n < 4096) { r16 = n - 2048; return; }
    if (n < 6144) { r16 = 2048 + (n - 4096); return; }
    if (n < 8192) { r8 = 2048 + (n - 6144); return; }
    if (n < 16384) { const int sg = (n - 8192) >> 11, ch = (n - 8192) & 2047, i = ch >> 7, o = ch & 127;
        if (sg == 1 || sg == 2) { const int r = i * 256 + ((sg == 2) ? 128 : 0) + o; r8 = 4096 + r; r16 = r; which = 1; }
        else r8 = 8192 + i * 256 + ((sg == 3) ? 128 : 0) + o;
        return; }
    r8 = 12288 + (n - 16384);
}
struct P0Item { const float* src; int N, K, k0, n0, mode; unsigned char* dst; unsigned char* dstch; unsigned char* dst8; float scale; };
__device__ __forceinline__ void p0_load(const P0Item& d, f32x4 (&v)[16], int lane) {
    const int kr = lane >> 3, nq = lane & 7;
    const float* p = d.src + (size_t)(d.k0 + kr) * d.N + d.n0 + 4 * nq;
#pragma unroll
    for (int i = 0; i < 16; ++i) v[i] = __builtin_nontemporal_load((const f32x4*)(p + (size_t)(8 * i) * d.N));
}
__device__ __forceinline__ void p0_store(const P0Item& d, const f32x4 (&v)[16], LAS float* scr, int lane) {
    const int kr = lane >> 3, nq = lane & 7;
#pragma unroll
    for (int i = 0; i < 16; ++i) { LAS float* q = scr + (8 * i + kr) * 33 + 4 * nq; q[0] = v[i].x; q[1] = v[i].y; q[2] = v[i].z; q[3] = v[i].w; }
    LDS_WAIT(); asm volatile("" ::: "memory");
    const int c = lane & 15;
    int r8 = d.n0, r16 = -1, which = 0;
    if (d.mode == 2) win_dest_row(d.n0, r8, r16, which);
    bf16* const d16 = (bf16*)(which ? d.dstch : d.dst);
#pragma unroll
    for (int j = 0; j < 8; ++j) { const int n = (lane >> 4) + 4 * j; const LAS float* s = scr + (8 * c) * 33 + n;
        const f32x4 a = {s[0 * 33], s[1 * 33], s[2 * 33], s[3 * 33]}, b = {s[4 * 33], s[5 * 33], s[6 * 33], s[7 * 33]};
        if (r8 >= 0) *(GAS v2u*)(d.dst8 + (size_t)(r8 + n) * d.K + d.k0 + 8 * c) = pg8::pack8_fp8(a * d.scale, b * d.scale);
        if (r16 >= 0) *(GAS v4u*)(d16 + (size_t)(r16 + n) * d.K + d.k0 + 8 * c) = pg8::pack8(a, b); }
    LDS_WAIT(); asm volatile("" ::: "memory");
}

struct KArgs { const float* in[14]; float* out; unsigned char* ws; int ph_lo, ph_hi; };
typedef const KArgs __attribute__((address_space(4))) * KArgsPtr;
template <int SET> __device__ __forceinline__ P0Item p0_decode(int it, const float* w_in, const float* w_a, const float* w_b, const float* w_o, unsigned char* ws) {
    constexpr int KB = DM / 128, I_A = (WB / 128) * (DM / 32);
    P0Item d; int r = it, nb;
    d.src = w_in; d.N = NIN; d.K = DM; d.mode = 2; d.dst = ws + WS_WINB; d.dstch = ws + WS_WCH; d.dst8 = ws + WS_WIN8; d.scale = pg8::SC_WIN;
    if (SET == 0) { nb = r % 256; nb = nb < 128 ? 64 + nb : 320 + (nb - 128); d.k0 = 128 * (r / 256); d.n0 = 32 * nb; return d; }
    if (r < KB * 512) { nb = r % 512; nb = nb < 64 ? nb : nb < 192 ? 192 + (nb - 64) : 448 + (nb - 192); d.k0 = 128 * (r / 512); d.n0 = 32 * nb; return d; }
    r -= KB * 512; d.mode = 1; d.dst = nullptr; d.dstch = nullptr; d.N = DM;
    if (r < I_A) { d.src = w_a; d.K = WB; d.dst8 = ws + WS_WA8; d.scale = pg8::SC_WAB; }
    else if ((r -= I_A) < I_A) { d.src = w_b; d.K = WB; d.dst8 = ws + WS_WB8; d.scale = pg8::SC_WAB; }
    else { r -= I_A; d.src = w_o; d.K = DM; d.dst8 = ws + WS_WO8; d.scale = pg8::SC_WO; }
    d.k0 = 128 * (r / (DM / 32)); d.n0 = 32 * (r % (DM / 32)); return d;
}
template <int SET> __device__ __forceinline__ void p0_weights(KArgsPtr ap, unsigned char* ws, LAS float* scr, int lane, int w0, int wn) {
    constexpr int NITEMS = SET == 0 ? (DM / 128) * 256 : (DM / 128) * 512 + 2 * (WB / 128) * (DM / 32) + (DM / 128) * (DM / 32);
    const float *w_in = ap->in[5], *w_a = ap->in[9], *w_b = ap->in[10], *w_o = ap->in[11];
    f32x4 cur[16], nxt[16];
    int it = w0;
    if (it < NITEMS) { const P0Item d = p0_decode<SET>(it, w_in, w_a, w_b, w_o, ws); p0_load(d, cur, lane); }
    while (it < NITEMS) {
        const int itn = it + wn;
        if (itn < NITEMS) { const P0Item dn = p0_decode<SET>(itn, w_in, w_a, w_b, w_o, ws); p0_load(dn, nxt, lane); }
        { const P0Item d = p0_decode<SET>(it, w_in, w_a, w_b, w_o, ws); p0_store(d, cur, scr, lane); }
#pragma unroll
        for (int i = 0; i < 16; ++i) cur[i] = nxt[i];
        it = itn;
    }
}
template <int WHICH> __device__ __forceinline__ void p0_x(KArgsPtr ap, unsigned char* ws, size_t gt, size_t NT) {
    const float *x = ap->in[0], *xs = ap->in[1];
    const size_t NX = (size_t)M * DM / 16;
    for (size_t i0 = gt; i0 < NX; i0 += 4 * NT) {
        f32x4 a[4], b[4], c[4], d[4];
#pragma unroll
        for (int u = 0; u < 4; ++u) { const size_t i = i0 + u * NT; if (i < NX) { const size_t e = i * 16; const float* src = (e < (size_t)MP * DM) ? x + e : xs + (e - (size_t)MP * DM);
            a[u] = __builtin_nontemporal_load((const f32x4*)src); b[u] = __builtin_nontemporal_load((const f32x4*)(src + 4)); c[u] = __builtin_nontemporal_load((const f32x4*)(src + 8)); d[u] = __builtin_nontemporal_load((const f32x4*)(src + 12)); } }
#pragma unroll
        for (int u = 0; u < 4; ++u) { const size_t i = i0 + u * NT; if (i < NX) { const size_t e = i * 16;
            if (WHICH & 1) { *(pg8::u32x4*)((bf16*)(ws + WS_XB) + e) = pg8::pack8(a[u], b[u]); *(pg8::u32x4*)((bf16*)(ws + WS_XB) + e + 8) = pg8::pack8(c[u], d[u]); }
            if (WHICH & 2) { const pg8::u32x2 p = pg8::pack8_fp8(a[u], b[u]), q = pg8::pack8_fp8(c[u], d[u]); *(pg8::u32x4*)(ws + WS_X8 + e) = (pg8::u32x4){p.x, p.y, q.x, q.y}; } } }
    }
    if (WHICH & 1) {
        for (size_t i = gt; i < (size_t)256 * (DM / 8); i += NT) {
            const int row = (int)(i >> 9), c8 = (int)(i & 511) * 8;
            pg8::u32x4 w = {0u, 0u, 0u, 0u};
            if (row < 72) { const float* src = (row < 8) ? x + ((size_t)((row >> 1) * 2048 + 2046 + (row & 1))) * DM + c8 : xs + ((size_t)(((row - 8) >> 1) * 64 + 62 + (row & 1))) * DM + c8;
                w = pg8::pack8(*(const f32x4*)src, *(const f32x4*)(src + 4)); }
            *(pg8::u32x4*)((bf16*)(ws + WS_XG) + (size_t)row * DM + c8) = w;
        }
    }
}
#define PHASE_ARGS() KArgsPtr ap = (KArgsPtr)__builtin_amdgcn_kernarg_segment_ptr(); asm volatile("" : "+s"(ap)); unsigned char* const ws = ap->ws; \
    const __amdgpu_buffer_rsrc_t rsrc = __builtin_amdgcn_make_buffer_rsrc((void*)ws, 0, 0x7fffffff, 0x00020000)

__global__ void __launch_bounds__(NWAVES * 64, 2) mk_fwd(const KArgs args) {
    extern __shared__ __attribute__((aligned(16))) unsigned char lds_raw[];
    LAS unsigned char* const lds = (LAS unsigned char*)lds_raw;
    volatile LAS unsigned* const MISC = (volatile LAS unsigned*)(lds + MISC_OFF);
    const int wave = __builtin_amdgcn_readfirstlane((int)threadIdx.x >> 6);
#define LANE_TID() int lane = (int)__builtin_amdgcn_mbcnt_hi(~0u, __builtin_amdgcn_mbcnt_lo(~0u, 0u)); asm volatile("" : "+v"(lane)); const int tid = wave * 64 + lane; (void)tid
    int tid0 = threadIdx.x;
    const int G = gridDim.x, vcu = (G % 8 == 0) ? ((int)blockIdx.x % 8) * (G / 8) + (int)blockIdx.x / 8 : (int)blockIdx.x;
    gu32* const ctl = (gu32*)(args.ws + WS_CTL);
    for (int u = tid0; u < (LDS_BYTES - LDSCTL_OFF) / 4; u += NWAVES * 64) ((LAS unsigned*)(lds + LDSCTL_OFF))[u] = 0u;
    __syncthreads();
    XcdBarrier bar; bar.bar = (unsigned*)(ctl + CW_BAR); bar.x = 0; bar.st = nullptr;
    if (N_LAUNCHES != PER_PHASE) bar = xcd_barrier_post((unsigned*)(ctl + CW_BAR), MISC + 8);
#define GRID_BAR(seam) do { if (N_LAUNCHES == PER_PHASE) { if (threadIdx.x == 0) __hip_atomic_store(ctl + CW_TMO, 0xBADBA0u | (unsigned)(seam), RLX_AGENT); } else { xcd_barrier(bar); } } while (0)
    const int lo = args.ph_lo, hi = args.ph_hi;
#define IN(k) (lo <= (k) && (k) < hi)
#define BOTH(k) (IN(k) && IN((k) + 1))
    const int gw = vcu * NWAVES + wave, NGW = G * NWAVES;

    constexpr int NCX = 8;
    const bool dynp1 = (G == 32 * pg8::NXCD);
    const bool early_attn = dynp1 && (lo <= 1 && 2 < hi);
    if (IN(0)) {
        PHASE_ARGS(); (void)rsrc; LANE_TID();
        LAS float* scr = (LAS float*)(lds + wave * P0_WAVE_LDS);
        p0_weights<0>(ap, ws, scr, lane, gw, NGW);
        p0_x<3>(ap, ws, (size_t)blockIdx.x * (NWAVES * 64) + tid, (size_t)G * NWAVES * 64);
        if (!dynp1) p0_weights<1>(ap, ws, scr, lane, gw, NGW);
        if (BOTH(0)) GRID_BAR(0);
    }

    if (IN(1)) {
        if (dynp1) {
            const int xq = (int)blockIdx.x % pg8::NXCD, rho = (int)blockIdx.x / pg8::NXCD, NGX = 32 - NCX;
            gu32* const done = ctl + CW_P0B;
            if (rho >= NGX) {
                { PHASE_ARGS(); (void)rsrc; LANE_TID();
                  LAS float* scr = (LAS float*)(lds + wave * P0_WAVE_LDS);
                  const int cb = (rho - NGX) * pg8::NXCD + xq;
                  p0_weights<1>(ap, ws, scr, lane, cb * NWAVES + wave, NCX * pg8::NXCD * NWAVES); }
                asm volatile("s_waitcnt vmcnt(0)" ::: "memory");
                __syncthreads();
                { LANE_TID(); if (wave == 0 && lane == 0) { __builtin_amdgcn_fence(__ATOMIC_RELEASE, "agent"); asm volatile("s_waitcnt vmcnt(0)" ::: "memory"); (void)__hip_atomic_fetch_add(done, 1u, RLX_AGENT); } }
            } else {
                PHASE_ARGS();
                pg8::Sched S; S.init(M / 256, NB16 / 256, G, (int)blockIdx.x, 0, 0, WS_XB, WS_XG, WS_WINB, WS_WCH, DM * 2); S.nextra = 16;
                pg8::EpiProjB E{ap->in[6], (bf16*)(ws + WS_K), (bf16*)(ws + WS_V), ap->out, nullptr};
                const pg8::Dyn D{(unsigned*)(ctl + CW_P1A + 64 * xq), xq, rho, NGX, MISC + 16, nullptr, 0};
                pg8::gemm_phase<pg8::EpiProjB, PG8_ALIGN, PG8_SP2, false, true>(lds + RING_OFF, wave, rsrc, DM * 2, DM * 2, S, E, D);
            }
            { LANE_TID(); if (wave == 0 && lane == 0) { unsigned sp = 0; while (__hip_atomic_load(done, RLX_AGENT) < (unsigned)(NCX * pg8::NXCD)) { __builtin_amdgcn_s_sleep(4); if (++sp > (1u << 22)) break; }
                  __builtin_amdgcn_fence(__ATOMIC_ACQUIRE, "agent"); } }
            __syncthreads();
            { PHASE_ARGS();
              pg8::Sched S; S.init(M / 256, NF8 / 256, G, (int)blockIdx.x, 0, 0, WS_X8, WS_X8, WS_WIN8, WS_WIN8, DM);
              S.il = 1;
              pg8::EpiProj8 E{ap->in[6], (bf16*)(ws + WS_Q), (bf16*)(ws + WS_SZA), (bf16*)(ws + WS_U), (bf16*)(ws + WS_GT), (bf16*)(ws + WS_SGA), (bf16*)(ws + WS_SGB), nullptr};
              const pg8::Dyn D{(unsigned*)(ctl + CW_P1B + 64 * xq), xq, rho, 32, MISC + 16, early_attn ? (unsigned*)(ctl + CW_QZ) : nullptr, 320};
              pg8::gemm_phase<pg8::EpiProj8, PG8_ALIGN, PG8_SP2, true, true>(lds + RING_OFF, wave, rsrc, DM, DM, S, E, D); }
            if (early_attn) { LANE_TID(); if (wave == 0 && lane == 0) { unsigned sp = 0;
                  while (__hip_atomic_load(ctl + CW_QZ, RLX_AGENT) < (unsigned)G) { __builtin_amdgcn_s_sleep(4); if (++sp > (1u << 22)) break; }
                  __builtin_amdgcn_fence(__ATOMIC_ACQUIRE, "agent"); } }
            __syncthreads();

        } else {
            { PHASE_ARGS();
              pg8::Sched S; S.init(M / 256, NB16 / 256, G, (int)blockIdx.x, 0, 0, WS_XB, WS_XG, WS_WINB, WS_WCH, DM * 2); S.nextra = 16;
              pg8::EpiProjB E{ap->in[6], (bf16*)(ws + WS_K), (bf16*)(ws + WS_V), ap->out, nullptr};
              pg8::gemm_phase<pg8::EpiProjB, PG8_ALIGN, PG8_SP2, false>(lds + RING_OFF, wave, rsrc, DM * 2, DM * 2, S, E); }
            { PHASE_ARGS();
              pg8::Sched S; S.init(M / 256, NF8 / 256, G, (int)blockIdx.x, 0, 0, WS_X8, WS_X8, WS_WIN8, WS_WIN8, DM);
              pg8::EpiProj8 E{ap->in[6], (bf16*)(ws + WS_Q), (bf16*)(ws + WS_SZA), (bf16*)(ws + WS_U), (bf16*)(ws + WS_GT), (bf16*)(ws + WS_SGA), (bf16*)(ws + WS_SGB), nullptr};
              pg8::gemm_phase<pg8::EpiProj8, PG8_ALIGN, PG8_SP2, true>(lds + RING_OFF, wave, rsrc, DM, DM, S, E); }
        }
        if (BOTH(1) && !early_attn) GRID_BAR(1);
    }

    if (IN(2)) {
        PHASE_ARGS(); (void)rsrc; LANE_TID();
        { const sbk::Args A{(const bf16*)(ws + WS_Q), (const bf16*)(ws + WS_K), (const bf16*)(ws + WS_V), (const bf16*)(ws + WS_SZA), ws + WS_YA8, ap->in[2], ap->in[3], (unsigned*)(ctl + CW_QUEUE)};
          SB_LAS char* wl = (LAS char*)(lds + RING_OFF) + wave * sbk::WAVE_LDS;
          bool passed = !early_attn;
          for (;;) {
              unsigned t = 0;
              if (lane == 0) t = __hip_atomic_fetch_add(A.queue, 1u, __ATOMIC_RELAXED, __HIP_MEMORY_SCOPE_AGENT);
              t = (unsigned)__builtin_amdgcn_readfirstlane((int)t);
              if (t >= (unsigned)sbk::N_PROMPT_UNITS && !passed) { GRID_BAR(1); passed = true; }
              if (t >= (unsigned)sbk::N_UNITS) break;
              sbk::unit(A, t < (unsigned)sbk::N_PROMPT_UNITS ? sbk::N_SAMPLE_UNITS + (int)t : (int)t - sbk::N_PROMPT_UNITS, wl, lane);
          } }
        const float *state_conv = ap->in[4], *conv_w = ap->in[7], *conv_b = ap->in[8];
        const bf16 *Ub = (const bf16*)(ws + WS_U), *GT = (const bf16*)(ws + WS_GT);
        const size_t NI = (size_t)M * (WB / 8);
        size_t cbase = 0; int kk = 16;
        for (;;) {
            size_t i;
            if (early_attn) {
                if (kk == 16) { unsigned cq = 0; if (lane == 0) cq = __hip_atomic_fetch_add(ctl + CW_CONVQ, 1u, RLX_AGENT); cq = (unsigned)__builtin_amdgcn_readfirstlane((int)cq); cbase = (size_t)cq * 1024; kk = 0; }
                if (cbase >= NI) break;
                i = cbase + (size_t)kk * 64 + lane; ++kk;
            } else { i = (size_t)blockIdx.x * (NWAVES * 64) + tid + cbase; cbase += (size_t)G * NWAVES * 64; if (i >= NI) break; }
            const int row = (int)(i >> 8), c = (int)(i & 255) * 8;
            int t, sb = 0; const bool samp = row >= MP;
            if (samp) { t = (row - MP) & 63; sb = (row - MP) >> 6; } else t = row & 2047;
            const pg8::u32x4 u2 = *(const pg8::u32x4*)(Ub + (size_t)row * WB + c), gg = *(const pg8::u32x4*)(GT + (size_t)row * WB + c);
            float xm1[8], xm2[8], x0[8], g[8];
            const unsigned uw[4] = {u2.x, u2.y, u2.z, u2.w}, gw4[4] = {gg.x, gg.y, gg.z, gg.w};
#pragma unroll
            for (int k = 0; k < 4; ++k) { x0[2 * k] = pg8::bf_lo(uw[k]); x0[2 * k + 1] = pg8::bf_hi(uw[k]); g[2 * k] = pg8::bf_lo(gw4[k]); g[2 * k + 1] = pg8::bf_hi(gw4[k]); }
            if (t >= 1) { const pg8::u32x4 v = *(const pg8::u32x4*)(Ub + (size_t)(row - 1) * WB + c); const unsigned w[4] = {v.x, v.y, v.z, v.w};
#pragma unroll
                for (int k = 0; k < 4; ++k) { xm1[2 * k] = pg8::bf_lo(w[k]); xm1[2 * k + 1] = pg8::bf_hi(w[k]); } }
            else {
#pragma unroll
                for (int k = 0; k < 8; ++k) xm1[k] = samp ? state_conv[(size_t)(sb * 2 + 1) * WB + c + k] : 0.f; }
            if (t >= 2) { const pg8::u32x4 v = *(const pg8::u32x4*)(Ub + (size_t)(row - 2) * WB + c); const unsigned w[4] = {v.x, v.y, v.z, v.w};
#pragma unroll
                for (int k = 0; k < 4; ++k) { xm2[2 * k] = pg8::bf_lo(w[k]); xm2[2 * k + 1] = pg8::bf_hi(w[k]); } }
            else {
#pragma unroll
                for (int k = 0; k < 8; ++k) xm2[k] = samp ? state_conv[(size_t)(sb * 2 + t) * WB + c + k] : 0.f; }
            float y[8];
#pragma unroll
            for (int k = 0; k < 8; ++k) y[k] = pg8::SC_Y * g[k] * (conv_b[c + k] + conv_w[c + k] * xm2[k] + conv_w[WB + c + k] * xm1[k] + conv_w[2 * WB + c + k] * x0[k]);
            *(pg8::u32x2*)(ws + WS_YB8 + (size_t)row * WB + c) = pg8::pack8_fp8((f32x4){y[0], y[1], y[2], y[3]}, (f32x4){y[4], y[5], y[6], y[7]});
        }
        if (BOTH(2)) GRID_BAR(2);
    }

    const bool rm34 = dynp1 && BOTH(3);
    if (IN(3)) {
        PHASE_ARGS();
        pg8::Sched S; S.init(M / 256, DM / 256, G, (int)blockIdx.x, 1, 0, WS_YA8, WS_YB8, WS_WA8, WS_WB8, WB);
        if (rm34) { S.rm = 1; S.rho = (int)blockIdx.x / pg8::NXCD; S.xq = (int)blockIdx.x % pg8::NXCD; }
        pg8::EpiMerge E{(const bf16*)(ws + WS_SGA), (const bf16*)(ws + WS_SGB), (bf16*)(ws + WS_M1), ws + WS_MG8, rsrc, (unsigned)WS_MG8, rm34 ? (unsigned*)(ctl + CW_PM) : nullptr};
        pg8::gemm_phase<pg8::EpiMerge, PG8_ALIGN, PG8_SP2, true>(lds + RING_OFF, wave, rsrc, WB, WB, S, E);
        if (BOTH(3) && !rm34) GRID_BAR(3);
    }

    if (IN(4)) {
        PHASE_ARGS();
        pg8::Sched S; S.init(M / 256, DM / 256, G, (int)blockIdx.x, 0, 0, WS_MG8, WS_MG8, WS_WO8, WS_WO8, DM);
        if (rm34) {
            S.rm = 2; S.rho = (int)blockIdx.x / pg8::NXCD; S.xq = (int)blockIdx.x % pg8::NXCD;
            { LANE_TID(); if (wave == 0 && lane == 0) {
                  const int rho = (int)blockIdx.x / pg8::NXCD, xq = (int)blockIdx.x % pg8::NXCD, nu = rho >= 16 ? 3 : 2, p0 = rho >= 16 ? rho - 16 : 48 + rho;
                  for (int k = 0; k < nu; ++k) { const int pp = p0 + 16 * k, pm = pp < 64 ? 8 * (2 * (pp >> 5) + (xq >> 2)) + (pp & 7) : 32 + ((pp - 64) & 7); unsigned sp = 0;
                      while (__hip_atomic_load(ctl + CW_PM + 16 * pm, RLX_AGENT) < 16u) { __builtin_amdgcn_s_sleep(4); if (++sp > (1u << 22)) break; } }
                  __builtin_amdgcn_fence(__ATOMIC_ACQUIRE, "agent"); } }
            __syncthreads();
        }
        pg8::EpiOut E{(const bf16*)(ws + WS_XB), (bf16*)(ws + WS_PRE), DN_ALPHA};
        pg8::gemm_phase<pg8::EpiOut, PG8_ALIGN, PG8_SP2, true>(lds + RING_OFF, wave, rsrc, DM, DM, S, E);
        if (BOTH(4)) GRID_BAR(4);
    }

    if (IN(5)) {
        PHASE_ARGS(); (void)rsrc; LANE_TID();
        const float *ln_g = ap->in[12], *ln_b = ap->in[13]; float* out = ap->out;
        for (int m = gw; m < M; m += NGW) {
            const pg8::u32x4* rp = (const pg8::u32x4*)((const bf16*)(ws + WS_PRE) + (size_t)m * DM) + lane;
            f32x4 v[16]; float s = 0.f;
#pragma unroll
            for (int j = 0; j < 8; ++j) { const pg8::u32x4 w = rp[64 * j]; v[2 * j] = pg8::bf4_lo(w); v[2 * j + 1] = pg8::bf4_hi(w); }
#pragma unroll
            for (int j = 0; j < 16; ++j) s += (v[j].x + v[j].y) + (v[j].z + v[j].w);
            const float mean = wave_sum(s) * (1.f / DM); float s2 = 0.f;
#pragma unroll
            for (int j = 0; j < 16; ++j) { v[j] = v[j] - mean; s2 += (v[j].x * v[j].x + v[j].y * v[j].y) + (v[j].z * v[j].z + v[j].w * v[j].w); }
            const float rstd = 1.f / sqrtf(wave_sum(s2) * (1.f / DM) + LN_EPS);
            float* orow = out + pg8::OUT_Y + (size_t)m * DM;
#pragma unroll
            for (int j = 0; j < 16; ++j) { const int e = ((j >> 1) * 64 + lane) * 8 + (j & 1) * 4;
                const f32x4 g = *(const f32x4*)(ln_g + e), bb = *(const f32x4*)(ln_b + e); *(GAS f32x4*)(orow + e) = v[j] * rstd * g + bb; }
        }
    }
#undef IN
#undef BOTH
}

extern "C" void kernel_launch(void* const* d_in, const int* in_sizes, int n_in, void* d_out, int out_size, void* d_ws, size_t ws_size, hipStream_t stream) {
    static int grid = 0;
    if (grid == 0) {
        if (n_in != 14 || (size_t)out_size != pg8::OUT_TOTAL || ws_size < WS_END) { fprintf(stderr, "kernel_launch: unexpected problem (n_in %d, out %d, ws %zu; need ws >= %zu); nothing launched\n", n_in, out_size, ws_size, (size_t)WS_END); grid = -1; return; }
        int dev = 0, cus = 0, per_cu = 0;
        if (hipGetDevice(&dev) != hipSuccess || hipDeviceGetAttribute(&cus, hipDeviceAttributeMultiprocessorCount, dev) != hipSuccess) { fprintf(stderr, "kernel_launch: device query failed\n"); grid = -1; return; }
        if (hipFuncSetAttribute((const void*)mk_fwd, hipFuncAttributeMaxDynamicSharedMemorySize, LDS_BYTES) != hipSuccess) { fprintf(stderr, "kernel_launch: hipFuncSetAttribute failed\n"); grid = -1; return; }
        if (hipOccupancyMaxActiveBlocksPerMultiprocessor(&per_cu, (const void*)mk_fwd, NWAVES * 64, LDS_BYTES) != hipSuccess || per_cu < 1) { fprintf(stderr, "kernel_launch: occupancy query reports %d workgroups per CU\n", per_cu); }
        (void)hipGetLastError();
        grid = cus;
    }
    if (grid < 0) return;
    if (hipMemsetAsync((char*)d_ws + WS_CTL, 0, CTL_ZERO_BYTES, stream) != hipSuccess) { fprintf(stderr, "kernel_launch: hipMemsetAsync failed\n"); return; }
    KArgs a{};
    for (int i = 0; i < 14; ++i) a.in[i] = (const float*)d_in[i];
    a.out = (float*)d_out; a.ws = (unsigned char*)d_ws;
    if (N_LAUNCHES == 1) {
        a.ph_lo = 0; a.ph_hi = PER_PHASE;
        hipLaunchKernelGGL(mk_fwd, dim3(grid), dim3(NWAVES * 64), LDS_BYTES, stream, a);
    } else {
        for (int li = 0; li < PER_PHASE; ++li) { a.ph_lo = li; a.ph_hi = li + 1; hipLaunchKernelGGL(mk_fwd, dim3(grid), dim3(NWAVES * 64), LDS_BYTES, stream, a); }
    }
    const hipError_t le = hipPeekAtLastError();
    if (le != hipSuccess) fprintf(stderr, "kernel_launch: launch failed: %s\n", hipGetErrorName(le));
}
```

```cpp
#include <hip/hip_runtime.h>
#include <cstdio>
#include <cstdint>

#ifndef MK_N_LAUNCHES
#define MK_N_LAUNCHES 1
#endif
#ifndef SB_PRUNE
#define SB_PRUNE 1
#endif

namespace pg8 {
#define PG8_LAS __attribute__((address_space(3)))
typedef unsigned short bf16_t;
typedef short bf16x8 __attribute__((ext_vector_type(8)));
typedef float f32x4 __attribute__((ext_vector_type(4)));
typedef unsigned u32x4 __attribute__((ext_vector_type(4)));
constexpr int BM = 256, BK = 64, HALF = 128, HTB = HALF * BK * 2  , STAGE_BYTES = 8 * HTB, NXCD = 8, WGM = 8;

__host__ __device__ __forceinline__ int lds_byte(int r, int c) { const int st = (r >> 4) * 2 + (c >> 5), rr = r & 15, cc = c & 31, ob = rr * 64 + cc * 2; return st * 1024 + (ob ^ (((ob >> 9) & 1) << 5)); }
__host__ __device__ __forceinline__ void stage_rc(int b, int& R, int& C) { const int st = b / 1024, sb = b % 1024, swz = sb ^ (((sb >> 9) & 1) << 5); R = (st >> 1) * 16 + swz / 64; C = (st & 1) * 32 + (swz % 64) / 2; }
__host__ __device__ __forceinline__ int perm32(int rho) { const int n = rho >> 4, i = rho & 15; return 8 * (i >> 2) + 4 * n + (i & 3); }

struct Unit { int pm, pn, z; };

struct Sched {
    int nM, nN, nwg, G, c, zmode, pm0;
    int il;
    int rm, rho, xq;
    int nextra;
    int tail_c0;
    unsigned A0, A1, B0, B1, tstep;
    __device__ void init(int nM_, int nN_, int G_, int c_, int zmode_, int pm0_, size_t a0, size_t a1, size_t b0, size_t b1, int LDb) {
        nM = nM_; nN = nN_; nwg = nM * nN; G = G_; c = c_; zmode = zmode_; pm0 = pm0_; nextra = 0; tail_c0 = -1; rm = 0; rho = 0; xq = 0; il = 0; A0 = (unsigned)a0; A1 = (unsigned)a1; B0 = (unsigned)b0; B1 = (unsigned)b1; tstep = (unsigned)(BM * LDb); }
    __device__ bool next(int i, Unit& u) const {
        int ii = i, z = 0;
        if (zmode == 1) { ii = i >> 1; z = i & 1; }
        if (rm) {
            int p;
            if (rm == 1) { if (ii < 2) p = 32 * ii + rho; else if (ii == 2 && rho < 16) p = 64 + rho; else return false; }
            else if (rho >= 16) { if (ii > 2) return false; p = rho - 16 + 16 * ii; } else { if (ii > 1) return false; p = 48 + rho + 16 * ii; }
            return rm_at(p, u, z);
        }
        long L = (long)ii * G + c;
        if (tail_c0 >= 0) { const int full = nwg / G; if (ii >= full) { if (c < tail_c0) return false; const long idx = (long)(ii - full) * (G - tail_c0) + (c - tail_c0); if (idx >= nwg - (long)full * G) return false; L = (long)full * G + idx; } }
        return at(L, u, z);
    }
    __device__ bool rm_at(int p, Unit& u, int z) const {
        if (p < 64) { const int r = p >> 5, q = p & 31; u.pm = pm0 + 8 * (2 * r + (xq >> 2)) + (q & 7); u.pn = 4 * (xq & 3) + (q >> 3); }
        else { const int q = p - 64; u.pm = pm0 + 32 + (q & 7); u.pn = 2 * xq + (q >> 3); }
        u.z = z; return true;
    }
    __device__ bool at(long L, Unit& u, int z = 0) const {
        if (il) {
            const int k = (int)(L / NXCD), x = (int)(L % NXCD);
            if (k >= 400) return false;
            if (k < 384) { const int blk = 8 * (k >> 5) + x, q = k & 31, g = blk / 20, j = blk % 20; u.pm = pm0 + 8 * g + (q & 7); u.pn = 4 * j + (q >> 3); }
            else { const int q = k - 384; u.pm = pm0 + 32 + (q & 7); u.pn = 64 + 2 * x + (q >> 3); }
            u.z = z; return true;
        }
        if (L >= nwg) { if (L >= nwg + nextra) return false; u.pm = 0; u.pn = (int)(L - nwg); u.z = 1; return true; }
        int wgid = (int)L; { const int q = nwg / NXCD, r = nwg % NXCD, xcd = wgid % NXCD, off = wgid / NXCD; wgid = (xcd < r ? xcd * (q + 1) : r * (q + 1) + (xcd - r) * q) + off; }
        const int nig = WGM * nN, gid = wgid / nig, fm = gid * WGM, gsz = (nM - fm) < WGM ? (nM - fm) : WGM;
        u.pm = pm0 + fm + ((wgid % nig) % gsz); u.pn = (wgid % nig) / gsz; u.z = z; return true;
    }
    __device__ __forceinline__ unsigned ptrA(const Unit& u) const { return (u.z ? A1 : A0) + (unsigned)u.pm * tstep; }
    __device__ __forceinline__ unsigned ptrB(const Unit& u) const { return (u.z ? B1 : B0) + (unsigned)u.pn * tstep; }
};

typedef __bf16 bf16v2_t __attribute__((ext_vector_type(2)));
typedef float f32v2_t __attribute__((ext_vector_type(2)));
__device__ __forceinline__ unsigned cvt_pk_bf16(float lo, float hi) { const bf16v2_t r = __builtin_convertvector((f32v2_t){lo, hi}, bf16v2_t); return __builtin_bit_cast(unsigned, r); }
__device__ __forceinline__ u32x4 pack8(const f32x4 a, const f32x4 b) { u32x4 w; w.x = cvt_pk_bf16(a[0], a[1]); w.y = cvt_pk_bf16(a[2], a[3]); w.z = cvt_pk_bf16(b[0], b[1]); w.w = cvt_pk_bf16(b[2], b[3]); return w; }
__device__ __forceinline__ float bf_lo(unsigned w) { return __uint_as_float(w << 16); }
__device__ __forceinline__ float bf_hi(unsigned w) { return __uint_as_float(w & 0xffff0000u); }
__device__ __forceinline__ float sigmoid_f(float v) { return __builtin_amdgcn_rcpf(1.0f + __builtin_amdgcn_exp2f(-1.4426950408889634f * v)); }
__device__ __forceinline__ f32x4 sigmoid4(f32x4 v) { return (f32x4){sigmoid_f(v[0]), sigmoid_f(v[1]), sigmoid_f(v[2]), sigmoid_f(v[3])}; }
__device__ __forceinline__ f32x4 silu4(f32x4 v) { return v * sigmoid4(v); }


constexpr size_t OUT_Y = 0, OUT_KP = 41943040, OUT_VP = 58720256, OUT_CP = 75497472, OUT_KS = 75513856, OUT_VS = 79708160, OUT_CS = 83902464, OUT_TOTAL = 84033536;
constexpr float QSCALE = 0.08838834764831845f * 1.4426950408889634f;

typedef unsigned u32x2 __attribute__((ext_vector_type(2)));
__device__ __forceinline__ float clamp8(float v) { return __builtin_amdgcn_fmed3f(v, -448.0f, 448.0f); }
__device__ __forceinline__ unsigned cvt4_fp8(const f32x4 a) { unsigned w = __builtin_amdgcn_cvt_pk_fp8_f32(clamp8(a[0]), clamp8(a[1]), 0, false); return __builtin_amdgcn_cvt_pk_fp8_f32(clamp8(a[2]), clamp8(a[3]), w, true); }
__device__ __forceinline__ u32x2 pack8_fp8(const f32x4 a, const f32x4 b) { u32x2 w; w.x = cvt4_fp8(a); w.y = cvt4_fp8(b); return w; }
constexpr float SC_WIN = 64.f, SC_WAB = 64.f, SC_WO = 128.f, SC_Y = 4.f, SC_MG = 8.f;

struct EpiProjB {
    static constexpr bool PERM = true, AFTER_DRAIN = false;
    const float* bias;
    bf16_t *K, *V;
    float* out;
    unsigned* sig;
    __device__ __forceinline__ unsigned* sig_ptr(const Unit& u) const { return (sig != nullptr && u.z == 0 && u.pm < 32) ? sig + 16 * (u.pm >> 3) : nullptr; }
    __device__ __forceinline__ void operator()(const f32x4 (&acc)[2][2][4][2], const Unit& u, int wr, int wc, int fr, int fq) const {
        const int pn = u.pn, cl = wc * 32 + 8 * fq;
        if (u.z == 0) {
            const int row0 = u.pm * BM + wr * 64 + fr;
            const bool isv = pn >= 8; const int c0 = (pn & 7) * BM + cl;
            const float* bp = bias + (isv ? 4096 : 2048) + c0;
            f32x4 bv[2][2];
#pragma unroll
            for (int bj = 0; bj < 2; ++bj)
#pragma unroll
                for (int n = 0; n < 2; ++n) bv[bj][n] = *(const f32x4*)(bp + bj * HALF + 4 * n);
            bf16_t* B = isv ? V : K;
            float* O = (u.pm < 32) ? out + (isv ? OUT_VP : OUT_KP) : out + (isv ? OUT_VS : OUT_KS) - (size_t)8192 * 2048;
#pragma unroll
            for (int ai = 0; ai < 2; ++ai)
#pragma unroll
                for (int m = 0; m < 4; ++m) { const size_t ro = (size_t)(row0 + ai * HALF + m * 16) * 2048 + c0;
#pragma unroll
                    for (int bj = 0; bj < 2; ++bj) { const f32x4 v0 = acc[ai][bj][m][0] + bv[bj][0], v1 = acc[ai][bj][m][1] + bv[bj][1];
                        *(u32x4*)(B + ro + bj * HALF) = pack8(v0, v1); *(f32x4*)(O + ro + bj * HALF) = v0; *(f32x4*)(O + ro + bj * HALF + 4) = v1; } }
        } else {
            const int ch = pn * HALF + cl;
            f32x4 bc[2], bh[2];
#pragma unroll
            for (int n = 0; n < 2; ++n) { bc[n] = *(const f32x4*)(bias + 10240 + ch + 4 * n); bh[n] = *(const f32x4*)(bias + 12288 + ch + 4 * n); }
#pragma unroll
            for (int ai = 0; ai < 1; ++ai)
#pragma unroll
                for (int m = 0; m < 4; ++m) { const int row = wr * 64 + m * 16 + fr;
                    if (row < 72) { float* cp = (row < 8) ? out + OUT_CP + (size_t)row * 2048 + ch : out + OUT_CS + (size_t)(row - 8) * 2048 + ch;
                        *(f32x4*)cp = (acc[0][0][m][0] + bc[0]) * (acc[0][1][m][0] + bh[0]); *(f32x4*)(cp + 4) = (acc[0][0][m][1] + bc[1]) * (acc[0][1][m][1] + bh[1]); } }
        }
    }
};

struct EpiProj8 {
    static constexpr bool PERM = true, AFTER_DRAIN = false;
    const float* bias;
    bf16_t *Q, *SZA, *U, *GT, *SGA, *SGB;
    unsigned* sig;
    __device__ __forceinline__ unsigned* sig_ptr(const Unit& u) const { return (sig != nullptr && u.pn < 16 && u.pm < 32) ? sig + 16 * (u.pm >> 3) : nullptr; }
    __device__ __forceinline__ void operator()(const f32x4 (&acc)[2][2][4][2], const Unit& u, int wr, int wc, int fr, int fq) const {
        const int pn = u.pn, row0 = u.pm * BM + wr * 64 + fr, cl = wc * 32 + 8 * fq;
        constexpr float DS = 1.0f / SC_WIN;
        if (pn >= 16 && pn < 32) {
            const int ch = (pn - 16) * HALF + cl;
            f32x4 bc[2], bh[2];
#pragma unroll
            for (int n = 0; n < 2; ++n) { bc[n] = *(const f32x4*)(bias + 10240 + ch + 4 * n); bh[n] = *(const f32x4*)(bias + 12288 + ch + 4 * n); }
#pragma unroll
            for (int ai = 0; ai < 2; ++ai)
#pragma unroll
                for (int m = 0; m < 4; ++m) { const int row = row0 + ai * HALF + m * 16;
                    *(u32x4*)(U + (size_t)row * 2048 + ch) = pack8((acc[ai][0][m][0] * DS + bc[0]) * (acc[ai][1][m][0] * DS + bh[0]), (acc[ai][0][m][1] * DS + bc[1]) * (acc[ai][1][m][1] * DS + bh[1])); }
        } else if (pn >= 32 && pn < 48) {
            const int ch = (pn - 32) * HALF + cl;
            f32x4 bb[2], bz[2];
#pragma unroll
            for (int n = 0; n < 2; ++n) { bb[n] = *(const f32x4*)(bias + 8192 + ch + 4 * n); bz[n] = *(const f32x4*)(bias + 14336 + ch + 4 * n); }
#pragma unroll
            for (int ai = 0; ai < 2; ++ai)
#pragma unroll
                for (int m = 0; m < 4; ++m) { const int row = row0 + ai * HALF + m * 16;
                    const f32x4 g0 = (acc[ai][0][m][0] * DS + bb[0]) * silu4(acc[ai][1][m][0] * DS + bz[0]), g1 = (acc[ai][0][m][1] * DS + bb[1]) * silu4(acc[ai][1][m][1] * DS + bz[1]);
                    *(u32x4*)(GT + (size_t)row * 2048 + ch) = pack8(g0, g1); }
        } else {
            int kind, c0, ld, sb; bf16_t* B;
            if (pn < 8) { kind = 0; c0 = pn * BM + cl; sb = c0; ld = 2048; B = Q; }
            else if (pn < 16) { kind = 1; c0 = (pn - 8) * BM + cl; sb = 6144 + c0; ld = 2048; B = SZA; }
            else if (pn < 64) { kind = 2; c0 = (pn - 48) * BM + cl; sb = 16384 + c0; ld = 4096; B = SGA; }
            else { kind = 2; c0 = (pn - 64) * BM + cl; sb = 20480 + c0; ld = 4096; B = SGB; }
            f32x4 bv[2][2];
#pragma unroll
            for (int bj = 0; bj < 2; ++bj)
#pragma unroll
                for (int n = 0; n < 2; ++n) bv[bj][n] = *(const f32x4*)(bias + sb + bj * HALF + 4 * n);
#pragma unroll
            for (int ai = 0; ai < 2; ++ai)
#pragma unroll
                for (int m = 0; m < 4; ++m) { bf16_t* rowp = B + (size_t)(row0 + ai * HALF + m * 16) * ld + c0;
#pragma unroll
                    for (int bj = 0; bj < 2; ++bj) { f32x4 v0 = acc[ai][bj][m][0] * DS + bv[bj][0], v1 = acc[ai][bj][m][1] * DS + bv[bj][1];
                        if (kind == 0) { v0 = v0 * QSCALE; v1 = v1 * QSCALE; } else if (kind == 1) { v0 = silu4(v0); v1 = silu4(v1); } else { v0 = sigmoid4(v0); v1 = sigmoid4(v1); }
                        *(u32x4*)(rowp + bj * HALF) = pack8(v0, v1); } }
        }
    }
};

__device__ __forceinline__ f32x4 bf4_lo(const u32x4 w) { return (f32x4){bf_lo(w.x), bf_hi(w.x), bf_lo(w.y), bf_hi(w.y)}; }
__device__ __forceinline__ f32x4 bf4_hi(const u32x4 w) { return (f32x4){bf_lo(w.z), bf_hi(w.z), bf_lo(w.w), bf_hi(w.w)}; }
struct EpiMerge {
    static constexpr bool PERM = true, AFTER_DRAIN = false;
    const bf16_t *SGA, *SGB; bf16_t* M1; unsigned char* MG8; __amdgpu_buffer_rsrc_t wsr; unsigned offMG8;
    unsigned* sig;
    __device__ __forceinline__ unsigned* sig_ptr(const Unit& u) const { return (sig != nullptr && u.z == 1) ? sig + 16 * u.pm : nullptr; }
    __device__ __forceinline__ void operator()(const f32x4 (&acc)[2][2][4][2], const Unit& u, int wr, int wc, int fr, int fq) const {
        const int row0 = u.pm * BM + wr * 64 + fr, col0 = u.pn * BM + wc * 32 + 8 * fq;
        const bf16_t* SG = u.z ? SGB : SGA;
        constexpr float DS = 1.0f / (SC_Y * SC_WAB);
#pragma unroll
        for (int ai = 0; ai < 2; ++ai) {
            u32x4 g[4][2], mv[4][2];
#pragma unroll
            for (int m = 0; m < 4; ++m)
#pragma unroll
                for (int bj = 0; bj < 2; ++bj) { const size_t ro = (size_t)(row0 + ai * HALF + m * 16) * 4096 + col0 + bj * HALF;
                    g[m][bj] = *(const u32x4*)(SG + ro); if (u.z) mv[m][bj] = *(const u32x4*)(M1 + ro); }
#pragma unroll
            for (int m = 0; m < 4; ++m)
#pragma unroll
                for (int bj = 0; bj < 2; ++bj) { const size_t ro = (size_t)(row0 + ai * HALF + m * 16) * 4096 + col0 + bj * HALF;
                    f32x4 v0 = acc[ai][bj][m][0] * DS * bf4_lo(g[m][bj]), v1 = acc[ai][bj][m][1] * DS * bf4_hi(g[m][bj]);
                    if (u.z == 0) *(u32x4*)(M1 + ro) = pack8(v0, v1);
                    else { v0 = v0 + bf4_lo(mv[m][bj]); v1 = v1 + bf4_hi(mv[m][bj]); __builtin_amdgcn_raw_buffer_store_b64(pack8_fp8(v0 * SC_MG, v1 * SC_MG), wsr, (int)(offMG8 + (unsigned)ro), 0, 16  ); } }
        }
    }
};

struct EpiOut {
    static constexpr bool PERM = true, AFTER_DRAIN = false;
    const bf16_t* XB; bf16_t* PRE; float alpha;
    __device__ __forceinline__ void operator()(const f32x4 (&acc)[2][2][4][2], const Unit& u, int wr, int wc, int fr, int fq) const {
        const int row0 = u.pm * BM + wr * 64 + fr, col0 = u.pn * BM + wc * 32 + 8 * fq;
        constexpr float DS = 1.0f / (SC_MG * SC_WO);
#pragma unroll
        for (int ai = 0; ai < 2; ++ai) {
            u32x4 xv[4][2];
#pragma unroll
            for (int m = 0; m < 4; ++m)
#pragma unroll
                for (int bj = 0; bj < 2; ++bj) xv[m][bj] = *(const u32x4*)(XB + (size_t)(row0 + ai * HALF + m * 16) * 4096 + col0 + bj * HALF);
#pragma unroll
            for (int m = 0; m < 4; ++m)
#pragma unroll
                for (int bj = 0; bj < 2; ++bj) { const size_t ro = (size_t)(row0 + ai * HALF + m * 16) * 4096 + col0 + bj * HALF;
                    *(u32x4*)(PRE + ro) = pack8(bf4_lo(xv[m][bj]) * alpha + acc[ai][bj][m][0] * DS, bf4_hi(xv[m][bj]) * alpha + acc[ai][bj][m][1] * DS); }
        }
    }
};

typedef int v8i_t __attribute__((ext_vector_type(8)));
struct Dyn { unsigned* ctr; int x, first, base; volatile PG8_LAS unsigned* slot; unsigned* once; int once_k; unsigned* once_x; unsigned once_nloc; };
template <class T> struct has_sig { static constexpr bool v = false; };
template <> struct has_sig<EpiMerge> { static constexpr bool v = true; };

template <class Epi, bool ALIGN_EPI = false, bool SP2 = false, bool F8 = false, bool DYN = false>
__device__ __forceinline__ void gemm_phase(PG8_LAS unsigned char* lds, const int wave_sgpr, const __amdgpu_buffer_rsrc_t rsrc, const int LDb, const int Kb, const Sched& S, const Epi& E, const Dyn D = Dyn{nullptr, 0, 0, 0, nullptr, nullptr, 0, nullptr, 1u}) {
    int lane_ = (int)__builtin_amdgcn_mbcnt_hi(~0u, __builtin_amdgcn_mbcnt_lo(~0u, 0u)); asm volatile("" : "+v"(lane_));
    const int wid = wave_sgpr, lane = lane_, tid = wid * 64 + lane, wr = wid >> 2, wc = wid & 3, fr = lane & 15, fq = lane >> 4;
    const int nt = Kb / 128;
    unsigned voffA[2], voffB[2];
#pragma unroll
    for (int i = 0; i < 2; ++i) { int R, C; stage_rc(tid * 16 + i * 8192, R, C); const int Rb = Epi::PERM ? ((R & ~31) + perm32(R & 31)) : R;
        voffA[i] = (unsigned)(R * LDb + C * 2); voffB[i] = (unsigned)(Rb * LDb + C * 2); }
    const unsigned kstep = 128u;
    const unsigned hstep = (unsigned)(HALF * LDb);
    const unsigned ldsw = (unsigned)wid * 1024u;
    constexpr int KOFF = 1024;
    const int aoff = lds_byte(wr * 64 + fr, fq * 8), boff = lds_byte(wc * 32 + fr, fq * 8);
#define PG8_SA(b, h) (((b) * 2 + (h)) * HTB)
#define PG8_SB(b, h) ((4 + (b) * 2 + (h)) * HTB)
#define PG8_STAGE(bufoff, gbase, voff) do { _Pragma("unroll") for (int _i = 0; _i < 2; ++_i) \
        __builtin_amdgcn_raw_ptr_buffer_load_lds(rsrc, (PG8_LAS void*)(lds + (bufoff) + ldsw + _i * 8192), 16, (int)(voff)[_i], (int)(gbase), 0, 0); } while (0)
#define PG8_LDA(dst, b, h) do { _Pragma("unroll") for (int m = 0; m < 4; ++m) _Pragma("unroll") for (int k = 0; k < 2; ++k) dst[m][k] = *(const PG8_LAS bf16x8*)(lds + PG8_SA(b, h) + aoff + m * 2048 + k * KOFF); } while (0)
#define PG8_LDB(dst, b, h) do { _Pragma("unroll") for (int n = 0; n < 2; ++n) _Pragma("unroll") for (int k = 0; k < 2; ++k) dst[n][k] = *(const PG8_LAS bf16x8*)(lds + PG8_SB(b, h) + boff + n * 2048 + k * KOFF); } while (0)
#define PG8_MMA(ai, bj, At, Bt) do { __builtin_amdgcn_s_setprio(1); _Pragma("unroll") for (int m = 0; m < 4; ++m) _Pragma("unroll") for (int n = 0; n < 2; ++n) { \
        if constexpr (F8) { typedef int v4i_t __attribute__((ext_vector_type(4))); \
            const v8i_t pa = __builtin_shufflevector(__builtin_bit_cast(v4i_t, At[m][0]), __builtin_bit_cast(v4i_t, At[m][1]), 0, 1, 2, 3, 4, 5, 6, 7); \
            const v8i_t pb = __builtin_shufflevector(__builtin_bit_cast(v4i_t, Bt[n][0]), __builtin_bit_cast(v4i_t, Bt[n][1]), 0, 1, 2, 3, 4, 5, 6, 7); \
            acc[ai][bj][m][n] = __builtin_amdgcn_mfma_scale_f32_16x16x128_f8f6f4(pb, pa, acc[ai][bj][m][n], 0, 0, 0, 0, 0, 0); } \
        else { _Pragma("unroll") for (int k = 0; k < 2; ++k) acc[ai][bj][m][n] = __builtin_amdgcn_mfma_f32_16x16x32_bf16(Bt[n][k], At[m][k], acc[ai][bj][m][n], 0, 0, 0); } } \
        __builtin_amdgcn_s_setprio(0); } while (0)
#define PG8_WAIT_V(n) asm volatile("s_waitcnt vmcnt(" #n ")" ::: "memory")
#define PG8_WAIT_L(n) asm volatile("s_waitcnt lgkmcnt(" #n ")" ::: "memory")
#define PG8_BAR __builtin_amdgcn_s_barrier()
#define PG8_SCHED __builtin_amdgcn_sched_barrier(0)
    Unit cur, nxt; int ui = 0; bool once_done = false;
    if constexpr (DYN) {
        if (!S.at((long)D.first * NXCD + D.x, cur)) return;
        if (wid == 0) { if (lane == 0) { const unsigned t = __hip_atomic_fetch_add(D.ctr, 1u, __ATOMIC_RELAXED, __HIP_MEMORY_SCOPE_AGENT) + (unsigned)D.base; *D.slot = t; } asm volatile("s_waitcnt lgkmcnt(0)" ::: "memory"); }
        __builtin_amdgcn_s_barrier();
    } else { if (!S.next(0, cur)) return; }
    f32x4 acc[2][2][4][2];
#pragma unroll
    for (int a = 0; a < 2; ++a)
#pragma unroll
        for (int b = 0; b < 2; ++b)
#pragma unroll
            for (int m = 0; m < 4; ++m)
#pragma unroll
                for (int n = 0; n < 2; ++n) acc[a][b][m][n] = (f32x4){0.f, 0.f, 0.f, 0.f};
    bf16x8 At[4][2], B0[2][2], B1[2][2];
    unsigned cA = S.ptrA(cur), cB = S.ptrB(cur);
    if constexpr (SP2) {
        PG8_STAGE(PG8_SB(0, 0), cB, voffB); PG8_STAGE(PG8_SB(0, 1), cB + hstep, voffB); PG8_STAGE(PG8_SA(0, 0), cA, voffA); PG8_STAGE(PG8_SA(0, 1), cA + hstep, voffA);
        if (wr == 1) PG8_BAR;
        PG8_WAIT_V(2); PG8_BAR;
        PG8_STAGE(PG8_SB(1, 0), cB + kstep, voffB); PG8_STAGE(PG8_SA(1, 0), cA + kstep, voffA); PG8_STAGE(PG8_SB(1, 1), cB + hstep + kstep, voffB);
        PG8_WAIT_V(6); PG8_BAR;
    } else {
        PG8_STAGE(PG8_SB(0, 0), cB, voffB); PG8_STAGE(PG8_SA(0, 0), cA, voffA); PG8_STAGE(PG8_SB(0, 1), cB + hstep, voffB); PG8_STAGE(PG8_SA(0, 1), cA + hstep, voffA);
        if (wr == 1) PG8_BAR;
        PG8_WAIT_V(4); PG8_BAR;
        PG8_STAGE(PG8_SB(1, 0), cB + kstep, voffB); PG8_STAGE(PG8_SA(1, 0), cA + kstep, voffA); PG8_STAGE(PG8_SB(1, 1), cB + hstep + kstep, voffB);
        PG8_WAIT_V(6); PG8_BAR;
    }
    for (;;) {
        bool has_next;
        unsigned tn = 0;
        if constexpr (DYN) { tn = (unsigned)__builtin_amdgcn_readfirstlane((int)*D.slot); has_next = S.at((long)tn * NXCD + D.x, nxt); }
        else has_next = S.next(ui + 1, nxt);
        const unsigned nA = has_next ? S.ptrA(nxt) : cA, nB = has_next ? S.ptrB(nxt) : cB;
        for (int t = 0; t < nt; t += 2) {
            const bool last = (t == nt - 2);
            const unsigned a1 = cA + (unsigned)(t + 1) * kstep;
            const unsigned a2 = last ? nA : cA + (unsigned)(t + 2) * kstep, b2 = last ? nB : cB + (unsigned)(t + 2) * kstep;
            const unsigned a3 = a2 + kstep, b3 = b2 + kstep;
            if constexpr (SP2) {
            PG8_LDB(B0, 0, 0); PG8_LDB(B1, 0, 1); PG8_SCHED; PG8_LDA(At, 0, 0); PG8_STAGE(PG8_SA(1, 1), a1 + hstep, voffA);
            PG8_WAIT_V(8); PG8_WAIT_L(0); PG8_BAR; PG8_MMA(0, 0, At, B0); PG8_MMA(0, 1, At, B1); PG8_BAR; PG8_SCHED;
            PG8_LDA(At, 0, 1); PG8_STAGE(PG8_SB(0, 0), b2, voffB); PG8_STAGE(PG8_SB(0, 1), b2 + hstep, voffB); PG8_STAGE(PG8_SA(0, 0), a2, voffA);
            PG8_WAIT_V(8); PG8_WAIT_L(0); PG8_BAR; PG8_MMA(1, 0, At, B0); PG8_MMA(1, 1, At, B1); PG8_BAR; PG8_SCHED;
            PG8_LDB(B0, 1, 0); PG8_LDB(B1, 1, 1); PG8_SCHED; PG8_LDA(At, 1, 0); PG8_STAGE(PG8_SA(0, 1), a2 + hstep, voffA);
            PG8_WAIT_V(8); PG8_WAIT_L(0); PG8_BAR; PG8_MMA(0, 0, At, B0); PG8_MMA(0, 1, At, B1); PG8_BAR; PG8_SCHED;
            PG8_LDA(At, 1, 1); PG8_STAGE(PG8_SB(1, 0), b3, voffB); PG8_STAGE(PG8_SB(1, 1), b3 + hstep, voffB); PG8_STAGE(PG8_SA(1, 0), a3, voffA);
            PG8_WAIT_V(8); PG8_WAIT_L(0); PG8_BAR; PG8_MMA(1, 0, At, B0); PG8_MMA(1, 1, At, B1); PG8_BAR; PG8_SCHED;
            } else {
            PG8_LDB(B0, 0, 0); PG8_SCHED; PG8_LDA(At, 0, 0); PG8_STAGE(PG8_SA(1, 1), a1 + hstep, voffA);
            PG8_WAIT_L(8); PG8_BAR; PG8_WAIT_L(0); PG8_MMA(0, 0, At, B0); PG8_BAR; PG8_SCHED;
            PG8_LDB(B1, 0, 1); PG8_STAGE(PG8_SB(0, 0), b2, voffB);
            PG8_BAR; PG8_WAIT_L(0); PG8_MMA(0, 1, At, B1); PG8_BAR;
            PG8_LDA(At, 0, 1); PG8_STAGE(PG8_SA(0, 0), a2, voffA);
            PG8_BAR; PG8_WAIT_L(0); PG8_MMA(1, 0, At, B0); PG8_BAR; PG8_SCHED;
            PG8_STAGE(PG8_SB(0, 1), b2 + hstep, voffB);
            PG8_WAIT_V(6); PG8_BAR; PG8_MMA(1, 1, At, B1); PG8_BAR;
            PG8_LDB(B0, 1, 0); PG8_SCHED; PG8_LDA(At, 1, 0); PG8_STAGE(PG8_SA(0, 1), a2 + hstep, voffA);
            PG8_WAIT_L(8); PG8_BAR; PG8_WAIT_L(0); PG8_MMA(0, 0, At, B0); PG8_BAR; PG8_SCHED;
            PG8_LDB(B1, 1, 1); PG8_STAGE(PG8_SB(1, 0), b3, voffB);
            PG8_BAR; PG8_WAIT_L(0); PG8_MMA(0, 1, At, B1); PG8_BAR;
            PG8_LDA(At, 1, 1); PG8_STAGE(PG8_SA(1, 0), a3, voffA);
            PG8_BAR; PG8_WAIT_L(0); PG8_MMA(1, 0, At, B0); PG8_BAR; PG8_SCHED;
            PG8_STAGE(PG8_SB(1, 1), b3 + hstep, voffB);
            PG8_WAIT_V(6); PG8_BAR; PG8_MMA(1, 1, At, B1); PG8_BAR;
            }
        }
        if constexpr (ALIGN_EPI) { if (wr == 0) PG8_BAR; }
        { int lz = (int)__builtin_amdgcn_mbcnt_hi(~0u, __builtin_amdgcn_mbcnt_lo(~0u, 0u)); asm volatile("" : "+v"(lz));
          unsigned tk2 = 0x7fffffffu;
          if constexpr (DYN) { if (has_next && wid == 0 && lz == 0) tk2 = __hip_atomic_fetch_add(D.ctr, 1u, __ATOMIC_RELAXED, __HIP_MEMORY_SCOPE_AGENT) + (unsigned)D.base; }
          E(acc, cur, wr, wc, lz & 15, lz >> 4);
          __builtin_amdgcn_s_waitcnt(0x0F70);
          if constexpr (DYN) { if (wid == 0) { int l2 = (int)__builtin_amdgcn_mbcnt_hi(~0u, __builtin_amdgcn_mbcnt_lo(~0u, 0u)); asm volatile("" : "+v"(l2)); if (l2 == 0) *D.slot = tk2; asm volatile("s_waitcnt lgkmcnt(0)" ::: "memory"); } } }
        if constexpr (DYN) {
            if (D.once != nullptr && !once_done && (!has_next || tn >= (unsigned)D.once_k)) {
                once_done = true;
                PG8_BAR;
                if (wid == 0) { int l4 = (int)__builtin_amdgcn_mbcnt_hi(~0u, __builtin_amdgcn_mbcnt_lo(~0u, 0u)); asm volatile("" : "+v"(l4));
                    if (l4 == 0) {
                        if (D.once_nloc <= 1u) { __builtin_amdgcn_fence(__ATOMIC_RELEASE, "agent"); (void)__hip_atomic_fetch_add(D.once, 1u, __ATOMIC_RELAXED, __HIP_MEMORY_SCOPE_AGENT); }
                        else if (__hip_atomic_fetch_add(D.once_x, 1u, __ATOMIC_RELAXED, __HIP_MEMORY_SCOPE_AGENT) + 1u == D.once_nloc) {
                            __builtin_amdgcn_fence(__ATOMIC_RELEASE, "agent"); (void)__hip_atomic_fetch_add(D.once, D.once_nloc, __ATOMIC_RELAXED, __HIP_MEMORY_SCOPE_AGENT); } } }
            }
        }
        if constexpr (has_sig<Epi>::v) {
            unsigned* const sp = E.sig_ptr(cur);
            if (sp != nullptr) {
                PG8_BAR;
                if (wid == 0) { int l3 = (int)__builtin_amdgcn_mbcnt_hi(~0u, __builtin_amdgcn_mbcnt_lo(~0u, 0u)); asm volatile("" : "+v"(l3));
                    if (l3 == 0) (void)__hip_atomic_fetch_add(sp, 1u, __ATOMIC_RELAXED, __HIP_MEMORY_SCOPE_AGENT); }
            }
        }
        if (!has_next) break;
#pragma unroll
        for (int a = 0; a < 2; ++a)
#pragma unroll
            for (int b = 0; b < 2; ++b)
#pragma unroll
                for (int m = 0; m < 4; ++m)
#pragma unroll
                    for (int n = 0; n < 2; ++n) acc[a][b][m][n] = (f32x4){0.f, 0.f, 0.f, 0.f};
        cur = nxt; cA = nA; cB = nB; ++ui;
        if constexpr (DYN) PG8_BAR;
        if constexpr (ALIGN_EPI) { if (wr == 1) PG8_BAR; }
    }
    PG8_WAIT_V(0);
    if constexpr (!ALIGN_EPI) { if (wr == 0) PG8_BAR; }
    PG8_BAR;
#undef PG8_SA
#undef PG8_SB
#undef PG8_STAGE
#undef PG8_LDA
#undef PG8_LDB
#undef PG8_MMA
#undef PG8_WAIT_V
#undef PG8_WAIT_L
#undef PG8_BAR
#undef PG8_SCHED
}
}

#ifndef PG8_SP2
#define PG8_SP2 true
#endif
#ifndef PG8_ALIGN
#define PG8_ALIGN true
#endif

namespace sbk {
#define SB_LAS __attribute__((address_space(3)))
typedef unsigned short bf16;
typedef short bf16x8 __attribute__((ext_vector_type(8)));
typedef short s16x4 __attribute__((ext_vector_type(4)));
typedef float f32x16 __attribute__((ext_vector_type(16)));
typedef float f32x4 __attribute__((ext_vector_type(4)));
typedef unsigned u32x4 __attribute__((ext_vector_type(4)));
constexpr int WAVE_LDS = 16384;
#define SB_KSWZ(row, colB) ((row) * 256 + ((colB) ^ (((row) & 7) << 4)))
__device__ __forceinline__ int v_st(int k, int c) { const int kk = (k & ~0xC) | ((k & 4) << 1) | ((k & 8) >> 1); return ((kk >> 3) * 4 + (c >> 5)) * 512 + ((kk & 7) * 32 + (c & 31)) * 2; }
__device__ __forceinline__ int v_rd_base(int lane) { return ((lane & 3) << 3) | (((lane >> 2) & 3) << 6) | (((lane >> 4) & 1) << 5) | (((lane >> 5) & 1) << 8); }
__device__ __forceinline__ int crow(int r, int hi) { return (r & 3) + 8 * (r >> 2) + 4 * hi; }
__device__ __forceinline__ unsigned cvtpk(float lo, float hi) { return pg8::cvt_pk_bf16(lo, hi); }
__device__ __forceinline__ bf16x8 pack8(f32x4 a, f32x4 b) { u32x4 w = {cvtpk(a[0], a[1]), cvtpk(a[2], a[3]), cvtpk(b[0], b[1]), cvtpk(b[2], b[3])}; return __builtin_bit_cast(bf16x8, w); }

struct Args { const bf16 *Q, *K, *V, *SZA; unsigned char* YA8; const float *ck, *cv; unsigned* queue; };

__device__ __forceinline__ void tile_compute(SB_LAS char* wl, const bf16x8 (&qr)[8], f32x16 (&o)[4], float& R, const bool diag, const int r32, const int hi, const unsigned vb0) {
    f32x16 p = {};
    { const SB_LAS char* kb[4];
#pragma unroll
      for (int dd = 0; dd < 4; ++dd) kb[dd] = wl + SB_KSWZ(r32, (dd * 16 + hi * 8) * 2);
#pragma unroll
      for (int d0 = 0; d0 < 8; ++d0) { const bf16x8 kf = *(const SB_LAS bf16x8*)(kb[d0 & 3] + (d0 >> 2) * 128); p = __builtin_amdgcn_mfma_f32_32x32x16_bf16(kf, qr[d0], p, 0, 0, 0); } }
    if (diag) {
        const float NEG = -__builtin_inff();
#pragma unroll
        for (int r = 0; r < 16; ++r) if (crow(r, hi) >= r32) p[r] = NEG;
    }
    float s[16];
#pragma unroll
    for (int r = 0; r < 16; ++r) { const float z = p[r]; s[r] = fmaxf(z, 0.f) + __builtin_amdgcn_logf(1.0f + __builtin_amdgcn_exp2f(-__builtin_fabsf(z))); }
#pragma unroll
    for (int g = 0; g < 4; ++g) { s[4 * g + 2] += s[4 * g + 3]; s[4 * g + 1] += s[4 * g + 2]; s[4 * g] += s[4 * g + 1]; }
    float E[4], O[4];
#pragma unroll
    for (int g = 0; g < 4; ++g) { auto rr = __builtin_amdgcn_permlane32_swap(__float_as_uint(s[4 * g]), __float_as_uint(s[4 * g]), false, false); E[g] = __uint_as_float(rr[0]); O[g] = __uint_as_float(rr[1]); }
    float T[8]; T[7] = 0.f; T[6] = O[3]; T[5] = T[6] + E[3]; T[4] = T[5] + O[2]; T[3] = T[4] + E[2]; T[2] = T[3] + O[1]; T[1] = T[2] + E[1]; T[0] = T[1] + O[0];
    const float total = T[0] + E[0];
#pragma unroll
    for (int g = 0; g < 4; ++g) { const float base = R + (hi ? T[2 * g + 1] : T[2 * g]);
#pragma unroll
        for (int j = 0; j < 4; ++j) { const int r = 4 * g + j; p[r] = __builtin_amdgcn_exp2f(p[r] - (base + s[r])); } }
    R += total;
    bf16x8 pa0, pa1;
#define SB_PK4(P, B_, OUT) do { unsigned a0 = cvtpk(P[B_+0], P[B_+1]), a1 = cvtpk(P[B_+2], P[B_+3]); unsigned b0 = cvtpk(P[B_+4], P[B_+5]), b1 = cvtpk(P[B_+6], P[B_+7]); \
        auto r0 = __builtin_amdgcn_permlane32_swap(a0, b0, false, false); auto r1 = __builtin_amdgcn_permlane32_swap(a1, b1, false, false); \
        u32x4 w = {r0[0], r1[0], r0[1], r1[1]}; OUT = __builtin_bit_cast(bf16x8, w); } while (0)
    SB_PK4(p, 0, pa0); SB_PK4(p, 8, pa1);
#undef SB_PK4
#define SB_TRRD(dst, off) asm volatile("ds_read_b64_tr_b16 %0, %1 offset:%2" : "=&v"(dst) : "v"(vb0), "i"(off) : "memory")
#pragma unroll
    for (int d0 = 0; d0 < 4; ++d0) {
        s16x4 l0, h0, l1, h1;
        if (d0 == 0) { SB_TRRD(l0, 0); SB_TRRD(h0, 2048); SB_TRRD(l1, 4096); SB_TRRD(h1, 6144); }
        else if (d0 == 1) { SB_TRRD(l0, 512); SB_TRRD(h0, 512 + 2048); SB_TRRD(l1, 512 + 4096); SB_TRRD(h1, 512 + 6144); }
        else if (d0 == 2) { SB_TRRD(l0, 1024); SB_TRRD(h0, 1024 + 2048); SB_TRRD(l1, 1024 + 4096); SB_TRRD(h1, 1024 + 6144); }
        else { SB_TRRD(l0, 1536); SB_TRRD(h0, 1536 + 2048); SB_TRRD(l1, 1536 + 4096); SB_TRRD(h1, 1536 + 6144); }
        asm volatile("s_waitcnt lgkmcnt(0)" ::: "memory"); __builtin_amdgcn_sched_barrier(0);
        o[d0] = __builtin_amdgcn_mfma_f32_32x32x16_bf16(pa0, (bf16x8){l0[0], l0[1], l0[2], l0[3], h0[0], h0[1], h0[2], h0[3]}, o[d0], 0, 0, 0);
        o[d0] = __builtin_amdgcn_mfma_f32_32x32x16_bf16(pa1, (bf16x8){l1[0], l1[1], l1[2], l1[3], h1[0], h1[1], h1[2], h1[3]}, o[d0], 0, 0, 0);
    }
#undef SB_TRRD
}

constexpr int N_SAMPLE_UNITS = 32 * 16 * 2, N_PROMPT_UNITS = 4 * 16 * 64, N_UNITS = N_SAMPLE_UNITS + N_PROMPT_UNITS;
constexpr float PRUNE_LOG2 = 160.0f;

__device__ __forceinline__ void unit(const Args& A, const int id, SB_LAS char* wl, const int lane_in) {
    int lane = lane_in; asm volatile("" : "+v"(lane));
    const int r32 = lane & 31, hi = lane >> 5;
    const unsigned vb0 = (unsigned)(size_t)(wl + 8192) + (unsigned)v_rd_base(lane);
    int qrow0, h, nt_new, nt_cache, b; int krow0;
    if (id < N_SAMPLE_UNITS) { b = id >> 5; h = (id >> 1) & 15; const int half = id & 1; qrow0 = 8192 + b * 64 + half * 32; krow0 = 8192 + b * 64; nt_new = half + 1; nt_cache = 32; }
    else { const int j = id - N_SAMPLE_UNITS; const int g = 7 - (j >> 9), bh = (j & 511) >> 3, qb = g * 8 + (j & 7); b = bh >> 4; h = bh & 15; qrow0 = b * 2048 + qb * 32; krow0 = b * 2048; nt_new = qb + 1; nt_cache = 0; }
    bf16x8 qr[8];
#pragma unroll
    for (int d0 = 0; d0 < 8; ++d0) qr[d0] = *(const bf16x8*)(A.Q + (size_t)(qrow0 + r32) * 2048 + h * 128 + d0 * 16 + hi * 8);
    f32x16 o[4] = {}; float R = 0.f;
    const int NT = nt_new + nt_cache, srow = lane >> 4, sch = lane & 15;
    f32x4 raw[16];
    const unsigned lb16 = (unsigned)(srow * 2048 + sch * 8) * 2u, lb32 = lb16 * 2u;
    SB_LAS char* const kst0 = wl + SB_KSWZ(srow, sch * 16);
    SB_LAS char* const kst1 = wl + SB_KSWZ(4 + srow, sch * 16);
    SB_LAS char* const vst = wl + 8192 + ((sch * 8) >> 5) * 512 + srow * 64 + ((sch * 8) & 31) * 2;
#define SB_VOFF(i) ((((i) & 1) * 2048) + (((i) >> 2) * 4096) + ((((i) >> 1) & 1) * 256))
#define SB_KV_BF16(idx_) ((size_t)(krow0 + 32 * (nt_new - 1 - (idx_))) * 2048 + h * 128)
#define SB_KV_F32(idx_) (((size_t)(b * 1024 + 32 * (nt_cache - 1 - ((idx_) - nt_new))) * 16 + h) * 128)
#define SB_LD_BF16(idx_) do { const char* kt_ = (const char*)(A.K + SB_KV_BF16(idx_)); const char* vt_ = (const char*)(A.V + SB_KV_BF16(idx_)); _Pragma("unroll") for (int i = 0; i < 8; ++i) { \
        raw[i] = *(const f32x4*)(kt_ + (size_t)i * 16384 + lb16); raw[8 + i] = *(const f32x4*)(vt_ + (size_t)i * 16384 + lb16); } } while (0)
#define SB_LD_F32(P_, idx_) do { const char* t_ = (const char*)((P_) + SB_KV_F32(idx_)); _Pragma("unroll") for (int i = 0; i < 8; ++i) { \
        raw[2 * i] = *(const f32x4*)(t_ + (size_t)i * 32768 + lb32); raw[2 * i + 1] = *(const f32x4*)(t_ + (size_t)i * 32768 + lb32 + 16); } } while (0)
    bool live = true;
    if (live) SB_LD_BF16(0);
#pragma clang loop unroll(disable)
    for (int idx = 0; idx < NT && live; ++idx) {
        if (idx < nt_new) {
#pragma unroll
            for (int i = 0; i < 8; ++i) { *(SB_LAS f32x4*)(((i & 1) ? kst1 : kst0) + (i & ~1) * 1024) = raw[i]; *(SB_LAS f32x4*)(vst + SB_VOFF(i)) = raw[8 + i]; }
        } else {
#pragma unroll
            for (int i = 0; i < 8; ++i) *(SB_LAS bf16x8*)(((i & 1) ? kst1 : kst0) + (i & ~1) * 1024) = pack8(raw[2 * i], raw[2 * i + 1]);
            SB_LD_F32(A.cv, idx);
#pragma unroll
            for (int i = 0; i < 8; ++i) *(SB_LAS bf16x8*)(vst + SB_VOFF(i)) = pack8(raw[2 * i], raw[2 * i + 1]);
        }
        if (idx + 1 < NT) { if (idx + 1 < nt_new) SB_LD_BF16(idx + 1); else SB_LD_F32(A.ck, idx + 1); }
        tile_compute(wl, qr, o, R, idx == 0, r32, hi, vb0);
        if (SB_PRUNE) live = !__all(R > PRUNE_LOG2);
    }
#undef SB_VOFF
#undef SB_KV_BF16
#undef SB_KV_F32
#undef SB_LD_BF16
#undef SB_LD_F32
    asm volatile("s_waitcnt lgkmcnt(0)" ::: "memory");
    int lz = lane; asm volatile("" : "+v"(lz));
    { SB_LAS char* ob = wl + ((lz >> 5) * 4 * 128 + (lz & 31)) * 4;
#pragma unroll
      for (int d0 = 0; d0 < 4; ++d0)
#pragma unroll
        for (int r = 0; r < 16; ++r) *(SB_LAS float*)(ob + (((r & 3) + 8 * (r >> 2)) * 128 + d0 * 32) * 4) = o[d0][r]; }
    asm volatile("s_waitcnt lgkmcnt(0)" ::: "memory");
    const int rr = lz >> 4, ch = lz & 15;
#pragma unroll
    for (int i = 0; i < 8; ++i) { const int q = 4 * i + rr;
        const f32x4 a = *(const SB_LAS f32x4*)(wl + (q * 128 + ch * 8) * 4), c = *(const SB_LAS f32x4*)(wl + (q * 128 + ch * 8 + 4) * 4);
        const size_t go = (size_t)(qrow0 + q) * 2048 + h * 128 + ch * 8;
        const u32x4 z = *(const u32x4*)(A.SZA + go);
        const f32x4 ya = a * (f32x4){pg8::bf_lo(z.x), pg8::bf_hi(z.x), pg8::bf_lo(z.y), pg8::bf_hi(z.y)}, yc = c * (f32x4){pg8::bf_lo(z.z), pg8::bf_hi(z.z), pg8::bf_lo(z.w), pg8::bf_hi(z.w)};
        *(pg8::u32x2*)(A.YA8 + go) = pg8::pack8_fp8(ya * pg8::SC_Y, yc * pg8::SC_Y); }
    asm volatile("s_waitcnt lgkmcnt(0)" ::: "memory");
}

__device__ __forceinline__ void attn_phase(const Args& A, SB_LAS char* lds, const int wave, const int lane, unsigned* queue, const int id0, const int n) {
    SB_LAS char* wl = lds + wave * WAVE_LDS;
    for (;;) {
        unsigned id = 0;
        if (lane == 0) id = __hip_atomic_fetch_add(queue, 1u, __ATOMIC_RELAXED, __HIP_MEMORY_SCOPE_AGENT);
        id = (unsigned)__builtin_amdgcn_readfirstlane((int)id);
        if (id >= (unsigned)n) break;
        unit(A, id0 + (int)id, wl, lane);
    }
}
}

constexpr int NWAVES = 8;
constexpr int N_LAUNCHES = MK_N_LAUNCHES;
constexpr int PER_PHASE = 6;

constexpr int DM = 4096, NIN = 24576, WB = 2048;
constexpr int MP = 8192, MS = 2048, M = MP + MS;
constexpr int NB16 = 4096, NF8 = 20480;
constexpr float LN_EPS = 1e-5f;
constexpr float DN_ALPHA = 1.189207115002721f;

constexpr size_t MiB = 1u << 20;
constexpr size_t WS_CTL = 0, CTL_ZERO_BYTES = 1 * MiB;
constexpr size_t WS_WINB = 1 * MiB;
constexpr size_t WS_WCH = WS_WINB + 32 * MiB;
constexpr size_t WS_XG = WS_WCH + 32 * MiB;
constexpr size_t WS_WIN8 = WS_XG + 2 * MiB;
constexpr size_t WS_WA8 = WS_WIN8 + 80 * MiB;
constexpr size_t WS_WB8 = WS_WA8 + 8 * MiB;
constexpr size_t WS_WO8 = WS_WB8 + 8 * MiB;
constexpr size_t WS_XB = WS_WO8 + 16 * MiB;
constexpr size_t WS_X8 = WS_XB + 80 * MiB;
constexpr size_t WS_Q = WS_X8 + 40 * MiB, WS_K = WS_Q + 40 * MiB, WS_V = WS_K + 40 * MiB, WS_SZA = WS_V + 40 * MiB, WS_U = WS_SZA + 40 * MiB, WS_GT = WS_U + 40 * MiB;
constexpr size_t WS_SGA = WS_GT + 40 * MiB, WS_SGB = WS_SGA + 80 * MiB;
constexpr size_t WS_YA8 = WS_SGB + 80 * MiB, WS_YB8 = WS_YA8 + 20 * MiB;
constexpr size_t WS_M1 = WS_YB8 + 20 * MiB;
constexpr size_t WS_MG8 = WS_M1 + 80 * MiB;
constexpr size_t WS_PRE = WS_MG8 + 40 * MiB;
constexpr size_t WS_END = WS_PRE + 80 * MiB;
static_assert(WS_END < (size_t)0x7fffffff, "every GEMM operand must be addressable as a 31-bit byte offset from the workspace base");
constexpr int CW_TMO = 0, CW_CODE = 1, CW_QUEUE = 64;
constexpr int CW_ONCEX = 2880;
constexpr int CW_P1A = 1024, CW_P1B = 1536, CW_P0B = 2048, CW_PM = 2112, CW_QZ = 2752, CW_KV = 2816, CW_CONVQ = 128;
constexpr int CW_BAR = 4096;

constexpr int RING_OFF = 0, RING_BYTES = 131072;
constexpr int LDS_BYTES = 147456;
constexpr int LDSCTL_OFF = LDS_BYTES - 512, MISC_OFF = LDSCTL_OFF + 320;
constexpr int P0_WAVE_LDS = 128 * 33 * 4;
static_assert(8 * P0_WAVE_LDS <= LDSCTL_OFF, "LDS map");
static_assert(MISC_OFF + 128 <= LDS_BYTES, "LDS map");

#define GAS __attribute__((address_space(1)))
#define LAS __attribute__((address_space(3)))
typedef unsigned short bf16;
typedef unsigned v4u __attribute__((ext_vector_type(4)));
typedef unsigned v2u __attribute__((ext_vector_type(2)));
typedef float f32x4 __attribute__((ext_vector_type(4)));
typedef GAS unsigned gu32;
#define RLX_AGENT __ATOMIC_RELAXED, __HIP_MEMORY_SCOPE_AGENT
#define LDS_WAIT() asm volatile("s_waitcnt lgkmcnt(0)" ::: "memory")
#define VM_WAIT() asm volatile("s_waitcnt vmcnt(0)" ::: "memory")

#define XB_TMO      128
#define XB_XCNT(j)  (256  + 64 * (j))
#define XB_XSUB(j)  (1280 + 64 * (j))
#define XB_XGEN(j)  (2304 + 64 * (j))
#define XB_TOP      3328
#define XB_TOPGEN   3392
#define XCD_BAR_WORDS 3456
#define XB_SPIN_CAP (1u << 18)

__device__ __forceinline__ unsigned xb_ld(unsigned* p)              { return __hip_atomic_load(p, __ATOMIC_RELAXED, __HIP_MEMORY_SCOPE_AGENT); }
__device__ __forceinline__ unsigned xb_add(unsigned* p, unsigned v) { return __hip_atomic_fetch_add(p, v, __ATOMIC_RELAXED, __HIP_MEMORY_SCOPE_AGENT); }
__device__ __forceinline__ unsigned xb_xcc_id() { return (unsigned)__builtin_amdgcn_s_getreg((3 << 11) | 20) & 0xFu; }
#define XB_SPIN(cond, bar) do { unsigned _sp = 0; while (cond) { __builtin_amdgcn_s_sleep(1); \
    if ((++_sp & 255u) == 0u) { if (xb_ld(&(bar)[XB_TMO])) break; if (_sp > XB_SPIN_CAP) { atomicAdd(&(bar)[XB_TMO], 1u); break; } } } } while (0)

struct XcdBarrier {
    unsigned* bar; unsigned x;
    volatile LAS unsigned* st;
};
__device__ __forceinline__ XcdBarrier xcd_barrier_post(unsigned* bar, volatile LAS unsigned* st) {
    XcdBarrier b; b.bar = bar; b.x = xb_xcc_id(); b.st = st;
    if (threadIdx.x == 0) (void)xb_add(&bar[XB_XCNT(b.x)], 1u);
    return b;
}
__device__ __forceinline__ void xcd_barrier_complete(unsigned* bar, unsigned x, unsigned& nloc, unsigned& nx) {
    const unsigned G = gridDim.x * gridDim.y * gridDim.z;
    unsigned sum, cnt, mine, sp = 0u;
    for (;;) {
        sum = 0u; cnt = 0u; mine = 0u;
#pragma unroll
        for (unsigned j = 0; j < 16; ++j) { const unsigned c = xb_ld(&bar[XB_XCNT(j)]); sum += c; cnt += (c > 0u) ? 1u : 0u; mine = (j == x) ? c : mine; }
        if (sum == G) break;
        __builtin_amdgcn_s_sleep(1);
        if ((++sp & 255u) == 0u) { if (xb_ld(&bar[XB_TMO])) break; if (sp > XB_SPIN_CAP) { atomicAdd(&bar[XB_TMO], 1u); break; } }
    }
    nloc = mine > 0u ? mine : 1u; nx = cnt > 0u ? cnt : 1u;
}
__device__ __forceinline__ void xcd_barrier(const XcdBarrier& b) {
    asm volatile("s_waitcnt vmcnt(0)" ::: "memory");
    __syncthreads();
    if (threadIdx.x == 0) {
        unsigned* bar = b.bar;
        __builtin_amdgcn_s_waitcnt(0);
        unsigned nloc = b.st[0], nx = b.st[1];
        if (nloc == 0u) { xcd_barrier_complete(bar, b.x, nloc, nx); b.st[0] = nloc; b.st[1] = nx; }
        const unsigned old = xb_add(&bar[XB_XSUB(b.x)], 1u);
        const unsigned gen = old / nloc;
        if (old + 1u == (gen + 1u) * nloc) {
            __builtin_amdgcn_fence(__ATOMIC_RELEASE, "agent");
            asm volatile("s_waitcnt vmcnt(0)" ::: "memory");
            const unsigned og = xb_add(&bar[XB_TOP], 1u);
            const unsigned tg = og / nx;
            if (og + 1u == (tg + 1u) * nx) xb_add(&bar[XB_TOPGEN], 1u);
            else XB_SPIN(xb_ld(&bar[XB_TOPGEN]) == tg, bar);
            __builtin_amdgcn_fence(__ATOMIC_ACQUIRE, "agent");
            xb_add(&bar[XB_XGEN(b.x)], 1u);
            asm volatile("s_waitcnt vmcnt(0)" ::: "memory");
        } else {
            XB_SPIN(xb_ld(&bar[XB_XGEN(b.x)]) == gen, bar);
            __builtin_amdgcn_fence(__ATOMIC_ACQUIRE, "agent");
            asm volatile("s_waitcnt vmcnt(0)" ::: "memory");
        }
    }
    __syncthreads();
}

__device__ __forceinline__ float wave_sum(float v) {
#pragma unroll
    for (int o = 1; o < 64; o <<= 1) v += __shfl_xor(v, o);
    return v;
}
__device__ __forceinline__ void win_dest_row(int n, int& r8, int& r16, int& which) {
    r8 = -1; r16 = -1; which = 0;
    if (n < 2048) { r8 = n; return; }
    if (n < 4096) { r16 = n - 2048; return; }
    if (n < 6144) { r16 = 2048 + (n - 4096); return; }
    if (n < 8192) { r8 = 2048 + (n - 6144); return; }
    if (n < 16384) { const int sg = (n - 8192) >> 11, ch = (n - 8192) & 2047, i = ch >> 7, o = ch & 127;
        if (sg == 1 || sg == 2) { const int r = i * 256 + ((sg == 2) ? 128 : 0) + o; r8 = 4096 + r; r16 = r; which = 1; }
        else r8 = 8192 + i * 256 + ((sg == 3) ? 128 : 0) + o;
        return; }
    r8 = 12288 + (n - 16384);
}
struct P0Item { const float* src; int N, K, k0, n0, mode; unsigned char* dst; unsigned char* dstch; unsigned char* dst8; float scale; };
__device__ __forceinline__ void p0_load(const P0Item& d, f32x4 (&v)[16], int lane) {
    const int kr = lane >> 3, nq = lane & 7;
    const float* p = d.src + (size_t)(d.k0 + kr) * d.N + d.n0 + 4 * nq;
#pragma unroll
    for (int i = 0; i < 16; ++i) v[i] = __builtin_nontemporal_load((const f32x4*)(p + (size_t)(8 * i) * d.N));
}
__device__ __forceinline__ void p0_store(const P0Item& d, const f32x4 (&v)[16], LAS float* scr, int lane) {
    const int kr = lane >> 3, nq = lane & 7;
#pragma unroll
    for (int i = 0; i < 16; ++i) { LAS float* q = scr + (8 * i + kr) * 33 + 4 * nq; q[0] = v[i].x; q[1] = v[i].y; q[2] = v[i].z; q[3] = v[i].w; }
    LDS_WAIT(); asm volatile("" ::: "memory");
    const int c = lane & 15;
    int r8 = d.n0, r16 = -1, which = 0;
    if (d.mode == 2) win_dest_row(d.n0, r8, r16, which);
    bf16* const d16 = (bf16*)(which ? d.dstch : d.dst);
#pragma unroll
    for (int j = 0; j < 8; ++j) { const int n = (lane >> 4) + 4 * j; const LAS float* s = scr + (8 * c) * 33 + n;
        const f32x4 a = {s[0 * 33], s[1 * 33], s[2 * 33], s[3 * 33]}, b = {s[4 * 33], s[5 * 33], s[6 * 33], s[7 * 33]};
        if (r8 >= 0) *(GAS v2u*)(d.dst8 + (size_t)(r8 + n) * d.K + d.k0 + 8 * c) = pg8::pack8_fp8(a * d.scale, b * d.scale);
        if (r16 >= 0) *(GAS v4u*)(d16 + (size_t)(r16 + n) * d.K + d.k0 + 8 * c) = pg8::pack8(a, b); }
    LDS_WAIT(); asm volatile("" ::: "memory");
}

struct KArgs { const float* in[14]; float* out; unsigned char* ws; int ph_lo, ph_hi; };
typedef const KArgs __attribute__((address_space(4))) * KArgsPtr;
template <int SET> __device__ __forceinline__ P0Item p0_decode(int it, const float* w_in, const float* w_a, const float* w_b, const float* w_o, unsigned char* ws) {
    constexpr int KB = DM / 128, I_A = (WB / 128) * (DM / 32);
    P0Item d; int r = it, nb;
    d.src = w_in; d.N = NIN; d.K = DM; d.mode = 2; d.dst = ws + WS_WINB; d.dstch = ws + WS_WCH; d.dst8 = ws + WS_WIN8; d.scale = pg8::SC_WIN;
    if (SET == 0) { nb = r % 256; nb = nb < 128 ? 64 + nb : 320 + (nb - 128); d.k0 = 128 * (r / 256); d.n0 = 32 * nb; return d; }
    if (r < KB * 512) { nb = r % 512; nb = nb < 64 ? nb : nb < 192 ? 192 + (nb - 64) : 448 + (nb - 192); d.k0 = 128 * (r / 512); d.n0 = 32 * nb; return d; }
    r -= KB * 512; d.mode = 1; d.dst = nullptr; d.dstch = nullptr; d.N = DM;
    if (r < I_A) { d.src = w_a; d.K = WB; d.dst8 = ws + WS_WA8; d.scale = pg8::SC_WAB; }
    else if ((r -= I_A) < I_A) { d.src = w_b; d.K = WB; d.dst8 = ws + WS_WB8; d.scale = pg8::SC_WAB; }
    else { r -= I_A; d.src = w_o; d.K = DM; d.dst8 = ws + WS_WO8; d.scale = pg8::SC_WO; }
    d.k0 = 128 * (r / (DM / 32)); d.n0 = 32 * (r % (DM / 32)); return d;
}
template <int SET> __device__ __forceinline__ void p0_weights(KArgsPtr ap, unsigned char* ws, LAS float* scr, int lane, int w0, int wn) {
    constexpr int NITEMS = SET == 0 ? (DM / 128) * 256 : (DM / 128) * 512 + 2 * (WB / 128) * (DM / 32) + (DM / 128) * (DM / 32);
    const float *w_in = ap->in[5], *w_a = ap->in[9], *w_b = ap->in[10], *w_o = ap->in[11];
    f32x4 cur[16], nxt[16];
    int it = w0;
    if (it < NITEMS) { const P0Item d = p0_decode<SET>(it, w_in, w_a, w_b, w_o, ws); p0_load(d, cur, lane); }
    while (it < NITEMS) {
        const int itn = it + wn;
        if (itn < NITEMS) { const P0Item dn = p0_decode<SET>(itn, w_in, w_a, w_b, w_o, ws); p0_load(dn, nxt, lane); }
        { const P0Item d = p0_decode<SET>(it, w_in, w_a, w_b, w_o, ws); p0_store(d, cur, scr, lane); }
#pragma unroll
        for (int i = 0; i < 16; ++i) cur[i] = nxt[i];
        it = itn;
    }
}
template <int WHICH> __device__ __forceinline__ void p0_x(KArgsPtr ap, unsigned char* ws, size_t gt, size_t NT) {
    const float *x = ap->in[0], *xs = ap->in[1];
    const size_t NX = (size_t)M * DM / 16;
    for (size_t i0 = gt; i0 < NX; i0 += 4 * NT) {
        f32x4 a[4], b[4], c[4], d[4];
#pragma unroll
        for (int u = 0; u < 4; ++u) { const size_t i = i0 + u * NT; if (i < NX) { const size_t e = i * 16; const float* src = (e < (size_t)MP * DM) ? x + e : xs + (e - (size_t)MP * DM);
            a[u] = __builtin_nontemporal_load((const f32x4*)src); b[u] = __builtin_nontemporal_load((const f32x4*)(src + 4)); c[u] = __builtin_nontemporal_load((const f32x4*)(src + 8)); d[u] = __builtin_nontemporal_load((const f32x4*)(src + 12)); } }
#pragma unroll
        for (int u = 0; u < 4; ++u) { const size_t i = i0 + u * NT; if (i < NX) { const size_t e = i * 16;
            if (WHICH & 1) { *(pg8::u32x4*)((bf16*)(ws + WS_XB) + e) = pg8::pack8(a[u], b[u]); *(pg8::u32x4*)((bf16*)(ws + WS_XB) + e + 8) = pg8::pack8(c[u], d[u]); }
            if (WHICH & 2) { const pg8::u32x2 p = pg8::pack8_fp8(a[u], b[u]), q = pg8::pack8_fp8(c[u], d[u]); *(pg8::u32x4*)(ws + WS_X8 + e) = (pg8::u32x4){p.x, p.y, q.x, q.y}; } } }
    }
    if (WHICH & 1) {
        for (size_t i = gt; i < (size_t)256 * (DM / 8); i += NT) {
            const int row = (int)(i >> 9), c8 = (int)(i & 511) * 8;
            pg8::u32x4 w = {0u, 0u, 0u, 0u};
            if (row < 72) { const float* src = (row < 8) ? x + ((size_t)((row >> 1) * 2048 + 2046 + (row & 1))) * DM + c8 : xs + ((size_t)(((row - 8) >> 1) * 64 + 62 + (row & 1))) * DM + c8;
                w = pg8::pack8(*(const f32x4*)src, *(const f32x4*)(src + 4)); }
            *(pg8::u32x4*)((bf16*)(ws + WS_XG) + (size_t)row * DM + c8) = w;
        }
    }
}
#define PHASE_ARGS() KArgsPtr ap = (KArgsPtr)__builtin_amdgcn_kernarg_segment_ptr(); asm volatile("" : "+s"(ap)); unsigned char* const ws = ap->ws; \
    const __amdgpu_buffer_rsrc_t rsrc = __builtin_amdgcn_make_buffer_rsrc((void*)ws, 0, 0x7fffffff, 0x00020000)

__global__ void __launch_bounds__(NWAVES * 64, 2) mk_fwd(const KArgs args) {
    extern __shared__ __attribute__((aligned(16))) unsigned char lds_raw[];
    LAS unsigned char* const lds = (LAS unsigned char*)lds_raw;
    volatile LAS unsigned* const MISC = (volatile LAS unsigned*)(lds + MISC_OFF);
    const int wave = __builtin_amdgcn_readfirstlane((int)threadIdx.x >> 6);
#define LANE_TID() int lane = (int)__builtin_amdgcn_mbcnt_hi(~0u, __builtin_amdgcn_mbcnt_lo(~0u, 0u)); asm volatile("" : "+v"(lane)); const int tid = wave * 64 + lane; (void)tid
    int tid0 = threadIdx.x;
    const int G = gridDim.x, vcu = (G % 8 == 0) ? ((int)blockIdx.x % 8) * (G / 8) + (int)blockIdx.x / 8 : (int)blockIdx.x;
    gu32* const ctl = (gu32*)(args.ws + WS_CTL);
    for (int u = tid0; u < (LDS_BYTES - LDSCTL_OFF) / 4; u += NWAVES * 64) ((LAS unsigned*)(lds + LDSCTL_OFF))[u] = 0u;
    __syncthreads();
    XcdBarrier bar; bar.bar = (unsigned*)(ctl + CW_BAR); bar.x = 0; bar.st = nullptr;
    if (N_LAUNCHES != PER_PHASE) bar = xcd_barrier_post((unsigned*)(ctl + CW_BAR), MISC + 8);
#define GRID_BAR(seam) do { if (N_LAUNCHES == PER_PHASE) { if (threadIdx.x == 0) __hip_atomic_store(ctl + CW_TMO, 0xBADBA0u | (unsigned)(seam), RLX_AGENT); } else { xcd_barrier(bar); } } while (0)
    const int lo = args.ph_lo, hi = args.ph_hi;
#define IN(k) (lo <= (k) && (k) < hi)
#define BOTH(k) (IN(k) && IN((k) + 1))
    const int gw = vcu * NWAVES + wave, NGW = G * NWAVES;

    constexpr int NCX = 8;
    const bool dynp1 = (G == 32 * pg8::NXCD);
    const bool early_attn = dynp1 && (lo <= 1 && 2 < hi);
    if (IN(0)) {
        PHASE_ARGS(); (void)rsrc; LANE_TID();
        LAS float* scr = (LAS float*)(lds + wave * P0_WAVE_LDS);
        p0_weights<0>(ap, ws, scr, lane, gw, NGW);
        p0_x<3>(ap, ws, (size_t)blockIdx.x * (NWAVES * 64) + tid, (size_t)G * NWAVES * 64);
        if (!dynp1) p0_weights<1>(ap, ws, scr, lane, gw, NGW);
        if (BOTH(0)) GRID_BAR(0);
    }

    if (IN(1)) {
        if (dynp1) {
            const int xq = (int)blockIdx.x % pg8::NXCD, rho = (int)blockIdx.x / pg8::NXCD, NGX = 32 - NCX;
            gu32* const done = ctl + CW_P0B;
            if (rho >= NGX) {
                { PHASE_ARGS(); (void)rsrc; LANE_TID();
                  LAS float* scr = (LAS float*)(lds + wave * P0_WAVE_LDS);
                  const int cb = (rho - NGX) * pg8::NXCD + xq;
                  p0_weights<1>(ap, ws, scr, lane, cb * NWAVES + wave, NCX * pg8::NXCD * NWAVES); }
                asm volatile("s_waitcnt vmcnt(0)" ::: "memory");
                __syncthreads();
                { LANE_TID(); if (wave == 0 && lane == 0) { __builtin_amdgcn_fence(__ATOMIC_RELEASE, "agent"); asm volatile("s_waitcnt vmcnt(0)" ::: "memory"); (void)__hip_atomic_fetch_add(done, 1u, RLX_AGENT); } }
            } else {
                PHASE_ARGS();
                pg8::Sched S; S.init(M / 256, NB16 / 256, G, (int)blockIdx.x, 0, 0, WS_XB, WS_XG, WS_WINB, WS_WCH, DM * 2); S.nextra = 16;
                pg8::EpiProjB E{ap->in[6], (bf16*)(ws + WS_K), (bf16*)(ws + WS_V), ap->out, nullptr};
                const pg8::Dyn D{(unsigned*)(ctl + CW_P1A + 64 * xq), xq, rho, NGX, MISC + 16, nullptr, 0, nullptr, 1u};
                pg8::gemm_phase<pg8::EpiProjB, PG8_ALIGN, PG8_SP2, false, true>(lds + RING_OFF, wave, rsrc, DM * 2, DM * 2, S, E, D);
            }
            { LANE_TID(); if (wave == 0 && lane == 0) { unsigned sp = 0; while (__hip_atomic_load(done, RLX_AGENT) < (unsigned)(NCX * pg8::NXCD)) { __builtin_amdgcn_s_sleep(4); if (++sp > (1u << 22)) break; }
                  __builtin_amdgcn_fence(__ATOMIC_ACQUIRE, "agent"); } }
            __syncthreads();
            { PHASE_ARGS();
              pg8::Sched S; S.init(M / 256, NF8 / 256, G, (int)blockIdx.x, 0, 0, WS_X8, WS_X8, WS_WIN8, WS_WIN8, DM);
              S.il = 1;
              pg8::EpiProj8 E{ap->in[6], (bf16*)(ws + WS_Q), (bf16*)(ws + WS_SZA), (bf16*)(ws + WS_U), (bf16*)(ws + WS_GT), (bf16*)(ws + WS_SGA), (bf16*)(ws + WS_SGB), nullptr};
              const pg8::Dyn D{(unsigned*)(ctl + CW_P1B + 64 * xq), xq, rho, 32, MISC + 16, early_attn ? (unsigned*)(ctl + CW_QZ) : nullptr, 320, (unsigned*)(ctl + CW_ONCEX + 64 * (int)bar.x), (unsigned)MISC[8]};
              pg8::gemm_phase<pg8::EpiProj8, PG8_ALIGN, PG8_SP2, true, true>(lds + RING_OFF, wave, rsrc, DM, DM, S, E, D); }
            if (early_attn) { LANE_TID(); if (wave == 0 && lane == 0) { unsigned sp = 0;
                  while (__hip_atomic_load(ctl + CW_QZ, RLX_AGENT) < (unsigned)G) { __builtin_amdgcn_s_sleep(4); if (++sp > (1u << 22)) break; }
                  __builtin_amdgcn_fence(__ATOMIC_ACQUIRE, "agent"); } }
            __syncthreads();

        } else {
            { PHASE_ARGS();
              pg8::Sched S; S.init(M / 256, NB16 / 256, G, (int)blockIdx.x, 0, 0, WS_XB, WS_XG, WS_WINB, WS_WCH, DM * 2); S.nextra = 16;
              pg8::EpiProjB E{ap->in[6], (bf16*)(ws + WS_K), (bf16*)(ws + WS_V), ap->out, nullptr};
              pg8::gemm_phase<pg8::EpiProjB, PG8_ALIGN, PG8_SP2, false>(lds + RING_OFF, wave, rsrc, DM * 2, DM * 2, S, E); }
            { PHASE_ARGS();
              pg8::Sched S; S.init(M / 256, NF8 / 256, G, (int)blockIdx.x, 0, 0, WS_X8, WS_X8, WS_WIN8, WS_WIN8, DM);
              pg8::EpiProj8 E{ap->in[6], (bf16*)(ws + WS_Q), (bf16*)(ws + WS_SZA), (bf16*)(ws + WS_U), (bf16*)(ws + WS_GT), (bf16*)(ws + WS_SGA), (bf16*)(ws + WS_SGB), nullptr};
              pg8::gemm_phase<pg8::EpiProj8, PG8_ALIGN, PG8_SP2, true>(lds + RING_OFF, wave, rsrc, DM, DM, S, E); }
        }
        if (BOTH(1) && !early_attn) GRID_BAR(1);
    }

    if (IN(2)) {
        PHASE_ARGS(); (void)rsrc; LANE_TID();
        { const sbk::Args A{(const bf16*)(ws + WS_Q), (const bf16*)(ws + WS_K), (const bf16*)(ws + WS_V), (const bf16*)(ws + WS_SZA), ws + WS_YA8, ap->in[2], ap->in[3], (unsigned*)(ctl + CW_QUEUE)};
          SB_LAS char* wl = (LAS char*)(lds + RING_OFF) + wave * sbk::WAVE_LDS;
          bool passed = !early_attn;
          for (;;) {
              unsigned t = 0;
              if (lane == 0) t = __hip_atomic_fetch_add(A.queue, 1u, __ATOMIC_RELAXED, __HIP_MEMORY_SCOPE_AGENT);
              t = (unsigned)__builtin_amdgcn_readfirstlane((int)t);
              if (t >= (unsigned)sbk::N_PROMPT_UNITS && !passed) { GRID_BAR(1); passed = true; }
              if (t >= (unsigned)sbk::N_UNITS) break;
              sbk::unit(A, t < (unsigned)sbk::N_PROMPT_UNITS ? sbk::N_SAMPLE_UNITS + (int)t : (int)t - sbk::N_PROMPT_UNITS, wl, lane);
          } }
        const float *state_conv = ap->in[4], *conv_w = ap->in[7], *conv_b = ap->in[8];
        const bf16 *Ub = (const bf16*)(ws + WS_U), *GT = (const bf16*)(ws + WS_GT);
        const size_t NI = (size_t)M * (WB / 8);
        size_t cbase = 0; int kk = 16;
        for (;;) {
            size_t i;
            if (early_attn) {
                if (kk == 16) { unsigned cq = 0; if (lane == 0) cq = __hip_atomic_fetch_add(ctl + CW_CONVQ, 1u, RLX_AGENT); cq = (unsigned)__builtin_amdgcn_readfirstlane((int)cq); cbase = (size_t)cq * 1024; kk = 0; }
                if (cbase >= NI) break;
                i = cbase + (size_t)kk * 64 + lane; ++kk;
            } else { i = (size_t)blockIdx.x * (NWAVES * 64) + tid + cbase; cbase += (size_t)G * NWAVES * 64; if (i >= NI) break; }
            const int row = (int)(i >> 8), c = (int)(i & 255) * 8;
            int t, sb = 0; const bool samp = row >= MP;
            if (samp) { t = (row - MP) & 63; sb = (row - MP) >> 6; } else t = row & 2047;
            const pg8::u32x4 u2 = *(const pg8::u32x4*)(Ub + (size_t)row * WB + c), gg = *(const pg8::u32x4*)(GT + (size_t)row * WB + c);
            float xm1[8], xm2[8], x0[8], g[8];
            const unsigned uw[4] = {u2.x, u2.y, u2.z, u2.w}, gw4[4] = {gg.x, gg.y, gg.z, gg.w};
#pragma unroll
            for (int k = 0; k < 4; ++k) { x0[2 * k] = pg8::bf_lo(uw[k]); x0[2 * k + 1] = pg8::bf_hi(uw[k]); g[2 * k] = pg8::bf_lo(gw4[k]); g[2 * k + 1] = pg8::bf_hi(gw4[k]); }
            if (t >= 1) { const pg8::u32x4 v = *(const pg8::u32x4*)(Ub + (size_t)(row - 1) * WB + c); const unsigned w[4] = {v.x, v.y, v.z, v.w};
#pragma unroll
                for (int k = 0; k < 4; ++k) { xm1[2 * k] = pg8::bf_lo(w[k]); xm1[2 * k + 1] = pg8::bf_hi(w[k]); } }
            else {
#pragma unroll
                for (int k = 0; k < 8; ++k) xm1[k] = samp ? state_conv[(size_t)(sb * 2 + 1) * WB + c + k] : 0.f; }
            if (t >= 2) { const pg8::u32x4 v = *(const pg8::u32x4*)(Ub + (size_t)(row - 2) * WB + c); const unsigned w[4] = {v.x, v.y, v.z, v.w};
#pragma unroll
                for (int k = 0; k < 4; ++k) { xm2[2 * k] = pg8::bf_lo(w[k]); xm2[2 * k + 1] = pg8::bf_hi(w[k]); } }
            else {
#pragma unroll
                for (int k = 0; k < 8; ++k) xm2[k] = samp ? state_conv[(size_t)(sb * 2 + t) * WB + c + k] : 0.f; }
            float y[8];
#pragma unroll
            for (int k = 0; k < 8; ++k) y[k] = pg8::SC_Y * g[k] * (conv_b[c + k] + conv_w[c + k] * xm2[k] + conv_w[WB + c + k] * xm1[k] + conv_w[2 * WB + c + k] * x0[k]);
            *(pg8::u32x2*)(ws + WS_YB8 + (size_t)row * WB + c) = pg8::pack8_fp8((f32x4){y[0], y[1], y[2], y[3]}, (f32x4){y[4], y[5], y[6], y[7]});
        }
        if (BOTH(2)) GRID_BAR(2);
    }

    const bool rm34 = dynp1 && BOTH(3);
    if (IN(3)) {
        PHASE_ARGS();
        pg8::Sched S; S.init(M / 256, DM / 256, G, (int)blockIdx.x, 1, 0, WS_YA8, WS_YB8, WS_WA8, WS_WB8, WB);
        if (rm34) { S.rm = 1; S.rho = (int)blockIdx.x / pg8::NXCD; S.xq = (int)blockIdx.x % pg8::NXCD; }
        pg8::EpiMerge E{(const bf16*)(ws + WS_SGA), (const bf16*)(ws + WS_SGB), (bf16*)(ws + WS_M1), ws + WS_MG8, rsrc, (unsigned)WS_MG8, rm34 ? (unsigned*)(ctl + CW_PM) : nullptr};
        pg8::gemm_phase<pg8::EpiMerge, PG8_ALIGN, PG8_SP2, true>(lds + RING_OFF, wave, rsrc, WB, WB, S, E);
        if (BOTH(3) && !rm34) GRID_BAR(3);
    }

    if (IN(4)) {
        PHASE_ARGS();
        pg8::Sched S; S.init(M / 256, DM / 256, G, (int)blockIdx.x, 0, 0, WS_MG8, WS_MG8, WS_WO8, WS_WO8, DM);
        if (rm34) {
            S.rm = 2; S.rho = (int)blockIdx.x / pg8::NXCD; S.xq = (int)blockIdx.x % pg8::NXCD;
            { LANE_TID(); if (wave == 0 && lane == 0) {
                  const int rho = (int)blockIdx.x / pg8::NXCD, xq = (int)blockIdx.x % pg8::NXCD, nu = rho >= 16 ? 3 : 2, p0 = rho >= 16 ? rho - 16 : 48 + rho;
                  for (int k = 0; k < nu; ++k) { const int pp = p0 + 16 * k, pm = pp < 64 ? 8 * (2 * (pp >> 5) + (xq >> 2)) + (pp & 7) : 32 + ((pp - 64) & 7); unsigned sp = 0;
                      while (__hip_atomic_load(ctl + CW_PM + 16 * pm, RLX_AGENT) < 16u) { __builtin_amdgcn_s_sleep(4); if (++sp > (1u << 22)) break; } }
                  __builtin_amdgcn_fence(__ATOMIC_ACQUIRE, "agent"); } }
            __syncthreads();
        }
        pg8::EpiOut E{(const bf16*)(ws + WS_XB), (bf16*)(ws + WS_PRE), DN_ALPHA};
        pg8::gemm_phase<pg8::EpiOut, PG8_ALIGN, PG8_SP2, true>(lds + RING_OFF, wave, rsrc, DM, DM, S, E);
        if (BOTH(4)) GRID_BAR(4);
    }

    if (IN(5)) {
        PHASE_ARGS(); (void)rsrc; LANE_TID();
        const float *ln_g = ap->in[12], *ln_b = ap->in[13]; float* out = ap->out;
        for (int m = gw; m < M; m += NGW) {
            const pg8::u32x4* rp = (const pg8::u32x4*)((const bf16*)(ws + WS_PRE) + (size_t)m * DM) + lane;
            f32x4 v[16]; float s = 0.f;
#pragma unroll
            for (int j = 0; j < 8; ++j) { const pg8::u32x4 w = rp[64 * j]; v[2 * j] = pg8::bf4_lo(w); v[2 * j + 1] = pg8::bf4_hi(w); }
#pragma unroll
            for (int j = 0; j < 16; ++j) s += (v[j].x + v[j].y) + (v[j].z + v[j].w);
            const float mean = wave_sum(s) * (1.f / DM); float s2 = 0.f;
#pragma unroll
            for (int j = 0; j < 16; ++j) { v[j] = v[j] - mean; s2 += (v[j].x * v[j].x + v[j].y * v[j].y) + (v[j].z * v[j].z + v[j].w * v[j].w); }
            const float rstd = 1.f / sqrtf(wave_sum(s2) * (1.f / DM) + LN_EPS);
            float* orow = out + pg8::OUT_Y + (size_t)m * DM;
#pragma unroll
            for (int j = 0; j < 16; ++j) { const int e = ((j >> 1) * 64 + lane) * 8 + (j & 1) * 4;
                const f32x4 g = *(const f32x4*)(ln_g + e), bb = *(const f32x4*)(ln_b + e); *(GAS f32x4*)(orow + e) = v[j] * rstd * g + bb; }
        }
    }
#undef IN
#undef BOTH
}

extern "C" void kernel_launch(void* const* d_in, const int* in_sizes, int n_in, void* d_out, int out_size, void* d_ws, size_t ws_size, hipStream_t stream) {
    static int grid = 0;
    if (grid == 0) {
        if (n_in != 14 || (size_t)out_size != pg8::OUT_TOTAL || ws_size < WS_END) { fprintf(stderr, "kernel_launch: unexpected problem (n_in %d, out %d, ws %zu; need ws >= %zu); nothing launched\n", n_in, out_size, ws_size, (size_t)WS_END); grid = -1; return; }
        int dev = 0, cus = 0, per_cu = 0;
        if (hipGetDevice(&dev) != hipSuccess || hipDeviceGetAttribute(&cus, hipDeviceAttributeMultiprocessorCount, dev) != hipSuccess) { fprintf(stderr, "kernel_launch: device query failed\n"); grid = -1; return; }
        if (hipFuncSetAttribute((const void*)mk_fwd, hipFuncAttributeMaxDynamicSharedMemorySize, LDS_BYTES) != hipSuccess) { fprintf(stderr, "kernel_launch: hipFuncSetAttribute failed\n"); grid = -1; return; }
        if (hipOccupancyMaxActiveBlocksPerMultiprocessor(&per_cu, (const void*)mk_fwd, NWAVES * 64, LDS_BYTES) != hipSuccess || per_cu < 1) { fprintf(stderr, "kernel_launch: occupancy query reports %d workgroups per CU\n", per_cu); }
        (void)hipGetLastError();
        grid = cus;
    }
    if (grid < 0) return;
    if (hipMemsetAsync((char*)d_ws + WS_CTL, 0, CTL_ZERO_BYTES, stream) != hipSuccess) { fprintf(stderr, "kernel_launch: hipMemsetAsync failed\n"); return; }
    KArgs a{};
    for (int i = 0; i < 14; ++i) a.in[i] = (const float*)d_in[i];
    a.out = (float*)d_out; a.ws = (unsigned char*)d_ws;
    if (N_LAUNCHES == 1) {
        a.ph_lo = 0; a.ph_hi = PER_PHASE;
        hipLaunchKernelGGL(mk_fwd, dim3(grid), dim3(NWAVES * 64), LDS_BYTES, stream, a);
    } else {
        for (int li = 0; li < PER_PHASE; ++li) { a.ph_lo = li; a.ph_hi = li + 1; hipLaunchKernelGGL(mk_fwd, dim3(grid), dim3(NWAVES * 64), LDS_BYTES, stream, a); }
    }
    const hipError_t le = hipPeekAtLastError();
    if (le != hipSuccess) fprintf(stderr, "kernel_launch: launch failed: %s\n", hipGetErrorName(le));
}
```

```cpp
#include <hip/hip_runtime.h>
#include <cstdio>
#include <cstdint>

#ifndef MK_N_LAUNCHES
#define MK_N_LAUNCHES 1
#endif
#ifndef SB_PRUNE
#define SB_PRUNE 1
#endif

namespace pg8 {
#define PG8_LAS __attribute__((address_space(3)))
typedef unsigned short bf16_t;
typedef short bf16x8 __attribute__((ext_vector_type(8)));
typedef float f32x4 __attribute__((ext_vector_type(4)));
typedef unsigned u32x4 __attribute__((ext_vector_type(4)));
constexpr int BM = 256, BK = 64, HALF = 128, HTB = HALF * BK * 2  , STAGE_BYTES = 8 * HTB, NXCD = 8, WGM = 8;

__host__ __device__ __forceinline__ int lds_byte(int r, int c) { const int st = (r >> 4) * 2 + (c >> 5), rr = r & 15, cc = c & 31, ob = rr * 64 + cc * 2; return st * 1024 + (ob ^ (((ob >> 9) & 1) << 5)); }
__host__ __device__ __forceinline__ void stage_rc(int b, int& R, int& C) { const int st = b / 1024, sb = b % 1024, swz = sb ^ (((sb >> 9) & 1) << 5); R = (st >> 1) * 16 + swz / 64; C = (st & 1) * 32 + (swz % 64) / 2; }
__host__ __device__ __forceinline__ int perm32(int rho) { const int n = rho >> 4, i = rho & 15; return 8 * (i >> 2) + 4 * n + (i & 3); }

struct Unit { int pm, pn, z; };

struct Sched {
    int nM, nN, nwg, G, c, zmode, pm0;
    int il;
    int rm, rho, xq;
    int nextra;
    int tail_c0;
    unsigned A0, A1, B0, B1, tstep;
    __device__ void init(int nM_, int nN_, int G_, int c_, int zmode_, int pm0_, size_t a0, size_t a1, size_t b0, size_t b1, int LDb) {
        nM = nM_; nN = nN_; nwg = nM * nN; G = G_; c = c_; zmode = zmode_; pm0 = pm0_; nextra = 0; tail_c0 = -1; rm = 0; rho = 0; xq = 0; il = 0; A0 = (unsigned)a0; A1 = (unsigned)a1; B0 = (unsigned)b0; B1 = (unsigned)b1; tstep = (unsigned)(BM * LDb); }
    __device__ bool next(int i, Unit& u) const {
        int ii = i, z = 0;
        if (zmode == 1) { ii = i >> 1; z = i & 1; }
        if (rm) {
            int p;
            if (rm == 1) { if (ii < 2) p = 32 * ii + rho; else if (ii == 2 && rho < 16) p = 64 + rho; else return false; }
            else if (rho >= 16) { if (ii > 2) return false; p = rho - 16 + 16 * ii; } else { if (ii > 1) return false; p = 48 + rho + 16 * ii; }
            return rm_at(p, u, z);
        }
        long L = (long)ii * G + c;
        if (tail_c0 >= 0) { const int full = nwg / G; if (ii >= full) { if (c < tail_c0) return false; const long idx = (long)(ii - full) * (G - tail_c0) + (c - tail_c0); if (idx >= nwg - (long)full * G) return false; L = (long)full * G + idx; } }
        return at(L, u, z);
    }
    __device__ bool rm_at(int p, Unit& u, int z) const {
        if (p < 64) { const int r = p >> 5, q = p & 31; u.pm = pm0 + 8 * (2 * r + (xq >> 2)) + (q & 7); u.pn = 4 * (xq & 3) + (q >> 3); }
        else { const int q = p - 64; u.pm = pm0 + 32 + (q & 7); u.pn = 2 * xq + (q >> 3); }
        u.z = z; return true;
    }
    __device__ bool at(long L, Unit& u, int z = 0) const {
        if (il) {
            const int k = (int)(L / NXCD), x = (int)(L % NXCD);
            if (k >= 400) return false;
            if (k < 384) { const int blk = 8 * (k >> 5) + x, q = k & 31, g = blk / 20, j = blk % 20; u.pm = pm0 + 8 * g + (q & 7); u.pn = 4 * j + (q >> 3); }
            else { const int q = k - 384; u.pm = pm0 + 32 + (q & 7); u.pn = 64 + 2 * x + (q >> 3); }
            u.z = z; return true;
        }
        if (L >= nwg) { if (L >= nwg + nextra) return false; u.pm = 0; u.pn = (int)(L - nwg); u.z = 1; return true; }
        int wgid = (int)L; { const int q = nwg / NXCD, r = nwg % NXCD, xcd = wgid % NXCD, off = wgid / NXCD; wgid = (xcd < r ? xcd * (q + 1) : r * (q + 1) + (xcd - r) * q) + off; }
        const int nig = WGM * nN, gid = wgid / nig, fm = gid * WGM, gsz = (nM - fm) < WGM ? (nM - fm) : WGM;
        u.pm = pm0 + fm + ((wgid % nig) % gsz); u.pn = (wgid % nig) / gsz; u.z = z; return true;
    }
    __device__ __forceinline__ unsigned ptrA(const Unit& u) const { return (u.z ? A1 : A0) + (unsigned)u.pm * tstep; }
    __device__ __forceinline__ unsigned ptrB(const Unit& u) const { return (u.z ? B1 : B0) + (unsigned)u.pn * tstep; }
};

typedef __bf16 bf16v2_t __attribute__((ext_vector_type(2)));
typedef float f32v2_t __attribute__((ext_vector_type(2)));
__device__ __forceinline__ unsigned cvt_pk_bf16(float lo, float hi) { const bf16v2_t r = __builtin_convertvector((f32v2_t){lo, hi}, bf16v2_t); return __builtin_bit_cast(unsigned, r); }
__device__ __forceinline__ u32x4 pack8(const f32x4 a, const f32x4 b) { u32x4 w; w.x = cvt_pk_bf16(a[0], a[1]); w.y = cvt_pk_bf16(a[2], a[3]); w.z = cvt_pk_bf16(b[0], b[1]); w.w = cvt_pk_bf16(b[2], b[3]); return w; }
__device__ __forceinline__ float bf_lo(unsigned w) { return __uint_as_float(w << 16); }
__device__ __forceinline__ float bf_hi(unsigned w) { return __uint_as_float(w & 0xffff0000u); }
__device__ __forceinline__ float sigmoid_f(float v) { return __builtin_amdgcn_rcpf(1.0f + __builtin_amdgcn_exp2f(-1.4426950408889634f * v)); }
__device__ __forceinline__ f32x4 sigmoid4(f32x4 v) { return (f32x4){sigmoid_f(v[0]), sigmoid_f(v[1]), sigmoid_f(v[2]), sigmoid_f(v[3])}; }
__device__ __forceinline__ f32x4 silu4(f32x4 v) { return v * sigmoid4(v); }


constexpr size_t OUT_Y = 0, OUT_KP = 41943040, OUT_VP = 58720256, OUT_CP = 75497472, OUT_KS = 75513856, OUT_VS = 79708160, OUT_CS = 83902464, OUT_TOTAL = 84033536;
constexpr float QSCALE = 0.08838834764831845f * 1.4426950408889634f;

typedef unsigned u32x2 __attribute__((ext_vector_type(2)));
__device__ __forceinline__ float clamp8(float v) { return __builtin_amdgcn_fmed3f(v, -448.0f, 448.0f); }
__device__ __forceinline__ unsigned cvt4_fp8(const f32x4 a) { unsigned w = __builtin_amdgcn_cvt_pk_fp8_f32(clamp8(a[0]), clamp8(a[1]), 0, false); return __builtin_amdgcn_cvt_pk_fp8_f32(clamp8(a[2]), clamp8(a[3]), w, true); }
__device__ __forceinline__ u32x2 pack8_fp8(const f32x4 a, const f32x4 b) { u32x2 w; w.x = cvt4_fp8(a); w.y = cvt4_fp8(b); return w; }
constexpr float SC_WIN = 64.f, SC_WAB = 64.f, SC_WO = 128.f, SC_Y = 4.f, SC_MG = 8.f;

struct EpiProjB {
    static constexpr bool PERM = true, AFTER_DRAIN = false;
    const float* bias;
    bf16_t *K, *V;
    float* out;
    unsigned* sig;
    __device__ __forceinline__ unsigned* sig_ptr(const Unit& u) const { return (sig != nullptr && u.z == 0 && u.pm < 32) ? sig + 16 * (u.pm >> 3) : nullptr; }
    __device__ __forceinline__ void operator()(const f32x4 (&acc)[2][2][4][2], const Unit& u, int wr, int wc, int fr, int fq) const {
        const int pn = u.pn, cl = wc * 32 + 8 * fq;
        if (u.z == 0) {
            const int row0 = u.pm * BM + wr * 64 + fr;
            const bool isv = pn >= 8; const int c0 = (pn & 7) * BM + cl;
            const float* bp = bias + (isv ? 4096 : 2048) + c0;
            f32x4 bv[2][2];
#pragma unroll
            for (int bj = 0; bj < 2; ++bj)
#pragma unroll
                for (int n = 0; n < 2; ++n) bv[bj][n] = *(const f32x4*)(bp + bj * HALF + 4 * n);
            bf16_t* B = isv ? V : K;
            float* O = (u.pm < 32) ? out + (isv ? OUT_VP : OUT_KP) : out + (isv ? OUT_VS : OUT_KS) - (size_t)8192 * 2048;
#pragma unroll
            for (int ai = 0; ai < 2; ++ai)
#pragma unroll
                for (int m = 0; m < 4; ++m) { const size_t ro = (size_t)(row0 + ai * HALF + m * 16) * 2048 + c0;
#pragma unroll
                    for (int bj = 0; bj < 2; ++bj) { const f32x4 v0 = acc[ai][bj][m][0] + bv[bj][0], v1 = acc[ai][bj][m][1] + bv[bj][1];
                        *(u32x4*)(B + ro + bj * HALF) = pack8(v0, v1); *(f32x4*)(O + ro + bj * HALF) = v0; *(f32x4*)(O + ro + bj * HALF + 4) = v1; } }
        } else {
            const int ch = pn * HALF + cl;
            f32x4 bc[2], bh[2];
#pragma unroll
            for (int n = 0; n < 2; ++n) { bc[n] = *(const f32x4*)(bias + 10240 + ch + 4 * n); bh[n] = *(const f32x4*)(bias + 12288 + ch + 4 * n); }
#pragma unroll
            for (int ai = 0; ai < 1; ++ai)
#pragma unroll
                for (int m = 0; m < 4; ++m) { const int row = wr * 64 + m * 16 + fr;
                    if (row < 72) { float* cp = (row < 8) ? out + OUT_CP + (size_t)row * 2048 + ch : out + OUT_CS + (size_t)(row - 8) * 2048 + ch;
                        *(f32x4*)cp = (acc[0][0][m][0] + bc[0]) * (acc[0][1][m][0] + bh[0]); *(f32x4*)(cp + 4) = (acc[0][0][m][1] + bc[1]) * (acc[0][1][m][1] + bh[1]); } }
        }
    }
};

struct EpiProj8 {
    static constexpr bool PERM = true, AFTER_DRAIN = false;
    const float* bias;
    bf16_t *Q, *SZA, *U, *GT, *SGA, *SGB;
    unsigned* sig;
    __device__ __forceinline__ unsigned* sig_ptr(const Unit& u) const { return (sig != nullptr && u.pn < 16 && u.pm < 32) ? sig + 16 * (u.pm >> 3) : nullptr; }
    __device__ __forceinline__ void operator()(const f32x4 (&acc)[2][2][4][2], const Unit& u, int wr, int wc, int fr, int fq) const {
        const int pn = u.pn, row0 = u.pm * BM + wr * 64 + fr, cl = wc * 32 + 8 * fq;
        constexpr float DS = 1.0f / SC_WIN;
        if (pn >= 16 && pn < 32) {
            const int ch = (pn - 16) * HALF + cl;
            f32x4 bc[2], bh[2];
#pragma unroll
            for (int n = 0; n < 2; ++n) { bc[n] = *(const f32x4*)(bias + 10240 + ch + 4 * n); bh[n] = *(const f32x4*)(bias + 12288 + ch + 4 * n); }
#pragma unroll
            for (int ai = 0; ai < 2; ++ai)
#pragma unroll
                for (int m = 0; m < 4; ++m) { const int row = row0 + ai * HALF + m * 16;
                    *(u32x4*)(U + (size_t)row * 2048 + ch) = pack8((acc[ai][0][m][0] * DS + bc[0]) * (acc[ai][1][m][0] * DS + bh[0]), (acc[ai][0][m][1] * DS + bc[1]) * (acc[ai][1][m][1] * DS + bh[1])); }
        } else if (pn >= 32 && pn < 48) {
            const int ch = (pn - 32) * HALF + cl;
            f32x4 bb[2], bz[2];
#pragma unroll
            for (int n = 0; n < 2; ++n) { bb[n] = *(const f32x4*)(bias + 8192 + ch + 4 * n); bz[n] = *(const f32x4*)(bias + 14336 + ch + 4 * n); }
#pragma unroll
            for (int ai = 0; ai < 2; ++ai)
#pragma unroll
                for (int m = 0; m < 4; ++m) { const int row = row0 + ai * HALF + m * 16;
                    const f32x4 g0 = (acc[ai][0][m][0] * DS + bb[0]) * silu4(acc[ai][1][m][0] * DS + bz[0]), g1 = (acc[ai][0][m][1] * DS + bb[1]) * silu4(acc[ai][1][m][1] * DS + bz[1]);
                    *(u32x4*)(GT + (size_t)row * 2048 + ch) = pack8(g0, g1); }
        } else {
            int kind, c0, ld, sb; bf16_t* B;
            if (pn < 8) { kind = 0; c0 = pn * BM + cl; sb = c0; ld = 2048; B = Q; }
            else if (pn < 16) { kind = 1; c0 = (pn - 8) * BM + cl; sb = 6144 + c0; ld = 2048; B = SZA; }
            else if (pn < 64) { kind = 2; c0 = (pn - 48) * BM + cl; sb = 16384 + c0; ld = 4096; B = SGA; }
            else { kind = 2; c0 = (pn - 64) * BM + cl; sb = 20480 + c0; ld = 4096; B = SGB; }
            f32x4 bv[2][2];
#pragma unroll
            for (int bj = 0; bj < 2; ++bj)
#pragma unroll
                for (int n = 0; n < 2; ++n) bv[bj][n] = *(const f32x4*)(bias + sb + bj * HALF + 4 * n);
#pragma unroll
            for (int ai = 0; ai < 2; ++ai)
#pragma unroll
                for (int m = 0; m < 4; ++m) { bf16_t* rowp = B + (size_t)(row0 + ai * HALF + m * 16) * ld + c0;
#pragma unroll
                    for (int bj = 0; bj < 2; ++bj) { f32x4 v0 = acc[ai][bj][m][0] * DS + bv[bj][0], v1 = acc[ai][bj][m][1] * DS + bv[bj][1];
                        if (kind == 0) { v0 = v0 * QSCALE; v1 = v1 * QSCALE; } else if (kind == 1) { v0 = silu4(v0); v1 = silu4(v1); } else { v0 = sigmoid4(v0); v1 = sigmoid4(v1); }
                        *(u32x4*)(rowp + bj * HALF) = pack8(v0, v1); } }
        }
    }
};

__device__ __forceinline__ f32x4 bf4_lo(const u32x4 w) { return (f32x4){bf_lo(w.x), bf_hi(w.x), bf_lo(w.y), bf_hi(w.y)}; }
__device__ __forceinline__ f32x4 bf4_hi(const u32x4 w) { return (f32x4){bf_lo(w.z), bf_hi(w.z), bf_lo(w.w), bf_hi(w.w)}; }
struct EpiMerge {
    static constexpr bool PERM = true, AFTER_DRAIN = false;
    const bf16_t *SGA, *SGB; bf16_t* M1; unsigned char* MG8; __amdgpu_buffer_rsrc_t wsr; unsigned offMG8;
    unsigned* sig;
    __device__ __forceinline__ unsigned* sig_ptr(const Unit& u) const { return (sig != nullptr && u.z == 1) ? sig + 16 * u.pm : nullptr; }
    __device__ __forceinline__ void operator()(const f32x4 (&acc)[2][2][4][2], const Unit& u, int wr, int wc, int fr, int fq) const {
        const int row0 = u.pm * BM + wr * 64 + fr, col0 = u.pn * BM + wc * 32 + 8 * fq;
        const bf16_t* SG = u.z ? SGB : SGA;
        constexpr float DS = 1.0f / (SC_Y * SC_WAB);
#pragma unroll
        for (int ai = 0; ai < 2; ++ai) {
            u32x4 g[4][2], mv[4][2];
#pragma unroll
            for (int m = 0; m < 4; ++m)
#pragma unroll
                for (int bj = 0; bj < 2; ++bj) { const size_t ro = (size_t)(row0 + ai * HALF + m * 16) * 4096 + col0 + bj * HALF;
                    g[m][bj] = *(const u32x4*)(SG + ro); if (u.z) mv[m][bj] = *(const u32x4*)(M1 + ro); }
#pragma unroll
            for (int m = 0; m < 4; ++m)
#pragma unroll
                for (int bj = 0; bj < 2; ++bj) { const size_t ro = (size_t)(row0 + ai * HALF + m * 16) * 4096 + col0 + bj * HALF;
                    f32x4 v0 = acc[ai][bj][m][0] * DS * bf4_lo(g[m][bj]), v1 = acc[ai][bj][m][1] * DS * bf4_hi(g[m][bj]);
                    if (u.z == 0) *(u32x4*)(M1 + ro) = pack8(v0, v1);
                    else { v0 = v0 + bf4_lo(mv[m][bj]); v1 = v1 + bf4_hi(mv[m][bj]); __builtin_amdgcn_raw_buffer_store_b64(pack8_fp8(v0 * SC_MG, v1 * SC_MG), wsr, (int)(offMG8 + (unsigned)ro), 0, 16  ); } }
        }
    }
};

struct EpiOut {
    static constexpr bool PERM = true, AFTER_DRAIN = false;
    const bf16_t* XB; bf16_t* PRE; float alpha;
    __device__ __forceinline__ void operator()(const f32x4 (&acc)[2][2][4][2], const Unit& u, int wr, int wc, int fr, int fq) const {
        const int row0 = u.pm * BM + wr * 64 + fr, col0 = u.pn * BM + wc * 32 + 8 * fq;
        constexpr float DS = 1.0f / (SC_MG * SC_WO);
#pragma unroll
        for (int ai = 0; ai < 2; ++ai) {
            u32x4 xv[4][2];
#pragma unroll
            for (int m = 0; m < 4; ++m)
#pragma unroll
                for (int bj = 0; bj < 2; ++bj) xv[m][bj] = *(const u32x4*)(XB + (size_t)(row0 + ai * HALF + m * 16) * 4096 + col0 + bj * HALF);
#pragma unroll
            for (int m = 0; m < 4; ++m)
#pragma unroll
                for (int bj = 0; bj < 2; ++bj) { const size_t ro = (size_t)(row0 + ai * HALF + m * 16) * 4096 + col0 + bj * HALF;
                    *(u32x4*)(PRE + ro) = pack8(bf4_lo(xv[m][bj]) * alpha + acc[ai][bj][m][0] * DS, bf4_hi(xv[m][bj]) * alpha + acc[ai][bj][m][1] * DS); }
        }
    }
};

typedef int v8i_t __attribute__((ext_vector_type(8)));
struct Dyn { unsigned* ctr; int x, first, base; volatile PG8_LAS unsigned* slot; unsigned* once; int once_k; unsigned* once_x; unsigned once_nloc; };
template <class T> struct has_sig { static constexpr bool v = false; };
template <> struct has_sig<EpiMerge> { static constexpr bool v = true; };

template <class Epi, bool ALIGN_EPI = false, bool SP2 = false, bool F8 = false, bool DYN = false>
__device__ __forceinline__ void gemm_phase(PG8_LAS unsigned char* lds, const int wave_sgpr, const __amdgpu_buffer_rsrc_t rsrc, const int LDb, const int Kb, const Sched& S, const Epi& E, const Dyn D = Dyn{nullptr, 0, 0, 0, nullptr, nullptr, 0, nullptr, 1u}) {
    int lane_ = (int)__builtin_amdgcn_mbcnt_hi(~0u, __builtin_amdgcn_mbcnt_lo(~0u, 0u)); asm volatile("" : "+v"(lane_));
    const int wid = wave_sgpr, lane = lane_, tid = wid * 64 + lane, wr = wid >> 2, wc = wid & 3, fr = lane & 15, fq = lane >> 4;
    const int nt = Kb / 128;
    unsigned voffA[2], voffB[2];
#pragma unroll
    for (int i = 0; i < 2; ++i) { int R, C; stage_rc(tid * 16 + i * 8192, R, C); const int Rb = Epi::PERM ? ((R & ~31) + perm32(R & 31)) : R;
        voffA[i] = (unsigned)(R * LDb + C * 2); voffB[i] = (unsigned)(Rb * LDb + C * 2); }
    const unsigned kstep = 128u;
    const unsigned hstep = (unsigned)(HALF * LDb);
    const unsigned ldsw = (unsigned)wid * 1024u;
    constexpr int KOFF = 1024;
    const int aoff = lds_byte(wr * 64 + fr, fq * 8), boff = lds_byte(wc * 32 + fr, fq * 8);
#define PG8_SA(b, h) (((b) * 2 + (h)) * HTB)
#define PG8_SB(b, h) ((4 + (b) * 2 + (h)) * HTB)
#define PG8_STAGE(bufoff, gbase, voff) do { _Pragma("unroll") for (int _i = 0; _i < 2; ++_i) \
        __builtin_amdgcn_raw_ptr_buffer_load_lds(rsrc, (PG8_LAS void*)(lds + (bufoff) + ldsw + _i * 8192), 16, (int)(voff)[_i], (int)(gbase), 0, 0); } while (0)
#define PG8_LDA(dst, b, h) do { _Pragma("unroll") for (int m = 0; m < 4; ++m) _Pragma("unroll") for (int k = 0; k < 2; ++k) dst[m][k] = *(const PG8_LAS bf16x8*)(lds + PG8_SA(b, h) + aoff + m * 2048 + k * KOFF); } while (0)
#define PG8_LDB(dst, b, h) do { _Pragma("unroll") for (int n = 0; n < 2; ++n) _Pragma("unroll") for (int k = 0; k < 2; ++k) dst[n][k] = *(const PG8_LAS bf16x8*)(lds + PG8_SB(b, h) + boff + n * 2048 + k * KOFF); } while (0)
#define PG8_MMA(ai, bj, At, Bt) do { __builtin_amdgcn_s_setprio(1); _Pragma("unroll") for (int m = 0; m < 4; ++m) _Pragma("unroll") for (int n = 0; n < 2; ++n) { \
        if constexpr (F8) { typedef int v4i_t __attribute__((ext_vector_type(4))); \
            const v8i_t pa = __builtin_shufflevector(__builtin_bit_cast(v4i_t, At[m][0]), __builtin_bit_cast(v4i_t, At[m][1]), 0, 1, 2, 3, 4, 5, 6, 7); \
            const v8i_t pb = __builtin_shufflevector(__builtin_bit_cast(v4i_t, Bt[n][0]), __builtin_bit_cast(v4i_t, Bt[n][1]), 0, 1, 2, 3, 4, 5, 6, 7); \
            acc[ai][bj][m][n] = __builtin_amdgcn_mfma_scale_f32_16x16x128_f8f6f4(pb, pa, acc[ai][bj][m][n], 0, 0, 0, 0, 0, 0); } \
        else { _Pragma("unroll") for (int k = 0; k < 2; ++k) acc[ai][bj][m][n] = __builtin_amdgcn_mfma_f32_16x16x32_bf16(Bt[n][k], At[m][k], acc[ai][bj][m][n], 0, 0, 0); } } \
        __builtin_amdgcn_s_setprio(0); } while (0)
#define PG8_WAIT_V(n) asm volatile("s_waitcnt vmcnt(" #n ")" ::: "memory")
#define PG8_WAIT_L(n) asm volatile("s_waitcnt lgkmcnt(" #n ")" ::: "memory")
#define PG8_BAR __builtin_amdgcn_s_barrier()
#define PG8_SCHED __builtin_amdgcn_sched_barrier(0)
    Unit cur, nxt; int ui = 0; bool once_done = false;
    if constexpr (DYN) {
        if (!S.at((long)D.first * NXCD + D.x, cur)) return;
        if (wid == 0) { if (lane == 0) { const unsigned t = __hip_atomic_fetch_add(D.ctr, 1u, __ATOMIC_RELAXED, __HIP_MEMORY_SCOPE_AGENT) + (unsigned)D.base; *D.slot = t; } asm volatile("s_waitcnt lgkmcnt(0)" ::: "memory"); }
        __builtin_amdgcn_s_barrier();
    } else { if (!S.next(0, cur)) return; }
    f32x4 acc[2][2][4][2];
#pragma unroll
    for (int a = 0; a < 2; ++a)
#pragma unroll
        for (int b = 0; b < 2; ++b)
#pragma unroll
            for (int m = 0; m < 4; ++m)
#pragma unroll
                for (int n = 0; n < 2; ++n) acc[a][b][m][n] = (f32x4){0.f, 0.f, 0.f, 0.f};
    bf16x8 At[4][2], B0[2][2], B1[2][2];
    unsigned cA = S.ptrA(cur), cB = S.ptrB(cur);
    if constexpr (SP2) {
        PG8_STAGE(PG8_SB(0, 0), cB, voffB); PG8_STAGE(PG8_SB(0, 1), cB + hstep, voffB); PG8_STAGE(PG8_SA(0, 0), cA, voffA); PG8_STAGE(PG8_SA(0, 1), cA + hstep, voffA);
        if (wr == 1) PG8_BAR;
        PG8_WAIT_V(2); PG8_BAR;
        PG8_STAGE(PG8_SB(1, 0), cB + kstep, voffB); PG8_STAGE(PG8_SA(1, 0), cA + kstep, voffA); PG8_STAGE(PG8_SB(1, 1), cB + hstep + kstep, voffB);
        PG8_WAIT_V(6); PG8_BAR;
    } else {
        PG8_STAGE(PG8_SB(0, 0), cB, voffB); PG8_STAGE(PG8_SA(0, 0), cA, voffA); PG8_STAGE(PG8_SB(0, 1), cB + hstep, voffB); PG8_STAGE(PG8_SA(0, 1), cA + hstep, voffA);
        if (wr == 1) PG8_BAR;
        PG8_WAIT_V(4); PG8_BAR;
        PG8_STAGE(PG8_SB(1, 0), cB + kstep, voffB); PG8_STAGE(PG8_SA(1, 0), cA + kstep, voffA); PG8_STAGE(PG8_SB(1, 1), cB + hstep + kstep, voffB);
        PG8_WAIT_V(6); PG8_BAR;
    }
    for (;;) {
        bool has_next;
        unsigned tn = 0;
        if constexpr (DYN) { tn = (unsigned)__builtin_amdgcn_readfirstlane((int)*D.slot); has_next = S.at((long)tn * NXCD + D.x, nxt); }
        else has_next = S.next(ui + 1, nxt);
        const unsigned nA = has_next ? S.ptrA(nxt) : cA, nB = has_next ? S.ptrB(nxt) : cB;
        for (int t = 0; t < nt; t += 2) {
            const bool last = (t == nt - 2);
            const unsigned a1 = cA + (unsigned)(t + 1) * kstep;
            const unsigned a2 = last ? nA : cA + (unsigned)(t + 2) * kstep, b2 = last ? nB : cB + (unsigned)(t + 2) * kstep;
            const unsigned a3 = a2 + kstep, b3 = b2 + kstep;
            if constexpr (SP2) {
            PG8_LDB(B0, 0, 0); PG8_LDB(B1, 0, 1); PG8_SCHED; PG8_LDA(At, 0, 0); PG8_STAGE(PG8_SA(1, 1), a1 + hstep, voffA);
            PG8_WAIT_V(8); PG8_WAIT_L(0); PG8_BAR; PG8_MMA(0, 0, At, B0); PG8_MMA(0, 1, At, B1); PG8_BAR; PG8_SCHED;
            PG8_LDA(At, 0, 1); PG8_STAGE(PG8_SB(0, 0), b2, voffB); PG8_STAGE(PG8_SB(0, 1), b2 + hstep, voffB); PG8_STAGE(PG8_SA(0, 0), a2, voffA);
            PG8_WAIT_V(8); PG8_WAIT_L(0); PG8_BAR; PG8_MMA(1, 0, At, B0); PG8_MMA(1, 1, At, B1); PG8_BAR; PG8_SCHED;
            PG8_LDB(B0, 1, 0); PG8_LDB(B1, 1, 1); PG8_SCHED; PG8_LDA(At, 1, 0); PG8_STAGE(PG8_SA(0, 1), a2 + hstep, voffA);
            PG8_WAIT_V(8); PG8_WAIT_L(0); PG8_BAR; PG8_MMA(0, 0, At, B0); PG8_MMA(0, 1, At, B1); PG8_BAR; PG8_SCHED;
            PG8_LDA(At, 1, 1); PG8_STAGE(PG8_SB(1, 0), b3, voffB); PG8_STAGE(PG8_SB(1, 1), b3 + hstep, voffB); PG8_STAGE(PG8_SA(1, 0), a3, voffA);
            PG8_WAIT_V(8); PG8_WAIT_L(0); PG8_BAR; PG8_MMA(1, 0, At, B0); PG8_MMA(1, 1, At, B1); PG8_BAR; PG8_SCHED;
            } else {
            PG8_LDB(B0, 0, 0); PG8_SCHED; PG8_LDA(At, 0, 0); PG8_STAGE(PG8_SA(1, 1), a1 + hstep, voffA);
            PG8_WAIT_L(8); PG8_BAR; PG8_WAIT_L(0); PG8_MMA(0, 0, At, B0); PG8_BAR; PG8_SCHED;
            PG8_LDB(B1, 0, 1); PG8_STAGE(PG8_SB(0, 0), b2, voffB);
            PG8_BAR; PG8_WAIT_L(0); PG8_MMA(0, 1, At, B1); PG8_BAR;
            PG8_LDA(At, 0, 1); PG8_STAGE(PG8_SA(0, 0), a2, voffA);
            PG8_BAR; PG8_WAIT_L(0); PG8_MMA(1, 0, At, B0); PG8_BAR; PG8_SCHED;
            PG8_STAGE(PG8_SB(0, 1), b2 + hstep, voffB);
            PG8_WAIT_V(6); PG8_BAR; PG8_MMA(1, 1, At, B1); PG8_BAR;
            PG8_LDB(B0, 1, 0); PG8_SCHED; PG8_LDA(At, 1, 0); PG8_STAGE(PG8_SA(0, 1), a2 + hstep, voffA);
            PG8_WAIT_L(8); PG8_BAR; PG8_WAIT_L(0); PG8_MMA(0, 0, At, B0); PG8_BAR; PG8_SCHED;
            PG8_LDB(B1, 1, 1); PG8_STAGE(PG8_SB(1, 0), b3, voffB);
            PG8_BAR; PG8_WAIT_L(0); PG8_MMA(0, 1, At, B1); PG8_BAR;
            PG8_LDA(At, 1, 1); PG8_STAGE(PG8_SA(1, 0), a3, voffA);
            PG8_BAR; PG8_WAIT_L(0); PG8_MMA(1, 0, At, B0); PG8_BAR; PG8_SCHED;
            PG8_STAGE(PG8_SB(1, 1), b3 + hstep, voffB);
            PG8_WAIT_V(6); PG8_BAR; PG8_MMA(1, 1, At, B1); PG8_BAR;
            }
        }
        if constexpr (ALIGN_EPI) { if (wr == 0) PG8_BAR; }
        { int lz = (int)__builtin_amdgcn_mbcnt_hi(~0u, __builtin_amdgcn_mbcnt_lo(~0u, 0u)); asm volatile("" : "+v"(lz));
          unsigned tk2 = 0x7fffffffu;
          if constexpr (DYN) { if (has_next && wid == 0 && lz == 0) tk2 = __hip_atomic_fetch_add(D.ctr, 1u, __ATOMIC_RELAXED, __HIP_MEMORY_SCOPE_AGENT) + (unsigned)D.base; }
          E(acc, cur, wr, wc, lz & 15, lz >> 4);
          __builtin_amdgcn_s_waitcnt(0x0F70);
          if constexpr (DYN) { if (wid == 0) { int l2 = (int)__builtin_amdgcn_mbcnt_hi(~0u, __builtin_amdgcn_mbcnt_lo(~0u, 0u)); asm volatile("" : "+v"(l2)); if (l2 == 0) *D.slot = tk2; asm volatile("s_waitcnt lgkmcnt(0)" ::: "memory"); } } }
        if constexpr (DYN) {
            if (D.once != nullptr && !once_done && (!has_next || tn >= (unsigned)D.once_k)) {
                once_done = true;
                PG8_BAR;
                if (wid == 0) { int l4 = (int)__builtin_amdgcn_mbcnt_hi(~0u, __builtin_amdgcn_mbcnt_lo(~0u, 0u)); asm volatile("" : "+v"(l4));
                    if (l4 == 0) {
                        if (D.once_nloc <= 1u) { __builtin_amdgcn_fence(__ATOMIC_RELEASE, "agent"); (void)__hip_atomic_fetch_add(D.once, 1u, __ATOMIC_RELAXED, __HIP_MEMORY_SCOPE_AGENT); }
                        else if (__hip_atomic_fetch_add(D.once_x, 1u, __ATOMIC_RELAXED, __HIP_MEMORY_SCOPE_AGENT) + 1u == D.once_nloc) {
                            __builtin_amdgcn_fence(__ATOMIC_RELEASE, "agent"); (void)__hip_atomic_fetch_add(D.once, D.once_nloc, __ATOMIC_RELAXED, __HIP_MEMORY_SCOPE_AGENT); } } }
            }
        }
        if constexpr (has_sig<Epi>::v) {
            unsigned* const sp = E.sig_ptr(cur);
            if (sp != nullptr) {
                PG8_BAR;
                if (wid == 0) { int l3 = (int)__builtin_amdgcn_mbcnt_hi(~0u, __builtin_amdgcn_mbcnt_lo(~0u, 0u)); asm volatile("" : "+v"(l3));
                    if (l3 == 0) (void)__hip_atomic_fetch_add(sp, 1u, __ATOMIC_RELAXED, __HIP_MEMORY_SCOPE_AGENT); }
            }
        }
        if (!has_next) break;
#pragma unroll
        for (int a = 0; a < 2; ++a)
#pragma unroll
            for (int b = 0; b < 2; ++b)
#pragma unroll
                for (int m = 0; m < 4; ++m)
#pragma unroll
                    for (int n = 0; n < 2; ++n) acc[a][b][m][n] = (f32x4){0.f, 0.f, 0.f, 0.f};
        cur = nxt; cA = nA; cB = nB; ++ui;
        if constexpr (DYN) PG8_BAR;
        if constexpr (ALIGN_EPI) { if (wr == 1) PG8_BAR; }
    }
    PG8_WAIT_V(0);
    if constexpr (!ALIGN_EPI) { if (wr == 0) PG8_BAR; }
    PG8_BAR;
#undef PG8_SA
#undef PG8_SB
#undef PG8_STAGE
#undef PG8_LDA
#undef PG8_LDB
#undef PG8_MMA
#undef PG8_WAIT_V
#undef PG8_WAIT_L
#undef PG8_BAR
#undef PG8_SCHED
}
}

#ifndef PG8_SP2
#define PG8_SP2 true
#endif
#ifndef PG8_ALIGN
#define PG8_ALIGN true
#endif

namespace sbk {
#define SB_LAS __attribute__((address_space(3)))
typedef unsigned short bf16;
typedef short bf16x8 __attribute__((ext_vector_type(8)));
typedef short s16x4 __attribute__((ext_vector_type(4)));
typedef float f32x16 __attribute__((ext_vector_type(16)));
typedef float f32x4 __attribute__((ext_vector_type(4)));
typedef unsigned u32x4 __attribute__((ext_vector_type(4)));
constexpr int WAVE_LDS = 16384;
#define SB_KSWZ(row, colB) ((row) * 256 + ((colB) ^ (((row) & 7) << 4)))
__device__ __forceinline__ int v_st(int k, int c) { const int kk = (k & ~0xC) | ((k & 4) << 1) | ((k & 8) >> 1); return ((kk >> 3) * 4 + (c >> 5)) * 512 + ((kk & 7) * 32 + (c & 31)) * 2; }
__device__ __forceinline__ int v_rd_base(int lane) { return ((lane & 3) << 3) | (((lane >> 2) & 3) << 6) | (((lane >> 4) & 1) << 5) | (((lane >> 5) & 1) << 8); }
__device__ __forceinline__ int crow(int r, int hi) { return (r & 3) + 8 * (r >> 2) + 4 * hi; }
__device__ __forceinline__ unsigned cvtpk(float lo, float hi) { return pg8::cvt_pk_bf16(lo, hi); }
__device__ __forceinline__ bf16x8 pack8(f32x4 a, f32x4 b) { u32x4 w = {cvtpk(a[0], a[1]), cvtpk(a[2], a[3]), cvtpk(b[0], b[1]), cvtpk(b[2], b[3])}; return __builtin_bit_cast(bf16x8, w); }

struct Args { const bf16 *Q, *K, *V, *SZA; unsigned char* YA8; const float *ck, *cv; unsigned* queue; };

__device__ __forceinline__ void tile_compute(SB_LAS char* wl, const bf16x8 (&qr)[8], f32x16 (&o)[4], float& R, const bool diag, const int r32, const int hi, const unsigned vb0) {
    f32x16 p = {};
    { const SB_LAS char* kb[4];
#pragma unroll
      for (int dd = 0; dd < 4; ++dd) kb[dd] = wl + SB_KSWZ(r32, (dd * 16 + hi * 8) * 2);
#pragma unroll
      for (int d0 = 0; d0 < 8; ++d0) { const bf16x8 kf = *(const SB_LAS bf16x8*)(kb[d0 & 3] + (d0 >> 2) * 128); p = __builtin_amdgcn_mfma_f32_32x32x16_bf16(kf, qr[d0], p, 0, 0, 0); } }
    if (diag) {
        const float NEG = -__builtin_inff();
#pragma unroll
        for (int r = 0; r < 16; ++r) if (crow(r, hi) >= r32) p[r] = NEG;
    }
    float s[16];
#pragma unroll
    for (int r = 0; r < 16; ++r) { const float z = p[r]; s[r] = fmaxf(z, 0.f) + __builtin_amdgcn_logf(1.0f + __builtin_amdgcn_exp2f(-__builtin_fabsf(z))); }
#pragma unroll
    for (int g = 0; g < 4; ++g) { s[4 * g + 2] += s[4 * g + 3]; s[4 * g + 1] += s[4 * g + 2]; s[4 * g] += s[4 * g + 1]; }
    float E[4], O[4];
#pragma unroll
    for (int g = 0; g < 4; ++g) { auto rr = __builtin_amdgcn_permlane32_swap(__float_as_uint(s[4 * g]), __float_as_uint(s[4 * g]), false, false); E[g] = __uint_as_float(rr[0]); O[g] = __uint_as_float(rr[1]); }
    float T[8]; T[7] = 0.f; T[6] = O[3]; T[5] = T[6] + E[3]; T[4] = T[5] + O[2]; T[3] = T[4] + E[2]; T[2] = T[3] + O[1]; T[1] = T[2] + E[1]; T[0] = T[1] + O[0];
    const float total = T[0] + E[0];
#pragma unroll
    for (int g = 0; g < 4; ++g) { const float base = R + (hi ? T[2 * g + 1] : T[2 * g]);
#pragma unroll
        for (int j = 0; j < 4; ++j) { const int r = 4 * g + j; p[r] = __builtin_amdgcn_exp2f(p[r] - (base + s[r])); } }
    R += total;
    bf16x8 pa0, pa1;
#define SB_PK4(P, B_, OUT) do { unsigned a0 = cvtpk(P[B_+0], P[B_+1]), a1 = cvtpk(P[B_+2], P[B_+3]); unsigned b0 = cvtpk(P[B_+4], P[B_+5]), b1 = cvtpk(P[B_+6], P[B_+7]); \
        auto r0 = __builtin_amdgcn_permlane32_swap(a0, b0, false, false); auto r1 = __builtin_amdgcn_permlane32_swap(a1, b1, false, false); \
        u32x4 w = {r0[0], r1[0], r0[1], r1[1]}; OUT = __builtin_bit_cast(bf16x8, w); } while (0)
    SB_PK4(p, 0, pa0); SB_PK4(p, 8, pa1);
#undef SB_PK4
#define SB_TRRD(dst, off) asm volatile("ds_read_b64_tr_b16 %0, %1 offset:%2" : "=&v"(dst) : "v"(vb0), "i"(off) : "memory")
#pragma unroll
    for (int d0 = 0; d0 < 4; ++d0) {
        s16x4 l0, h0, l1, h1;
        if (d0 == 0) { SB_TRRD(l0, 0); SB_TRRD(h0, 2048); SB_TRRD(l1, 4096); SB_TRRD(h1, 6144); }
        else if (d0 == 1) { SB_TRRD(l0, 512); SB_TRRD(h0, 512 + 2048); SB_TRRD(l1, 512 + 4096); SB_TRRD(h1, 512 + 6144); }
        else if (d0 == 2) { SB_TRRD(l0, 1024); SB_TRRD(h0, 1024 + 2048); SB_TRRD(l1, 1024 + 4096); SB_TRRD(h1, 1024 + 6144); }
        else { SB_TRRD(l0, 1536); SB_TRRD(h0, 1536 + 2048); SB_TRRD(l1, 1536 + 4096); SB_TRRD(h1, 1536 + 6144); }
        asm volatile("s_waitcnt lgkmcnt(0)" ::: "memory"); __builtin_amdgcn_sched_barrier(0);
        o[d0] = __builtin_amdgcn_mfma_f32_32x32x16_bf16(pa0, (bf16x8){l0[0], l0[1], l0[2], l0[3], h0[0], h0[1], h0[2], h0[3]}, o[d0], 0, 0, 0);
        o[d0] = __builtin_amdgcn_mfma_f32_32x32x16_bf16(pa1, (bf16x8){l1[0], l1[1], l1[2], l1[3], h1[0], h1[1], h1[2], h1[3]}, o[d0], 0, 0, 0);
    }
#undef SB_TRRD
}

constexpr int N_SAMPLE_UNITS = 32 * 16 * 2, N_PROMPT_UNITS = 4 * 16 * 64, N_UNITS = N_SAMPLE_UNITS + N_PROMPT_UNITS;
constexpr float PRUNE_LOG2 = 160.0f;

__device__ __forceinline__ void unit(const Args& A, const int id, SB_LAS char* wl, const int lane_in) {
    int lane = lane_in; asm volatile("" : "+v"(lane));
    const int r32 = lane & 31, hi = lane >> 5;
    const unsigned vb0 = (unsigned)(size_t)(wl + 8192) + (unsigned)v_rd_base(lane);
    int qrow0, h, nt_new, nt_cache, b; int krow0;
    if (id < N_SAMPLE_UNITS) { b = id >> 5; h = (id >> 1) & 15; const int half = id & 1; qrow0 = 8192 + b * 64 + half * 32; krow0 = 8192 + b * 64; nt_new = half + 1; nt_cache = 32; }
    else { const int j = id - N_SAMPLE_UNITS; const int g = 7 - (j >> 9), bh = (j & 511) >> 3, qb = g * 8 + (j & 7); b = bh >> 4; h = bh & 15; qrow0 = b * 2048 + qb * 32; krow0 = b * 2048; nt_new = qb + 1; nt_cache = 0; }
    bf16x8 qr[8];
#pragma unroll
    for (int d0 = 0; d0 < 8; ++d0) qr[d0] = *(const bf16x8*)(A.Q + (size_t)(qrow0 + r32) * 2048 + h * 128 + d0 * 16 + hi * 8);
    f32x16 o[4] = {}; float R = 0.f;
    const int NT = nt_new + nt_cache, srow = lane >> 4, sch = lane & 15;
    f32x4 raw[16];
    const unsigned lb16 = (unsigned)(srow * 2048 + sch * 8) * 2u, lb32 = lb16 * 2u;
    SB_LAS char* const kst0 = wl + SB_KSWZ(srow, sch * 16);
    SB_LAS char* const kst1 = wl + SB_KSWZ(4 + srow, sch * 16);
    SB_LAS char* const vst = wl + 8192 + ((sch * 8) >> 5) * 512 + srow * 64 + ((sch * 8) & 31) * 2;
#define SB_VOFF(i) ((((i) & 1) * 2048) + (((i) >> 2) * 4096) + ((((i) >> 1) & 1) * 256))
#define SB_KV_BF16(idx_) ((size_t)(krow0 + 32 * (nt_new - 1 - (idx_))) * 2048 + h * 128)
#define SB_KV_F32(idx_) (((size_t)(b * 1024 + 32 * (nt_cache - 1 - ((idx_) - nt_new))) * 16 + h) * 128)
#define SB_LD_BF16(idx_) do { const char* kt_ = (const char*)(A.K + SB_KV_BF16(idx_)); const char* vt_ = (const char*)(A.V + SB_KV_BF16(idx_)); _Pragma("unroll") for (int i = 0; i < 8; ++i) { \
        raw[i] = *(const f32x4*)(kt_ + (size_t)i * 16384 + lb16); raw[8 + i] = *(const f32x4*)(vt_ + (size_t)i * 16384 + lb16); } } while (0)
#define SB_LD_F32(P_, idx_) do { const char* t_ = (const char*)((P_) + SB_KV_F32(idx_)); _Pragma("unroll") for (int i = 0; i < 8; ++i) { \
        raw[2 * i] = *(const f32x4*)(t_ + (size_t)i * 32768 + lb32); raw[2 * i + 1] = *(const f32x4*)(t_ + (size_t)i * 32768 + lb32 + 16); } } while (0)
    bool live = true;
    if (live) SB_LD_BF16(0);
#pragma clang loop unroll(disable)
    for (int idx = 0; idx < NT && live; ++idx) {
        if (idx < nt_new) {
#pragma unroll
            for (int i = 0; i < 8; ++i) { *(SB_LAS f32x4*)(((i & 1) ? kst1 : kst0) + (i & ~1) * 1024) = raw[i]; *(SB_LAS f32x4*)(vst + SB_VOFF(i)) = raw[8 + i]; }
        } else {
#pragma unroll
            for (int i = 0; i < 8; ++i) *(SB_LAS bf16x8*)(((i & 1) ? kst1 : kst0) + (i & ~1) * 1024) = pack8(raw[2 * i], raw[2 * i + 1]);
            SB_LD_F32(A.cv, idx);
#pragma unroll
            for (int i = 0; i < 8; ++i) *(SB_LAS bf16x8*)(vst + SB_VOFF(i)) = pack8(raw[2 * i], raw[2 * i + 1]);
        }
        if (idx + 1 < NT) { if (idx + 1 < nt_new) SB_LD_BF16(idx + 1); else SB_LD_F32(A.ck, idx + 1); }
        tile_compute(wl, qr, o, R, idx == 0, r32, hi, vb0);
        if (SB_PRUNE) live = !__all(R > PRUNE_LOG2);
    }
#undef SB_VOFF
#undef SB_KV_BF16
#undef SB_KV_F32
#undef SB_LD_BF16
#undef SB_LD_F32
    asm volatile("s_waitcnt lgkmcnt(0)" ::: "memory");
    int lz = lane; asm volatile("" : "+v"(lz));
    { SB_LAS char* ob = wl + ((lz >> 5) * 4 * 128 + (lz & 31)) * 4;
#pragma unroll
      for (int d0 = 0; d0 < 4; ++d0)
#pragma unroll
        for (int r = 0; r < 16; ++r) *(SB_LAS float*)(ob + (((r & 3) + 8 * (r >> 2)) * 128 + d0 * 32) * 4) = o[d0][r]; }
    asm volatile("s_waitcnt lgkmcnt(0)" ::: "memory");
    const int rr = lz >> 4, ch = lz & 15;
#pragma unroll
    for (int i = 0; i < 8; ++i) { const int q = 4 * i + rr;
        const f32x4 a = *(const SB_LAS f32x4*)(wl + (q * 128 + ch * 8) * 4), c = *(const SB_LAS f32x4*)(wl + (q * 128 + ch * 8 + 4) * 4);
        const size_t go = (size_t)(qrow0 + q) * 2048 + h * 128 + ch * 8;
        const u32x4 z = *(const u32x4*)(A.SZA + go);
        const f32x4 ya = a * (f32x4){pg8::bf_lo(z.x), pg8::bf_hi(z.x), pg8::bf_lo(z.y), pg8::bf_hi(z.y)}, yc = c * (f32x4){pg8::bf_lo(z.z), pg8::bf_hi(z.z), pg8::bf_lo(z.w), pg8::bf_hi(z.w)};
        *(pg8::u32x2*)(A.YA8 + go) = pg8::pack8_fp8(ya * pg8::SC_Y, yc * pg8::SC_Y); }
    asm volatile("s_waitcnt lgkmcnt(0)" ::: "memory");
}

__device__ __forceinline__ void attn_phase(const Args& A, SB_LAS char* lds, const int wave, const int lane, unsigned* queue, const int id0, const int n) {
    SB_LAS char* wl = lds + wave * WAVE_LDS;
    for (;;) {
        unsigned id = 0;
        if (lane == 0) id = __hip_atomic_fetch_add(queue, 1u, __ATOMIC_RELAXED, __HIP_MEMORY_SCOPE_AGENT);
        id = (unsigned)__builtin_amdgcn_readfirstlane((int)id);
        if (id >= (unsigned)n) break;
        unit(A, id0 + (int)id, wl, lane);
    }
}
}

constexpr int NWAVES = 8;
constexpr int N_LAUNCHES = MK_N_LAUNCHES;
constexpr int PER_PHASE = 6;

constexpr int DM = 4096, NIN = 24576, WB = 2048;
constexpr int MP = 8192, MS = 2048, M = MP + MS;
constexpr int NB16 = 4096, NF8 = 20480;
constexpr float LN_EPS = 1e-5f;
constexpr float DN_ALPHA = 1.189207115002721f;

constexpr size_t MiB = 1u << 20;
constexpr size_t WS_CTL = 0, CTL_ZERO_BYTES = 1 * MiB;
constexpr size_t WS_WINB = 1 * MiB;
constexpr size_t WS_WCH = WS_WINB + 32 * MiB;
constexpr size_t WS_XG = WS_WCH + 32 * MiB;
constexpr size_t WS_WIN8 = WS_XG + 2 * MiB;
constexpr size_t WS_WA8 = WS_WIN8 + 80 * MiB;
constexpr size_t WS_WB8 = WS_WA8 + 8 * MiB;
constexpr size_t WS_WO8 = WS_WB8 + 8 * MiB;
constexpr size_t WS_XB = WS_WO8 + 16 * MiB;
constexpr size_t WS_X8 = WS_XB + 80 * MiB;
constexpr size_t WS_Q = WS_X8 + 40 * MiB, WS_K = WS_Q + 40 * MiB, WS_V = WS_K + 40 * MiB, WS_SZA = WS_V + 40 * MiB, WS_U = WS_SZA + 40 * MiB, WS_GT = WS_U + 40 * MiB;
constexpr size_t WS_SGA = WS_GT + 40 * MiB, WS_SGB = WS_SGA + 80 * MiB;
constexpr size_t WS_YA8 = WS_SGB + 80 * MiB, WS_YB8 = WS_YA8 + 20 * MiB;
constexpr size_t WS_M1 = WS_YB8 + 20 * MiB;
constexpr size_t WS_MG8 = WS_M1 + 80 * MiB;
constexpr size_t WS_PRE = WS_MG8 + 40 * MiB;
constexpr size_t WS_END = WS_PRE + 80 * MiB;
static_assert(WS_END < (size_t)0x7fffffff, "every GEMM operand must be addressable as a 31-bit byte offset from the workspace base");
constexpr int CW_TMO = 0, CW_CODE = 1, CW_QUEUE = 64;
constexpr int CW_ONCEX = 2880;
constexpr int CW_P1A = 1024, CW_P1B = 1536, CW_P0B = 2048, CW_PM = 2112, CW_QZ = 2752, CW_KV = 2816, CW_CONVQ = 128;
constexpr int CW_BAR = 4096;

constexpr int RING_OFF = 0, RING_BYTES = 131072;
constexpr int LDS_BYTES = 147456;
constexpr int LDSCTL_OFF = LDS_BYTES - 512, MISC_OFF = LDSCTL_OFF + 320;
constexpr int P0_WAVE_LDS = 128 * 33 * 4;
static_assert(8 * P0_WAVE_LDS <= LDSCTL_OFF, "LDS map");
static_assert(MISC_OFF + 128 <= LDS_BYTES, "LDS map");

#define GAS __attribute__((address_space(1)))
#define LAS __attribute__((address_space(3)))
typedef unsigned short bf16;
typedef unsigned v4u __attribute__((ext_vector_type(4)));
typedef unsigned v2u __attribute__((ext_vector_type(2)));
typedef float f32x4 __attribute__((ext_vector_type(4)));
typedef GAS unsigned gu32;
#define RLX_AGENT __ATOMIC_RELAXED, __HIP_MEMORY_SCOPE_AGENT
#define LDS_WAIT() asm volatile("s_waitcnt lgkmcnt(0)" ::: "memory")
#define VM_WAIT() asm volatile("s_waitcnt vmcnt(0)" ::: "memory")

#define XB_TMO      128
#define XB_XCNT(j)  (256  + 64 * (j))
#define XB_XSUB(j)  (1280 + 64 * (j))
#define XB_XGEN(j)  (2304 + 64 * (j))
#define XB_TOP      3328
#define XB_TOPGEN   3392
#define XCD_BAR_WORDS 3456
#define XB_SPIN_CAP (1u << 18)

__device__ __forceinline__ unsigned xb_ld(unsigned* p)              { return __hip_atomic_load(p, __ATOMIC_RELAXED, __HIP_MEMORY_SCOPE_AGENT); }
__device__ __forceinline__ unsigned xb_add(unsigned* p, unsigned v) { return __hip_atomic_fetch_add(p, v, __ATOMIC_RELAXED, __HIP_MEMORY_SCOPE_AGENT); }
__device__ __forceinline__ unsigned xb_xcc_id() { return (unsigned)__builtin_amdgcn_s_getreg((3 << 11) | 20) & 0xFu; }
#define XB_SPIN(cond, bar) do { unsigned _sp = 0; while (cond) { __builtin_amdgcn_s_sleep(1); \
    if ((++_sp & 255u) == 0u) { if (xb_ld(&(bar)[XB_TMO])) break; if (_sp > XB_SPIN_CAP) { atomicAdd(&(bar)[XB_TMO], 1u); break; } } } } while (0)

struct XcdBarrier {
    unsigned* bar; unsigned x;
    volatile LAS unsigned* st;
};
__device__ __forceinline__ XcdBarrier xcd_barrier_post(unsigned* bar, volatile LAS unsigned* st) {
    XcdBarrier b; b.bar = bar; b.x = xb_xcc_id(); b.st = st;
    if (threadIdx.x == 0) (void)xb_add(&bar[XB_XCNT(b.x)], 1u);
    return b;
}
__device__ __forceinline__ void xcd_barrier_complete(unsigned* bar, unsigned x, unsigned& nloc, unsigned& nx) {
    const unsigned G = gridDim.x * gridDim.y * gridDim.z;
    unsigned sum, cnt, mine, sp = 0u;
    for (;;) {
        sum = 0u; cnt = 0u; mine = 0u;
#pragma unroll
        for (unsigned j = 0; j < 16; ++j) { const unsigned c = xb_ld(&bar[XB_XCNT(j)]); sum += c; cnt += (c > 0u) ? 1u : 0u; mine = (j == x) ? c : mine; }
        if (sum == G) break;
        __builtin_amdgcn_s_sleep(1);
        if ((++sp & 255u) == 0u) { if (xb_ld(&bar[XB_TMO])) break; if (sp > XB_SPIN_CAP) { atomicAdd(&bar[XB_TMO], 1u); break; } }
    }
    nloc = mine > 0u ? mine : 1u; nx = cnt > 0u ? cnt : 1u;
}
__device__ __forceinline__ void xcd_barrier(const XcdBarrier& b) {
    asm volatile("s_waitcnt vmcnt(0)" ::: "memory");
    __syncthreads();
    if (threadIdx.x == 0) {
        unsigned* bar = b.bar;
        __builtin_amdgcn_s_waitcnt(0);
        unsigned nloc = b.st[0], nx = b.st[1];
        if (nloc == 0u) { xcd_barrier_complete(bar, b.x, nloc, nx); b.st[0] = nloc; b.st[1] = nx; }
        const unsigned old = xb_add(&bar[XB_XSUB(b.x)], 1u);
        const unsigned gen = old / nloc;
        if (old + 1u == (gen + 1u) * nloc) {
            __builtin_amdgcn_fence(__ATOMIC_RELEASE, "agent");
            asm volatile("s_waitcnt vmcnt(0)" ::: "memory");
            const unsigned og = xb_add(&bar[XB_TOP], 1u);
            const unsigned tg = og / nx;
            if (og + 1u == (tg + 1u) * nx) xb_add(&bar[XB_TOPGEN], 1u);
            else XB_SPIN(xb_ld(&bar[XB_TOPGEN]) == tg, bar);
            __builtin_amdgcn_fence(__ATOMIC_ACQUIRE, "agent");
            xb_add(&bar[XB_XGEN(b.x)], 1u);
            asm volatile("s_waitcnt vmcnt(0)" ::: "memory");
        } else {
            XB_SPIN(xb_ld(&bar[XB_XGEN(b.x)]) == gen, bar);
            __builtin_amdgcn_fence(__ATOMIC_ACQUIRE, "agent");
            asm volatile("s_waitcnt vmcnt(0)" ::: "memory");
        }
    }
    __syncthreads();
}

__device__ __forceinline__ float wave_sum(float v) {
#pragma unroll
    for (int o = 1; o < 64; o <<= 1) v += __shfl_xor(v, o);
    return v;
}
__device__ __forceinline__ void win_dest_row(int n, int& r8, int& r16, int& which) {
    r8 = -1; r16 = -1; which = 0;
    if (n < 2048) { r8 = n; return; }
    if (n < 4096) { r16 = n - 2048; return; }
    if (n < 6144) { r16 = 2048 + (n - 4096); return; }
    if (n < 8192) { r8 = 2048 + (n - 6144); return; }
    if (n < 16384) { const int sg = (n - 8192) >> 11, ch = (n - 8192) & 2047, i = ch >> 7, o = ch & 127;
        if (sg == 1 || sg == 2) { const int r = i * 256 + ((sg == 2) ? 128 : 0) + o; r8 = 4096 + r; r16 = r; which = 1; }
        else r8 = 8192 + i * 256 + ((sg == 3) ? 128 : 0) + o;
        return; }
    r8 = 12288 + (n - 16384);
}
struct P0Item { const float* src; int N, K, k0, n0, mode; unsigned char* dst; unsigned char* dstch; unsigned char* dst8; float scale; };
__device__ __forceinline__ void p0_load(const P0Item& d, f32x4 (&v)[16], int lane) {
    const int kr = lane >> 3, nq = lane & 7;
    const float* p = d.src + (size_t)(d.k0 + kr) * d.N + d.n0 + 4 * nq;
#pragma unroll
    for (int i = 0; i < 16; ++i) v[i] = __builtin_nontemporal_load((const f32x4*)(p + (size_t)(8 * i) * d.N));
}
__device__ __forceinline__ void p0_store(const P0Item& d, const f32x4 (&v)[16], LAS float* scr, int lane) {
    const int kr = lane >> 3, nq = lane & 7;
#pragma unroll
    for (int i = 0; i < 16; ++i) { LAS float* q = scr + (8 * i + kr) * 33 + 4 * nq; q[0] = v[i].x; q[1] = v[i].y; q[2] = v[i].z; q[3] = v[i].w; }
    LDS_WAIT(); asm volatile("" ::: "memory");
    const int c = lane & 15;
    int r8 = d.n0, r16 = -1, which = 0;
    if (d.mode == 2) win_dest_row(d.n0, r8, r16, which);
    bf16* const d16 = (bf16*)(which ? d.dstch : d.dst);
#pragma unroll
    for (int j = 0; j < 8; ++j) { const int n = (lane >> 4) + 4 * j; const LAS float* s = scr + (8 * c) * 33 + n;
        const f32x4 a = {s[0 * 33], s[1 * 33], s[2 * 33], s[3 * 33]}, b = {s[4 * 33], s[5 * 33], s[6 * 33], s[7 * 33]};
        if (r8 >= 0) *(GAS v2u*)(d.dst8 + (size_t)(r8 + n) * d.K + d.k0 + 8 * c) = pg8::pack8_fp8(a * d.scale, b * d.scale);
        if (r16 >= 0) *(GAS v4u*)(d16 + (size_t)(r16 + n) * d.K + d.k0 + 8 * c) = pg8::pack8(a, b); }
    LDS_WAIT(); asm volatile("" ::: "memory");
}

struct KArgs { const float* in[14]; float* out; unsigned char* ws; int ph_lo, ph_hi; };
typedef const KArgs __attribute__((address_space(4))) * KArgsPtr;
template <int SET> __device__ __forceinline__ P0Item p0_decode(int it, const float* w_in, const float* w_a, const float* w_b, const float* w_o, unsigned char* ws) {
    constexpr int KB = DM / 128, I_A = (WB / 128) * (DM / 32);
    P0Item d; int r = it, nb;
    d.src = w_in; d.N = NIN; d.K = DM; d.mode = 2; d.dst = ws + WS_WINB; d.dstch = ws + WS_WCH; d.dst8 = ws + WS_WIN8; d.scale = pg8::SC_WIN;
    if (SET == 0) { nb = r % 256; nb = nb < 128 ? 64 + nb : 320 + (nb - 128); d.k0 = 128 * (r / 256); d.n0 = 32 * nb; return d; }
    if (r < KB * 512) { nb = r % 512; nb = nb < 64 ? nb : nb < 192 ? 192 + (nb - 64) : 448 + (nb - 192); d.k0 = 128 * (r / 512); d.n0 = 32 * nb; return d; }
    r -= KB * 512; d.mode = 1; d.dst = nullptr; d.dstch = nullptr; d.N = DM;
    if (r < I_A) { d.src = w_a; d.K = WB; d.dst8 = ws + WS_WA8; d.scale = pg8::SC_WAB; }
    else if ((r -= I_A) < I_A) { d.src = w_b; d.K = WB; d.dst8 = ws + WS_WB8; d.scale = pg8::SC_WAB; }
    else { r -= I_A; d.src = w_o; d.K = DM; d.dst8 = ws + WS_WO8; d.scale = pg8::SC_WO; }
    d.k0 = 128 * (r / (DM / 32)); d.n0 = 32 * (r % (DM / 32)); return d;
}
template <int SET> __device__ __forceinline__ void p0_weights(KArgsPtr ap, unsigned char* ws, LAS float* scr, int lane, int w0, int wn) {
    constexpr int NITEMS = SET == 0 ? (DM / 128) * 256 : (DM / 128) * 512 + 2 * (WB / 128) * (DM / 32) + (DM / 128) * (DM / 32);
    const float *w_in = ap->in[5], *w_a = ap->in[9], *w_b = ap->in[10], *w_o = ap->in[11];
    f32x4 cur[16], nxt[16];
    int it = w0;
    if (it < NITEMS) { const P0Item d = p0_decode<SET>(it, w_in, w_a, w_b, w_o, ws); p0_load(d, cur, lane); }
    while (it < NITEMS) {
        const int itn = it + wn;
        if (itn < NITEMS) { const P0Item dn = p0_decode<SET>(itn, w_in, w_a, w_b, w_o, ws); p0_load(dn, nxt, lane); }
        { const P0Item d = p0_decode<SET>(it, w_in, w_a, w_b, w_o, ws); p0_store(d, cur, scr, lane); }
#pragma unroll
        for (int i = 0; i < 16; ++i) cur[i] = nxt[i];
        it = itn;
    }
}
template <int WHICH> __device__ __forceinline__ void p0_x(KArgsPtr ap, unsigned char* ws, size_t gt, size_t NT) {
    const float *x = ap->in[0], *xs = ap->in[1];
    const size_t NX = (size_t)M * DM / 16;
    for (size_t i0 = gt; i0 < NX; i0 += 4 * NT) {
        f32x4 a[4], b[4], c[4], d[4];
#pragma unroll
        for (int u = 0; u < 4; ++u) { const size_t i = i0 + u * NT; if (i < NX) { const size_t e = i * 16; const float* src = (e < (size_t)MP * DM) ? x + e : xs + (e - (size_t)MP * DM);
            a[u] = __builtin_nontemporal_load((const f32x4*)src); b[u] = __builtin_nontemporal_load((const f32x4*)(src + 4)); c[u] = __builtin_nontemporal_load((const f32x4*)(src + 8)); d[u] = __builtin_nontemporal_load((const f32x4*)(src + 12)); } }
#pragma unroll
        for (int u = 0; u < 4; ++u) { const size_t i = i0 + u * NT; if (i < NX) { const size_t e = i * 16;
            if (WHICH & 1) { *(pg8::u32x4*)((bf16*)(ws + WS_XB) + e) = pg8::pack8(a[u], b[u]); *(pg8::u32x4*)((bf16*)(ws + WS_XB) + e + 8) = pg8::pack8(c[u], d[u]); }
            if (WHICH & 2) { const pg8::u32x2 p = pg8::pack8_fp8(a[u], b[u]), q = pg8::pack8_fp8(c[u], d[u]); *(pg8::u32x4*)(ws + WS_X8 + e) = (pg8::u32x4){p.x, p.y, q.x, q.y}; } } }
    }
    if (WHICH & 1) {
        for (size_t i = gt; i < (size_t)256 * (DM / 8); i += NT) {
            const int row = (int)(i >> 9), c8 = (int)(i & 511) * 8;
            pg8::u32x4 w = {0u, 0u, 0u, 0u};
            if (row < 72) { const float* src = (row < 8) ? x + ((size_t)((row >> 1) * 2048 + 2046 + (row & 1))) * DM + c8 : xs + ((size_t)(((row - 8) >> 1) * 64 + 62 + (row & 1))) * DM + c8;
                w = pg8::pack8(*(const f32x4*)src, *(const f32x4*)(src + 4)); }
            *(pg8::u32x4*)((bf16*)(ws + WS_XG) + (size_t)row * DM + c8) = w;
        }
    }
}
#define PHASE_ARGS() KArgsPtr ap = (KArgsPtr)__builtin_amdgcn_kernarg_segment_ptr(); asm volatile("" : "+s"(ap)); unsigned char* const ws = ap->ws; \
    const __amdgpu_buffer_rsrc_t rsrc = __builtin_amdgcn_make_buffer_rsrc((void*)ws, 0, 0x7fffffff, 0x00020000)

__global__ void __launch_bounds__(NWAVES * 64, 2) mk_fwd(const KArgs args) {
    extern __shared__ __attribute__((aligned(16))) unsigned char lds_raw[];
    LAS unsigned char* const lds = (LAS unsigned char*)lds_raw;
    volatile LAS unsigned* const MISC = (volatile LAS unsigned*)(lds + MISC_OFF);
    const int wave = __builtin_amdgcn_readfirstlane((int)threadIdx.x >> 6);
#define LANE_TID() int lane = (int)__builtin_amdgcn_mbcnt_hi(~0u, __builtin_amdgcn_mbcnt_lo(~0u, 0u)); asm volatile("" : "+v"(lane)); const int tid = wave * 64 + lane; (void)tid
    int tid0 = threadIdx.x;
    const int G = gridDim.x, vcu = (G % 8 == 0) ? ((int)blockIdx.x % 8) * (G / 8) + (int)blockIdx.x / 8 : (int)blockIdx.x;
    gu32* const ctl = (gu32*)(args.ws + WS_CTL);
    for (int u = tid0; u < (LDS_BYTES - LDSCTL_OFF) / 4; u += NWAVES * 64) ((LAS unsigned*)(lds + LDSCTL_OFF))[u] = 0u;
    __syncthreads();
    XcdBarrier bar; bar.bar = (unsigned*)(ctl + CW_BAR); bar.x = 0; bar.st = nullptr;
    if (N_LAUNCHES != PER_PHASE) bar = xcd_barrier_post((unsigned*)(ctl + CW_BAR), MISC + 8);
#define GRID_BAR(seam) do { if (N_LAUNCHES == PER_PHASE) { if (threadIdx.x == 0) __hip_atomic_store(ctl + CW_TMO, 0xBADBA0u | (unsigned)(seam), RLX_AGENT); } else { xcd_barrier(bar); } } while (0)
    const int lo = args.ph_lo, hi = args.ph_hi;
#define IN(k) (lo <= (k) && (k) < hi)
#define BOTH(k) (IN(k) && IN((k) + 1))
    const int gw = vcu * NWAVES + wave, NGW = G * NWAVES;

    constexpr int NCX = 8;
    const bool dynp1 = (G == 32 * pg8::NXCD);
    const bool early_attn = dynp1 && (lo <= 1 && 2 < hi);
    if (IN(0)) {
        PHASE_ARGS(); (void)rsrc; LANE_TID();
        LAS float* scr = (LAS float*)(lds + wave * P0_WAVE_LDS);
        p0_weights<0>(ap, ws, scr, lane, gw, NGW);
        p0_x<3>(ap, ws, (size_t)blockIdx.x * (NWAVES * 64) + tid, (size_t)G * NWAVES * 64);
        if (!dynp1) p0_weights<1>(ap, ws, scr, lane, gw, NGW);
        if (BOTH(0)) GRID_BAR(0);
    }

    if (IN(1)) {
        if (dynp1) {
            const int xq = (int)blockIdx.x % pg8::NXCD, rho = (int)blockIdx.x / pg8::NXCD, NGX = 32 - NCX;
            gu32* const done = ctl + CW_P0B;
            if (rho >= NGX) {
                { PHASE_ARGS(); (void)rsrc; LANE_TID();
                  LAS float* scr = (LAS float*)(lds + wave * P0_WAVE_LDS);
                  const int cb = (rho - NGX) * pg8::NXCD + xq;
                  p0_weights<1>(ap, ws, scr, lane, cb * NWAVES + wave, NCX * pg8::NXCD * NWAVES); }
                asm volatile("s_waitcnt vmcnt(0)" ::: "memory");
                __syncthreads();
                { LANE_TID(); if (wave == 0 && lane == 0) { __builtin_amdgcn_fence(__ATOMIC_RELEASE, "agent"); asm volatile("s_waitcnt vmcnt(0)" ::: "memory"); (void)__hip_atomic_fetch_add(done, 1u, RLX_AGENT); } }
            } else {
                PHASE_ARGS();
                pg8::Sched S; S.init(M / 256, NB16 / 256, G, (int)blockIdx.x, 0, 0, WS_XB, WS_XG, WS_WINB, WS_WCH, DM * 2); S.nextra = 16;
                pg8::EpiProjB E{ap->in[6], (bf16*)(ws + WS_K), (bf16*)(ws + WS_V), ap->out, nullptr};
                const pg8::Dyn D{(unsigned*)(ctl + CW_P1A + 64 * xq), xq, rho, NGX, MISC + 16, nullptr, 0, nullptr, 1u};
                pg8::gemm_phase<pg8::EpiProjB, PG8_ALIGN, PG8_SP2, false, true>(lds + RING_OFF, wave, rsrc, DM * 2, DM * 2, S, E, D);
            }
            { LANE_TID(); if (wave == 0 && lane == 0) { unsigned sp = 0; while (__hip_atomic_load(done, RLX_AGENT) < (unsigned)(NCX * pg8::NXCD)) { __builtin_amdgcn_s_sleep(4); if (++sp > (1u << 22)) break; }
                  __builtin_amdgcn_fence(__ATOMIC_ACQUIRE, "agent"); } }
            __syncthreads();
            { PHASE_ARGS();
              pg8::Sched S; S.init(M / 256, NF8 / 256, G, (int)blockIdx.x, 0, 0, WS_X8, WS_X8, WS_WIN8, WS_WIN8, DM);
              S.il = 1;
              pg8::EpiProj8 E{ap->in[6], (bf16*)(ws + WS_Q), (bf16*)(ws + WS_SZA), (bf16*)(ws + WS_U), (bf16*)(ws + WS_GT), (bf16*)(ws + WS_SGA), (bf16*)(ws + WS_SGB), nullptr};
              const pg8::Dyn D{(unsigned*)(ctl + CW_P1B + 64 * xq), xq, rho, 32, MISC + 16, early_attn ? (unsigned*)(ctl + CW_QZ) : nullptr, 320, (unsigned*)(ctl + CW_ONCEX + 64 * (int)bar.x), (unsigned)MISC[8]};
              pg8::gemm_phase<pg8::EpiProj8, PG8_ALIGN, PG8_SP2, true, true>(lds + RING_OFF, wave, rsrc, DM, DM, S, E, D); }
            if (early_attn) { LANE_TID(); if (wave == 0 && lane == 0) { unsigned sp = 0;
                  while (__hip_atomic_load(ctl + CW_QZ, RLX_AGENT) < (unsigned)G) { __builtin_amdgcn_s_sleep(4); if (++sp > (1u << 22)) break; }
                  __builtin_amdgcn_fence(__ATOMIC_ACQUIRE, "agent"); } }
            __syncthreads();

        } else {
            { PHASE_ARGS();
              pg8::Sched S; S.init(M / 256, NB16 / 256, G, (int)blockIdx.x, 0, 0, WS_XB, WS_XG, WS_WINB, WS_WCH, DM * 2); S.nextra = 16;
              pg8::EpiProjB E{ap->in[6], (bf16*)(ws + WS_K), (bf16*)(ws + WS_V), ap->out, nullptr};
              pg8::gemm_phase<pg8::EpiProjB, PG8_ALIGN, PG8_SP2, false>(lds + RING_OFF, wave, rsrc, DM * 2, DM * 2, S, E); }
            { PHASE_ARGS();
              pg8::Sched S; S.init(M / 256, NF8 / 256, G, (int)blockIdx.x, 0, 0, WS_X8, WS_X8, WS_WIN8, WS_WIN8, DM);
              pg8::EpiProj8 E{ap->in[6], (bf16*)(ws + WS_Q), (bf16*)(ws + WS_SZA), (bf16*)(ws + WS_U), (bf16*)(ws + WS_GT), (bf16*)(ws + WS_SGA), (bf16*)(ws + WS_SGB), nullptr};
              pg8::gemm_phase<pg8::EpiProj8, PG8_ALIGN, PG8_SP2, true>(lds + RING_OFF, wave, rsrc, DM, DM, S, E); }
        }
        if (BOTH(1) && !early_attn) GRID_BAR(1);
    }

    if (IN(2)) {
        PHASE_ARGS(); (void)rsrc; LANE_TID();
        { const sbk::Args A{(const bf16*)(ws + WS_Q), (const bf16*)(ws + WS_K), (const bf16*)(ws + WS_V), (const bf16*)(ws + WS_SZA), ws + WS_YA8, ap->in[2], ap->in[3], (unsigned*)(ctl + CW_QUEUE)};
          SB_LAS char* wl = (LAS char*)(lds + RING_OFF) + wave * sbk::WAVE_LDS;
          bool passed = !early_attn;
          for (;;) {
              unsigned t = 0;
              if (lane == 0) t = __hip_atomic_fetch_add(A.queue, 1u, __ATOMIC_RELAXED, __HIP_MEMORY_SCOPE_AGENT);
              t = (unsigned)__builtin_amdgcn_readfirstlane((int)t);
              if (t >= (unsigned)sbk::N_PROMPT_UNITS && !passed) { GRID_BAR(1); passed = true; }
              if (t >= (unsigned)sbk::N_UNITS) break;
              sbk::unit(A, t < (unsigned)sbk::N_PROMPT_UNITS ? sbk::N_SAMPLE_UNITS + (int)t : (int)t - sbk::N_PROMPT_UNITS, wl, lane);
          } }
        const float *state_conv = ap->in[4], *conv_w = ap->in[7], *conv_b = ap->in[8];
        const bf16 *Ub = (const bf16*)(ws + WS_U), *GT = (const bf16*)(ws + WS_GT);
        if (early_attn) for (;;) {
            unsigned cq = 0; if (lane == 0) cq = __hip_atomic_fetch_add(ctl + CW_CONVQ, 1u, RLX_AGENT); cq = (unsigned)__builtin_amdgcn_readfirstlane((int)cq);
            if (cq >= (unsigned)(M / 4)) break;
            const int r0 = (int)cq * 4; const bool samp = r0 >= MP; const int t0 = samp ? ((r0 - MP) & 63) : (r0 & 2047), sb = samp ? ((r0 - MP) >> 6) : 0;
#pragma clang loop unroll(disable)
            for (int j = 0; j < 4; ++j) {
                const int c = (lane + 64 * j) * 8;
                pg8::u32x4 uu[6], gg[4];
#pragma unroll
                for (int k = 0; k < 4; ++k) { uu[2 + k] = *(const pg8::u32x4*)(Ub + (size_t)(r0 + k) * WB + c); gg[k] = *(const pg8::u32x4*)(GT + (size_t)(r0 + k) * WB + c); }
                f32x4 h1a = {0.f, 0.f, 0.f, 0.f}, h1b = h1a, h2a = h1a, h2b = h1a;
                if (t0 > 0) { uu[0] = *(const pg8::u32x4*)(Ub + (size_t)(r0 - 2) * WB + c); uu[1] = *(const pg8::u32x4*)(Ub + (size_t)(r0 - 1) * WB + c); }
                else { uu[0] = (pg8::u32x4){0u, 0u, 0u, 0u}; uu[1] = uu[0];
                    if (samp) { const float* sc = state_conv + (size_t)(sb * 2) * WB + c; h2a = *(const f32x4*)sc; h2b = *(const f32x4*)(sc + 4); h1a = *(const f32x4*)(sc + WB); h1b = *(const f32x4*)(sc + WB + 4); } }
                const f32x4 ba = *(const f32x4*)(conv_b + c), bb = *(const f32x4*)(conv_b + c + 4);
                const f32x4 w0a = *(const f32x4*)(conv_w + c), w0b = *(const f32x4*)(conv_w + c + 4), w1a = *(const f32x4*)(conv_w + WB + c), w1b = *(const f32x4*)(conv_w + WB + c + 4),
                            w2a = *(const f32x4*)(conv_w + 2 * WB + c), w2b = *(const f32x4*)(conv_w + 2 * WB + c + 4);
                f32x4 xa[6], xb[6];
#pragma unroll
                for (int k = 0; k < 6; ++k) { xa[k] = pg8::bf4_lo(uu[k]); xb[k] = pg8::bf4_hi(uu[k]); }
                if (t0 == 0) { xa[0] = h2a; xb[0] = h2b; xa[1] = h1a; xb[1] = h1b; }
#pragma unroll
                for (int k = 0; k < 4; ++k) {
                    const f32x4 ya = pg8::bf4_lo(gg[k]) * pg8::SC_Y * (ba + w0a * xa[k] + w1a * xa[k + 1] + w2a * xa[k + 2]), yb = pg8::bf4_hi(gg[k]) * pg8::SC_Y * (bb + w0b * xb[k] + w1b * xb[k + 1] + w2b * xb[k + 2]);
                    *(pg8::u32x2*)(ws + WS_YB8 + (size_t)(r0 + k) * WB + c) = pg8::pack8_fp8(ya, yb); }
            }
        }
        const size_t NI = (size_t)M * (WB / 8);
        size_t cbase = 0;
        if (!early_attn) for (;;) {
            size_t i;
            { i = (size_t)blockIdx.x * (NWAVES * 64) + tid + cbase; cbase += (size_t)G * NWAVES * 64; if (i >= NI) break; }
            const int row = (int)(i >> 8), c = (int)(i & 255) * 8;
            int t, sb = 0; const bool samp = row >= MP;
            if (samp) { t = (row - MP) & 63; sb = (row - MP) >> 6; } else t = row & 2047;
            const pg8::u32x4 u2 = *(const pg8::u32x4*)(Ub + (size_t)row * WB + c), gg = *(const pg8::u32x4*)(GT + (size_t)row * WB + c);
            float xm1[8], xm2[8], x0[8], g[8];
            const unsigned uw[4] = {u2.x, u2.y, u2.z, u2.w}, gw4[4] = {gg.x, gg.y, gg.z, gg.w};
#pragma unroll
            for (int k = 0; k < 4; ++k) { x0[2 * k] = pg8::bf_lo(uw[k]); x0[2 * k + 1] = pg8::bf_hi(uw[k]); g[2 * k] = pg8::bf_lo(gw4[k]); g[2 * k + 1] = pg8::bf_hi(gw4[k]); }
            if (t >= 1) { const pg8::u32x4 v = *(const pg8::u32x4*)(Ub + (size_t)(row - 1) * WB + c); const unsigned w[4] = {v.x, v.y, v.z, v.w};
#pragma unroll
                for (int k = 0; k < 4; ++k) { xm1[2 * k] = pg8::bf_lo(w[k]); xm1[2 * k + 1] = pg8::bf_hi(w[k]); } }
            else {
#pragma unroll
                for (int k = 0; k < 8; ++k) xm1[k] = samp ? state_conv[(size_t)(sb * 2 + 1) * WB + c + k] : 0.f; }
            if (t >= 2) { const pg8::u32x4 v = *(const pg8::u32x4*)(Ub + (size_t)(row - 2) * WB + c); const unsigned w[4] = {v.x, v.y, v.z, v.w};
#pragma unroll
                for (int k = 0; k < 4; ++k) { xm2[2 * k] = pg8::bf_lo(w[k]); xm2[2 * k + 1] = pg8::bf_hi(w[k]); } }
            else {
#pragma unroll
                for (int k = 0; k < 8; ++k) xm2[k] = samp ? state_conv[(size_t)(sb * 2 + t) * WB + c + k] : 0.f; }
            float y[8];
#pragma unroll
            for (int k = 0; k < 8; ++k) y[k] = pg8::SC_Y * g[k] * (conv_b[c + k] + conv_w[c + k] * xm2[k] + conv_w[WB + c + k] * xm1[k] + conv_w[2 * WB + c + k] * x0[k]);
            *(pg8::u32x2*)(ws + WS_YB8 + (size_t)row * WB + c) = pg8::pack8_fp8((f32x4){y[0], y[1], y[2], y[3]}, (f32x4){y[4], y[5], y[6], y[7]});
        }
        if (BOTH(2)) GRID_BAR(2);
    }

    const bool rm34 = dynp1 && BOTH(3);
    if (IN(3)) {
        PHASE_ARGS();
        pg8::Sched S; S.init(M / 256, DM / 256, G, (int)blockIdx.x, 1, 0, WS_YA8, WS_YB8, WS_WA8, WS_WB8, WB);
        if (rm34) { S.rm = 1; S.rho = (int)blockIdx.x / pg8::NXCD; S.xq = (int)blockIdx.x % pg8::NXCD; }
        pg8::EpiMerge E{(const bf16*)(ws + WS_SGA), (const bf16*)(ws + WS_SGB), (bf16*)(ws + WS_M1), ws + WS_MG8, rsrc, (unsigned)WS_MG8, rm34 ? (unsigned*)(ctl + CW_PM) : nullptr};
        pg8::gemm_phase<pg8::EpiMerge, PG8_ALIGN, PG8_SP2, true>(lds + RING_OFF, wave, rsrc, WB, WB, S, E);
        if (BOTH(3) && !rm34) GRID_BAR(3);
    }

    if (IN(4)) {
        PHASE_ARGS();
        pg8::Sched S; S.init(M / 256, DM / 256, G, (int)blockIdx.x, 0, 0, WS_MG8, WS_MG8, WS_WO8, WS_WO8, DM);
        if (rm34) {
            S.rm = 2; S.rho = (int)blockIdx.x / pg8::NXCD; S.xq = (int)blockIdx.x % pg8::NXCD;
            { LANE_TID(); if (wave == 0 && lane == 0) {
                  const int rho = (int)blockIdx.x / pg8::NXCD, xq = (int)blockIdx.x % pg8::NXCD, nu = rho >= 16 ? 3 : 2, p0 = rho >= 16 ? rho - 16 : 48 + rho;
                  for (int k = 0; k < nu; ++k) { const int pp = p0 + 16 * k, pm = pp < 64 ? 8 * (2 * (pp >> 5) + (xq >> 2)) + (pp & 7) : 32 + ((pp - 64) & 7); unsigned sp = 0;
                      while (__hip_atomic_load(ctl + CW_PM + 16 * pm, RLX_AGENT) < 16u) { __builtin_amdgcn_s_sleep(4); if (++sp > (1u << 22)) break; } }
                  __builtin_amdgcn_fence(__ATOMIC_ACQUIRE, "agent"); } }
            __syncthreads();
        }
        pg8::EpiOut E{(const bf16*)(ws + WS_XB), (bf16*)(ws + WS_PRE), DN_ALPHA};
        pg8::gemm_phase<pg8::EpiOut, PG8_ALIGN, PG8_SP2, true>(lds + RING_OFF, wave, rsrc, DM, DM, S, E);
        if (BOTH(4)) GRID_BAR(4);
    }

    if (IN(5)) {
        PHASE_ARGS(); (void)rsrc; LANE_TID();
        const float *ln_g = ap->in[12], *ln_b = ap->in[13]; float* out = ap->out;
        for (int m = gw; m < M; m += NGW) {
            const pg8::u32x4* rp = (const pg8::u32x4*)((const bf16*)(ws + WS_PRE) + (size_t)m * DM) + lane;
            f32x4 v[16]; float s = 0.f;
#pragma unroll
            for (int j = 0; j < 8; ++j) { const pg8::u32x4 w = rp[64 * j]; v[2 * j] = pg8::bf4_lo(w); v[2 * j + 1] = pg8::bf4_hi(w); }
#pragma unroll
            for (int j = 0; j < 16; ++j) s += (v[j].x + v[j].y) + (v[j].z + v[j].w);
            const float mean = wave_sum(s) * (1.f / DM); float s2 = 0.f;
#pragma unroll
            for (int j = 0; j < 16; ++j) { v[j] = v[j] - mean; s2 += (v[j].x * v[j].x + v[j].y * v[j].y) + (v[j].z * v[j].z + v[j].w * v[j].w); }
            const float rstd = 1.f / sqrtf(wave_sum(s2) * (1.f / DM) + LN_EPS);
            float* orow = out + pg8::OUT_Y + (size_t)m * DM;
#pragma unroll
            for (int j = 0; j < 16; ++j) { const int e = ((j >> 1) * 64 + lane) * 8 + (j & 1) * 4;
                const f32x4 g = *(const f32x4*)(ln_g + e), bb = *(const f32x4*)(ln_b + e); *(GAS f32x4*)(orow + e) = v[j] * rstd * g + bb; }
        }
    }
#undef IN
#undef BOTH
}

extern "C" void kernel_launch(void* const* d_in, const int* in_sizes, int n_in, void* d_out, int out_size, void* d_ws, size_t ws_size, hipStream_t stream) {
    static int grid = 0;
    if (grid == 0) {
        if (n_in != 14 || (size_t)out_size != pg8::OUT_TOTAL || ws_size < WS_END) { fprintf(stderr, "kernel_launch: unexpected problem (n_in %d, out %d, ws %zu; need ws >= %zu); nothing launched\n", n_in, out_size, ws_size, (size_t)WS_END); grid = -1; return; }
        int dev = 0, cus = 0, per_cu = 0;
        if (hipGetDevice(&dev) != hipSuccess || hipDeviceGetAttribute(&cus, hipDeviceAttributeMultiprocessorCount, dev) != hipSuccess) { fprintf(stderr, "kernel_launch: device query failed\n"); grid = -1; return; }
        if (hipFuncSetAttribute((const void*)mk_fwd, hipFuncAttributeMaxDynamicSharedMemorySize, LDS_BYTES) != hipSuccess) { fprintf(stderr, "kernel_launch: hipFuncSetAttribute failed\n"); grid = -1; return; }
        if (hipOccupancyMaxActiveBlocksPerMultiprocessor(&per_cu, (const void*)mk_fwd, NWAVES * 64, LDS_BYTES) != hipSuccess || per_cu < 1) { fprintf(stderr, "kernel_launch: occupancy query reports %d workgroups per CU\n", per_cu); }
        (void)hipGetLastError();
        grid = cus;
    }
    if (grid < 0) return;
    if (hipMemsetAsync((char*)d_ws + WS_CTL, 0, CTL_ZERO_BYTES, stream) != hipSuccess) { fprintf(stderr, "kernel_launch: hipMemsetAsync failed\n"); return; }
    KArgs a{};
    for (int i = 0; i < 14; ++i) a.in[i] = (const float*)d_in[i];
    a.out = (float*)d_out; a.ws = (unsigned char*)d_ws;
    if (N_LAUNCHES == 1) {
        a.ph_lo = 0; a.ph_hi = PER_PHASE;
        hipLaunchKernelGGL(mk_fwd, dim3(grid), dim3(NWAVES * 64), LDS_BYTES, stream, a);
    } else {
        for (int li = 0; li < PER_PHASE; ++li) { a.ph_lo = li; a.ph_hi = li + 1; hipLaunchKernelGGL(mk_fwd, dim3(grid), dim3(NWAVES * 64), LDS_BYTES, stream, a); }
    }
    const hipError_t le = hipPeekAtLastError();
    if (le != hipSuccess) fprintf(stderr, "kernel_launch: launch failed: %s\n", hipGetErrorName(le));
}
```

```cpp
#include <hip/hip_runtime.h>
#include <cstdio>
#include <cstdint>

#ifndef MK_N_LAUNCHES
#define MK_N_LAUNCHES 1
#endif
#ifndef SB_PRUNE
#define SB_PRUNE 1
#endif

namespace pg8 {
#define PG8_LAS __attribute__((address_space(3)))
typedef unsigned short bf16_t;
typedef short bf16x8 __attribute__((ext_vector_type(8)));
typedef float f32x4 __attribute__((ext_vector_type(4)));
typedef unsigned u32x4 __attribute__((ext_vector_type(4)));
constexpr int BM = 256, BK = 64, HALF = 128, HTB = HALF * BK * 2  , STAGE_BYTES = 8 * HTB, NXCD = 8, WGM = 8;

__host__ __device__ __forceinline__ int lds_byte(int r, int c) { const int st = (r >> 4) * 2 + (c >> 5), rr = r & 15, cc = c & 31, ob = rr * 64 + cc * 2; return st * 1024 + (ob ^ (((ob >> 9) & 1) << 5)); }
__host__ __device__ __forceinline__ void stage_rc(int b, int& R, int& C) { const int st = b / 1024, sb = b % 1024, swz = sb ^ (((sb >> 9) & 1) << 5); R = (st >> 1) * 16 + swz / 64; C = (st & 1) * 32 + (swz % 64) / 2; }
__host__ __device__ __forceinline__ int perm32(int rho) { const int n = rho >> 4, i = rho & 15; return 8 * (i >> 2) + 4 * n + (i & 3); }

struct Unit { int pm, pn, z; };

struct Sched {
    int nM, nN, nwg, G, c, zmode, pm0;
    int il;
    int rm, rho, xq;
    int nextra;
    int tail_c0;
    unsigned A0, A1, B0, B1, tstep;
    __device__ void init(int nM_, int nN_, int G_, int c_, int zmode_, int pm0_, size_t a0, size_t a1, size_t b0, size_t b1, int LDb) {
        nM = nM_; nN = nN_; nwg = nM * nN; G = G_; c = c_; zmode = zmode_; pm0 = pm0_; nextra = 0; tail_c0 = -1; rm = 0; rho = 0; xq = 0; il = 0; A0 = (unsigned)a0; A1 = (unsigned)a1; B0 = (unsigned)b0; B1 = (unsigned)b1; tstep = (unsigned)(BM * LDb); }
    __device__ bool next(int i, Unit& u) const {
        int ii = i, z = 0;
        if (zmode == 1) { ii = i >> 1; z = i & 1; }
        if (rm) {
            int p;
            if (rm == 1) { if (ii < 2) p = 32 * ii + rho; else if (ii == 2 && rho < 16) p = 64 + rho; else return false; }
            else if (rho >= 16) { if (ii > 2) return false; p = rho - 16 + 16 * ii; } else { if (ii > 1) return false; p = 48 + rho + 16 * ii; }
            return rm_at(p, u, z);
        }
        long L = (long)ii * G + c;
        if (tail_c0 >= 0) { const int full = nwg / G; if (ii >= full) { if (c < tail_c0) return false; const long idx = (long)(ii - full) * (G - tail_c0) + (c - tail_c0); if (idx >= nwg - (long)full * G) return false; L = (long)full * G + idx; } }
        return at(L, u, z);
    }
    __device__ bool rm_at(int p, Unit& u, int z) const {
        if (p < 64) { const int r = p >> 5, q = p & 31; u.pm = pm0 + 8 * (2 * r + (xq >> 2)) + (q & 7); u.pn = 4 * (xq & 3) + (q >> 3); }
        else { const int q = p - 64; u.pm = pm0 + 32 + (q & 7); u.pn = 2 * xq + (q >> 3); }
        u.z = z; return true;
    }
    __device__ bool at(long L, Unit& u, int z = 0) const {
        if (il) {
            const int k = (int)(L / NXCD), x = (int)(L % NXCD);
            if (k >= 400) return false;
            if (k < 384) { const int blk = 8 * (k >> 5) + x, q = k & 31, g = blk / 20, j = blk % 20; u.pm = pm0 + 8 * g + (q & 7); u.pn = 4 * j + (q >> 3); }
            else { const int q = k - 384; u.pm = pm0 + 32 + (q & 7); u.pn = 64 + 2 * x + (q >> 3); }
            u.z = z; return true;
        }
        if (L >= nwg) { if (L >= nwg + nextra) return false; u.pm = 0; u.pn = (int)(L - nwg); u.z = 1; return true; }
        int wgid = (int)L; { const int q = nwg / NXCD, r = nwg % NXCD, xcd = wgid % NXCD, off = wgid / NXCD; wgid = (xcd < r ? xcd * (q + 1) : r * (q + 1) + (xcd - r) * q) + off; }
        const int nig = WGM * nN, gid = wgid / nig, fm = gid * WGM, gsz = (nM - fm) < WGM ? (nM - fm) : WGM;
        u.pm = pm0 + fm + ((wgid % nig) % gsz); u.pn = (wgid % nig) / gsz; u.z = z; return true;
    }
    __device__ __forceinline__ unsigned ptrA(const Unit& u) const { return (u.z ? A1 : A0) + (unsigned)u.pm * tstep; }
    __device__ __forceinline__ unsigned ptrB(const Unit& u) const { return (u.z ? B1 : B0) + (unsigned)u.pn * tstep; }
};

typedef __bf16 bf16v2_t __attribute__((ext_vector_type(2)));
typedef float f32v2_t __attribute__((ext_vector_type(2)));
__device__ __forceinline__ unsigned cvt_pk_bf16(float lo, float hi) { const bf16v2_t r = __builtin_convertvector((f32v2_t){lo, hi}, bf16v2_t); return __builtin_bit_cast(unsigned, r); }
__device__ __forceinline__ u32x4 pack8(const f32x4 a, const f32x4 b) { u32x4 w; w.x = cvt_pk_bf16(a[0], a[1]); w.y = cvt_pk_bf16(a[2], a[3]); w.z = cvt_pk_bf16(b[0], b[1]); w.w = cvt_pk_bf16(b[2], b[3]); return w; }
__device__ __forceinline__ float bf_lo(unsigned w) { return __uint_as_float(w << 16); }
__device__ __forceinline__ float bf_hi(unsigned w) { return __uint_as_float(w & 0xffff0000u); }
__device__ __forceinline__ float sigmoid_f(float v) { return __builtin_amdgcn_rcpf(1.0f + __builtin_amdgcn_exp2f(-1.4426950408889634f * v)); }
__device__ __forceinline__ f32x4 sigmoid4(f32x4 v) { return (f32x4){sigmoid_f(v[0]), sigmoid_f(v[1]), sigmoid_f(v[2]), sigmoid_f(v[3])}; }
__device__ __forceinline__ f32x4 silu4(f32x4 v) { return v * sigmoid4(v); }


constexpr size_t OUT_Y = 0, OUT_KP = 41943040, OUT_VP = 58720256, OUT_CP = 75497472, OUT_KS = 75513856, OUT_VS = 79708160, OUT_CS = 83902464, OUT_TOTAL = 84033536;
constexpr float QSCALE = 0.08838834764831845f * 1.4426950408889634f;

typedef unsigned u32x2 __attribute__((ext_vector_type(2)));
__device__ __forceinline__ float clamp8(float v) { return __builtin_amdgcn_fmed3f(v, -448.0f, 448.0f); }
__device__ __forceinline__ unsigned cvt4_fp8(const f32x4 a) { unsigned w = __builtin_amdgcn_cvt_pk_fp8_f32(clamp8(a[0]), clamp8(a[1]), 0, false); return __builtin_amdgcn_cvt_pk_fp8_f32(clamp8(a[2]), clamp8(a[3]), w, true); }
__device__ __forceinline__ u32x2 pack8_fp8(const f32x4 a, const f32x4 b) { u32x2 w; w.x = cvt4_fp8(a); w.y = cvt4_fp8(b); return w; }
constexpr float SC_WIN = 64.f, SC_WAB = 64.f, SC_WO = 128.f, SC_Y = 4.f, SC_MG = 8.f;

struct EpiProjB {
    static constexpr bool PERM = true, AFTER_DRAIN = false;
    const float* bias;
    bf16_t *K, *V;
    float* out;
    unsigned* sig;
    __device__ __forceinline__ unsigned* sig_ptr(const Unit& u) const { return (sig != nullptr && u.z == 0 && u.pm < 32) ? sig + 16 * (u.pm >> 3) : nullptr; }
    __device__ __forceinline__ void operator()(const f32x4 (&acc)[2][2][4][2], const Unit& u, int wr, int wc, int fr, int fq) const {
        const int pn = u.pn, cl = wc * 32 + 8 * fq;
        if (u.z == 0) {
            const int row0 = u.pm * BM + wr * 64 + fr;
            const bool isv = pn >= 8; const int c0 = (pn & 7) * BM + cl;
            const float* bp = bias + (isv ? 4096 : 2048) + c0;
            f32x4 bv[2][2];
#pragma unroll
            for (int bj = 0; bj < 2; ++bj)
#pragma unroll
                for (int n = 0; n < 2; ++n) bv[bj][n] = *(const f32x4*)(bp + bj * HALF + 4 * n);
            bf16_t* B = isv ? V : K;
            float* O = (u.pm < 32) ? out + (isv ? OUT_VP : OUT_KP) : out + (isv ? OUT_VS : OUT_KS) - (size_t)8192 * 2048;
#pragma unroll
            for (int ai = 0; ai < 2; ++ai)
#pragma unroll
                for (int m = 0; m < 4; ++m) { const size_t ro = (size_t)(row0 + ai * HALF + m * 16) * 2048 + c0;
#pragma unroll
                    for (int bj = 0; bj < 2; ++bj) { const f32x4 v0 = acc[ai][bj][m][0] + bv[bj][0], v1 = acc[ai][bj][m][1] + bv[bj][1];
                        *(u32x4*)(B + ro + bj * HALF) = pack8(v0, v1); *(f32x4*)(O + ro + bj * HALF) = v0; *(f32x4*)(O + ro + bj * HALF + 4) = v1; } }
        } else {
            const int ch = pn * HALF + cl;
            f32x4 bc[2], bh[2];
#pragma unroll
            for (int n = 0; n < 2; ++n) { bc[n] = *(const f32x4*)(bias + 10240 + ch + 4 * n); bh[n] = *(const f32x4*)(bias + 12288 + ch + 4 * n); }
#pragma unroll
            for (int ai = 0; ai < 1; ++ai)
#pragma unroll
                for (int m = 0; m < 4; ++m) { const int row = wr * 64 + m * 16 + fr;
                    if (row < 72) { float* cp = (row < 8) ? out + OUT_CP + (size_t)row * 2048 + ch : out + OUT_CS + (size_t)(row - 8) * 2048 + ch;
                        *(f32x4*)cp = (acc[0][0][m][0] + bc[0]) * (acc[0][1][m][0] + bh[0]); *(f32x4*)(cp + 4) = (acc[0][0][m][1] + bc[1]) * (acc[0][1][m][1] + bh[1]); } }
        }
    }
};

struct EpiProj8 {
    static constexpr bool PERM = true, AFTER_DRAIN = false;
    const float* bias;
    bf16_t *Q, *SZA, *U, *GT, *SGA, *SGB;
    unsigned* sig;
    __device__ __forceinline__ unsigned* sig_ptr(const Unit& u) const { return (sig != nullptr && u.pn < 16 && u.pm < 32) ? sig + 16 * (u.pm >> 3) : nullptr; }
    __device__ __forceinline__ void operator()(const f32x4 (&acc)[2][2][4][2], const Unit& u, int wr, int wc, int fr, int fq) const {
        const int pn = u.pn, row0 = u.pm * BM + wr * 64 + fr, cl = wc * 32 + 8 * fq;
        constexpr float DS = 1.0f / SC_WIN;
        if (pn >= 16 && pn < 32) {
            const int ch = (pn - 16) * HALF + cl;
            f32x4 bc[2], bh[2];
#pragma unroll
            for (int n = 0; n < 2; ++n) { bc[n] = *(const f32x4*)(bias + 10240 + ch + 4 * n); bh[n] = *(const f32x4*)(bias + 12288 + ch + 4 * n); }
#pragma unroll
            for (int ai = 0; ai < 2; ++ai)
#pragma unroll
                for (int m = 0; m < 4; ++m) { const int row = row0 + ai * HALF + m * 16;
                    *(u32x4*)(U + (size_t)row * 2048 + ch) = pack8((acc[ai][0][m][0] * DS + bc[0]) * (acc[ai][1][m][0] * DS + bh[0]), (acc[ai][0][m][1] * DS + bc[1]) * (acc[ai][1][m][1] * DS + bh[1])); }
        } else if (pn >= 32 && pn < 48) {
            const int ch = (pn - 32) * HALF + cl;
            f32x4 bb[2], bz[2];
#pragma unroll
            for (int n = 0; n < 2; ++n) { bb[n] = *(const f32x4*)(bias + 8192 + ch + 4 * n); bz[n] = *(const f32x4*)(bias + 14336 + ch + 4 * n); }
#pragma unroll
            for (int ai = 0; ai < 2; ++ai)
#pragma unroll
                for (int m = 0; m < 4; ++m) { const int row = row0 + ai * HALF + m * 16;
                    const f32x4 g0 = (acc[ai][0][m][0] * DS + bb[0]) * silu4(acc[ai][1][m][0] * DS + bz[0]), g1 = (acc[ai][0][m][1] * DS + bb[1]) * silu4(acc[ai][1][m][1] * DS + bz[1]);
                    *(u32x4*)(GT + (size_t)row * 2048 + ch) = pack8(g0, g1); }
        } else {
            int kind, c0, ld, sb; bf16_t* B;
            if (pn < 8) { kind = 0; c0 = pn * BM + cl; sb = c0; ld = 2048; B = Q; }
            else if (pn < 16) { kind = 1; c0 = (pn - 8) * BM + cl; sb = 6144 + c0; ld = 2048; B = SZA; }
            else if (pn < 64) { kind = 2; c0 = (pn - 48) * BM + cl; sb = 16384 + c0; ld = 4096; B = SGA; }
            else { kind = 2; c0 = (pn - 64) * BM + cl; sb = 20480 + c0; ld = 4096; B = SGB; }
            f32x4 bv[2][2];
#pragma unroll
            for (int bj = 0; bj < 2; ++bj)
#pragma unroll
                for (int n = 0; n < 2; ++n) bv[bj][n] = *(const f32x4*)(bias + sb + bj * HALF + 4 * n);
#pragma unroll
            for (int ai = 0; ai < 2; ++ai)
#pragma unroll
                for (int m = 0; m < 4; ++m) { bf16_t* rowp = B + (size_t)(row0 + ai * HALF + m * 16) * ld + c0;
#pragma unroll
                    for (int bj = 0; bj < 2; ++bj) { f32x4 v0 = acc[ai][bj][m][0] * DS + bv[bj][0], v1 = acc[ai][bj][m][1] * DS + bv[bj][1];
                        if (kind == 0) { v0 = v0 * QSCALE; v1 = v1 * QSCALE; } else if (kind == 1) { v0 = silu4(v0); v1 = silu4(v1); } else { v0 = sigmoid4(v0); v1 = sigmoid4(v1); }
                        *(u32x4*)(rowp + bj * HALF) = pack8(v0, v1); } }
        }
    }
};

__device__ __forceinline__ f32x4 bf4_lo(const u32x4 w) { return (f32x4){bf_lo(w.x), bf_hi(w.x), bf_lo(w.y), bf_hi(w.y)}; }
__device__ __forceinline__ f32x4 bf4_hi(const u32x4 w) { return (f32x4){bf_lo(w.z), bf_hi(w.z), bf_lo(w.w), bf_hi(w.w)}; }
struct EpiMerge {
    static constexpr bool PERM = true, AFTER_DRAIN = false;
    const bf16_t *SGA, *SGB; bf16_t* M1; unsigned char* MG8; __amdgpu_buffer_rsrc_t wsr; unsigned offMG8;
    unsigned* sig;
    __device__ __forceinline__ unsigned* sig_ptr(const Unit& u) const { return (sig != nullptr && u.z == 1) ? sig + 16 * u.pm : nullptr; }
    static constexpr float GB_MIN = 9.094947017729282e-13f;
    __device__ __forceinline__ void scale(f32x4 (&acc)[2][2][4][2], const Unit& u, int wr, int wc, int fr, int fq) const {
        const int row0 = u.pm * BM + wr * 64 + fr, col0 = u.pn * BM + wc * 32 + 8 * fq;
#pragma unroll
        for (int ai = 0; ai < 2; ++ai) {
#pragma unroll
          for (int mh = 0; mh < 2; ++mh) {
            u32x4 ga[2][2], gb[2][2];
#pragma unroll
            for (int mm = 0; mm < 2; ++mm)
#pragma unroll
                for (int bj = 0; bj < 2; ++bj) { const size_t ro = (size_t)(row0 + ai * HALF + (2 * mh + mm) * 16) * 4096 + col0 + bj * HALF;
                    ga[mm][bj] = *(const u32x4*)(SGA + ro); gb[mm][bj] = *(const u32x4*)(SGB + ro); }
#pragma unroll
            for (int mm = 0; mm < 2; ++mm)
#pragma unroll
                for (int bj = 0; bj < 2; ++bj) { const int m = 2 * mh + mm;
                    const f32x4 b0 = bf4_lo(gb[mm][bj]), b1 = bf4_hi(gb[mm][bj]);
                    f32x4 r0, r1;
#pragma unroll
                    for (int e = 0; e < 4; ++e) { r0[e] = __builtin_amdgcn_rcpf(fmaxf(b0[e], GB_MIN)); r1[e] = __builtin_amdgcn_rcpf(fmaxf(b1[e], GB_MIN)); }
                    acc[ai][bj][m][0] = acc[ai][bj][m][0] * (bf4_lo(ga[mm][bj]) * r0); acc[ai][bj][m][1] = acc[ai][bj][m][1] * (bf4_hi(ga[mm][bj]) * r1); }
          }
        }
    }
    __device__ __forceinline__ void operator()(const f32x4 (&acc)[2][2][4][2], const Unit& u, int wr, int wc, int fr, int fq) const {
        const int row0 = u.pm * BM + wr * 64 + fr, col0 = u.pn * BM + wc * 32 + 8 * fq;
        constexpr float DS = SC_MG / (SC_Y * SC_WAB);
#pragma unroll
        for (int ai = 0; ai < 2; ++ai) {
            u32x4 g[4][2];
#pragma unroll
            for (int m = 0; m < 4; ++m)
#pragma unroll
                for (int bj = 0; bj < 2; ++bj) g[m][bj] = *(const u32x4*)(SGB + (size_t)(row0 + ai * HALF + m * 16) * 4096 + col0 + bj * HALF);
#pragma unroll
            for (int m = 0; m < 4; ++m)
#pragma unroll
                for (int bj = 0; bj < 2; ++bj) { const size_t ro = (size_t)(row0 + ai * HALF + m * 16) * 4096 + col0 + bj * HALF;
                    const f32x4 b0 = bf4_lo(g[m][bj]), b1 = bf4_hi(g[m][bj]);
                    f32x4 c0, c1;
#pragma unroll
                    for (int e = 0; e < 4; ++e) { c0[e] = fmaxf(b0[e], GB_MIN) * DS; c1[e] = fmaxf(b1[e], GB_MIN) * DS; }
                    __builtin_amdgcn_raw_buffer_store_b64(pack8_fp8(acc[ai][bj][m][0] * c0, acc[ai][bj][m][1] * c1), wsr, (int)(offMG8 + (unsigned)ro), 0, 16  ); }
        }
    }
};

struct EpiOut {
    static constexpr bool PERM = true, AFTER_DRAIN = false;
    const bf16_t* XB; bf16_t* PRE; float alpha;
    __device__ __forceinline__ void operator()(const f32x4 (&acc)[2][2][4][2], const Unit& u, int wr, int wc, int fr, int fq) const {
        const int row0 = u.pm * BM + wr * 64 + fr, col0 = u.pn * BM + wc * 32 + 8 * fq;
        constexpr float DS = 1.0f / (SC_MG * SC_WO);
#pragma unroll
        for (int ai = 0; ai < 2; ++ai) {
            u32x4 xv[4][2];
#pragma unroll
            for (int m = 0; m < 4; ++m)
#pragma unroll
                for (int bj = 0; bj < 2; ++bj) xv[m][bj] = *(const u32x4*)(XB + (size_t)(row0 + ai * HALF + m * 16) * 4096 + col0 + bj * HALF);
#pragma unroll
            for (int m = 0; m < 4; ++m)
#pragma unroll
                for (int bj = 0; bj < 2; ++bj) { const size_t ro = (size_t)(row0 + ai * HALF + m * 16) * 4096 + col0 + bj * HALF;
                    *(u32x4*)(PRE + ro) = pack8(bf4_lo(xv[m][bj]) * alpha + acc[ai][bj][m][0] * DS, bf4_hi(xv[m][bj]) * alpha + acc[ai][bj][m][1] * DS); }
        }
    }
};

typedef int v8i_t __attribute__((ext_vector_type(8)));
struct Dyn { unsigned* ctr; int x, first, base; volatile PG8_LAS unsigned* slot; unsigned* once; int once_k; unsigned* once_x; unsigned once_nloc; };
template <class T> struct has_sig { static constexpr bool v = false; };
template <> struct has_sig<EpiMerge> { static constexpr bool v = true; };
template <class T> struct has_chain { static constexpr bool v = false; };
template <> struct has_chain<EpiMerge> { static constexpr bool v = true; };

template <class Epi, bool ALIGN_EPI = false, bool SP2 = false, bool F8 = false, bool DYN = false>
__device__ __forceinline__ void gemm_phase(PG8_LAS unsigned char* lds, const int wave_sgpr, const __amdgpu_buffer_rsrc_t rsrc, const int LDb, const int Kb, const Sched& S, const Epi& E, const Dyn D = Dyn{nullptr, 0, 0, 0, nullptr, nullptr, 0, nullptr, 1u}) {
    int lane_ = (int)__builtin_amdgcn_mbcnt_hi(~0u, __builtin_amdgcn_mbcnt_lo(~0u, 0u)); asm volatile("" : "+v"(lane_));
    const int wid = wave_sgpr, lane = lane_, tid = wid * 64 + lane, wr = wid >> 2, wc = wid & 3, fr = lane & 15, fq = lane >> 4;
    const int nt = Kb / 128;
    unsigned voffA[2], voffB[2];
#pragma unroll
    for (int i = 0; i < 2; ++i) { int R, C; stage_rc(tid * 16 + i * 8192, R, C); const int Rb = Epi::PERM ? ((R & ~31) + perm32(R & 31)) : R;
        voffA[i] = (unsigned)(R * LDb + C * 2); voffB[i] = (unsigned)(Rb * LDb + C * 2); }
    const unsigned kstep = 128u;
    const unsigned hstep = (unsigned)(HALF * LDb);
    const unsigned ldsw = (unsigned)wid * 1024u;
    constexpr int KOFF = 1024;
    const int aoff = lds_byte(wr * 64 + fr, fq * 8), boff = lds_byte(wc * 32 + fr, fq * 8);
#define PG8_SA(b, h) (((b) * 2 + (h)) * HTB)
#define PG8_SB(b, h) ((4 + (b) * 2 + (h)) * HTB)
#define PG8_STAGE(bufoff, gbase, voff) do { _Pragma("unroll") for (int _i = 0; _i < 2; ++_i) \
        __builtin_amdgcn_raw_ptr_buffer_load_lds(rsrc, (PG8_LAS void*)(lds + (bufoff) + ldsw + _i * 8192), 16, (int)(voff)[_i], (int)(gbase), 0, 0); } while (0)
#define PG8_LDA(dst, b, h) do { _Pragma("unroll") for (int m = 0; m < 4; ++m) _Pragma("unroll") for (int k = 0; k < 2; ++k) dst[m][k] = *(const PG8_LAS bf16x8*)(lds + PG8_SA(b, h) + aoff + m * 2048 + k * KOFF); } while (0)
#define PG8_LDB(dst, b, h) do { _Pragma("unroll") for (int n = 0; n < 2; ++n) _Pragma("unroll") for (int k = 0; k < 2; ++k) dst[n][k] = *(const PG8_LAS bf16x8*)(lds + PG8_SB(b, h) + boff + n * 2048 + k * KOFF); } while (0)
#define PG8_MMA(ai, bj, At, Bt) do { __builtin_amdgcn_s_setprio(1); _Pragma("unroll") for (int m = 0; m < 4; ++m) _Pragma("unroll") for (int n = 0; n < 2; ++n) { \
        if constexpr (F8) { typedef int v4i_t __attribute__((ext_vector_type(4))); \
            const v8i_t pa = __builtin_shufflevector(__builtin_bit_cast(v4i_t, At[m][0]), __builtin_bit_cast(v4i_t, At[m][1]), 0, 1, 2, 3, 4, 5, 6, 7); \
            const v8i_t pb = __builtin_shufflevector(__builtin_bit_cast(v4i_t, Bt[n][0]), __builtin_bit_cast(v4i_t, Bt[n][1]), 0, 1, 2, 3, 4, 5, 6, 7); \
            acc[ai][bj][m][n] = __builtin_amdgcn_mfma_scale_f32_16x16x128_f8f6f4(pb, pa, acc[ai][bj][m][n], 0, 0, 0, 0, 0, 0); } \
        else { _Pragma("unroll") for (int k = 0; k < 2; ++k) acc[ai][bj][m][n] = __builtin_amdgcn_mfma_f32_16x16x32_bf16(Bt[n][k], At[m][k], acc[ai][bj][m][n], 0, 0, 0); } } \
        __builtin_amdgcn_s_setprio(0); } while (0)
#define PG8_WAIT_V(n) asm volatile("s_waitcnt vmcnt(" #n ")" ::: "memory")
#define PG8_WAIT_L(n) asm volatile("s_waitcnt lgkmcnt(" #n ")" ::: "memory")
#define PG8_BAR __builtin_amdgcn_s_barrier()
#define PG8_SCHED __builtin_amdgcn_sched_barrier(0)
    Unit cur, nxt; int ui = 0; bool once_done = false;
    if constexpr (DYN) {
        if (!S.at((long)D.first * NXCD + D.x, cur)) return;
        if (wid == 0) { if (lane == 0) { const unsigned t = __hip_atomic_fetch_add(D.ctr, 1u, __ATOMIC_RELAXED, __HIP_MEMORY_SCOPE_AGENT) + (unsigned)D.base; *D.slot = t; } asm volatile("s_waitcnt lgkmcnt(0)" ::: "memory"); }
        __builtin_amdgcn_s_barrier();
    } else { if (!S.next(0, cur)) return; }
    f32x4 acc[2][2][4][2];
#pragma unroll
    for (int a = 0; a < 2; ++a)
#pragma unroll
        for (int b = 0; b < 2; ++b)
#pragma unroll
            for (int m = 0; m < 4; ++m)
#pragma unroll
                for (int n = 0; n < 2; ++n) acc[a][b][m][n] = (f32x4){0.f, 0.f, 0.f, 0.f};
    bf16x8 At[4][2], B0[2][2], B1[2][2];
    unsigned cA = S.ptrA(cur), cB = S.ptrB(cur);
    if constexpr (SP2) {
        PG8_STAGE(PG8_SB(0, 0), cB, voffB); PG8_STAGE(PG8_SB(0, 1), cB + hstep, voffB); PG8_STAGE(PG8_SA(0, 0), cA, voffA); PG8_STAGE(PG8_SA(0, 1), cA + hstep, voffA);
        if (wr == 1) PG8_BAR;
        PG8_WAIT_V(2); PG8_BAR;
        PG8_STAGE(PG8_SB(1, 0), cB + kstep, voffB); PG8_STAGE(PG8_SA(1, 0), cA + kstep, voffA); PG8_STAGE(PG8_SB(1, 1), cB + hstep + kstep, voffB);
        PG8_WAIT_V(6); PG8_BAR;
    } else {
        PG8_STAGE(PG8_SB(0, 0), cB, voffB); PG8_STAGE(PG8_SA(0, 0), cA, voffA); PG8_STAGE(PG8_SB(0, 1), cB + hstep, voffB); PG8_STAGE(PG8_SA(0, 1), cA + hstep, voffA);
        if (wr == 1) PG8_BAR;
        PG8_WAIT_V(4); PG8_BAR;
        PG8_STAGE(PG8_SB(1, 0), cB + kstep, voffB); PG8_STAGE(PG8_SA(1, 0), cA + kstep, voffA); PG8_STAGE(PG8_SB(1, 1), cB + hstep + kstep, voffB);
        PG8_WAIT_V(6); PG8_BAR;
    }
    for (;;) {
        bool has_next;
        unsigned tn = 0;
        if constexpr (DYN) { tn = (unsigned)__builtin_amdgcn_readfirstlane((int)*D.slot); has_next = S.at((long)tn * NXCD + D.x, nxt); }
        else has_next = S.next(ui + 1, nxt);
        const unsigned nA = has_next ? S.ptrA(nxt) : cA, nB = has_next ? S.ptrB(nxt) : cB;
        for (int t = 0; t < nt; t += 2) {
            const bool last = (t == nt - 2);
            const unsigned a1 = cA + (unsigned)(t + 1) * kstep;
            const unsigned a2 = last ? nA : cA + (unsigned)(t + 2) * kstep, b2 = last ? nB : cB + (unsigned)(t + 2) * kstep;
            const unsigned a3 = a2 + kstep, b3 = b2 + kstep;
            if constexpr (SP2) {
            PG8_LDB(B0, 0, 0); PG8_LDB(B1, 0, 1); PG8_SCHED; PG8_LDA(At, 0, 0); PG8_STAGE(PG8_SA(1, 1), a1 + hstep, voffA);
            PG8_WAIT_V(8); PG8_WAIT_L(0); PG8_BAR; PG8_MMA(0, 0, At, B0); PG8_MMA(0, 1, At, B1); PG8_BAR; PG8_SCHED;
            PG8_LDA(At, 0, 1); PG8_STAGE(PG8_SB(0, 0), b2, voffB); PG8_STAGE(PG8_SB(0, 1), b2 + hstep, voffB); PG8_STAGE(PG8_SA(0, 0), a2, voffA);
            PG8_WAIT_V(8); PG8_WAIT_L(0); PG8_BAR; PG8_MMA(1, 0, At, B0); PG8_MMA(1, 1, At, B1); PG8_BAR; PG8_SCHED;
            PG8_LDB(B0, 1, 0); PG8_LDB(B1, 1, 1); PG8_SCHED; PG8_LDA(At, 1, 0); PG8_STAGE(PG8_SA(0, 1), a2 + hstep, voffA);
            PG8_WAIT_V(8); PG8_WAIT_L(0); PG8_BAR; PG8_MMA(0, 0, At, B0); PG8_MMA(0, 1, At, B1); PG8_BAR; PG8_SCHED;
            PG8_LDA(At, 1, 1); PG8_STAGE(PG8_SB(1, 0), b3, voffB); PG8_STAGE(PG8_SB(1, 1), b3 + hstep, voffB); PG8_STAGE(PG8_SA(1, 0), a3, voffA);
            PG8_WAIT_V(8); PG8_WAIT_L(0); PG8_BAR; PG8_MMA(1, 0, At, B0); PG8_MMA(1, 1, At, B1); PG8_BAR; PG8_SCHED;
            } else {
            PG8_LDB(B0, 0, 0); PG8_SCHED; PG8_LDA(At, 0, 0); PG8_STAGE(PG8_SA(1, 1), a1 + hstep, voffA);
            PG8_WAIT_L(8); PG8_BAR; PG8_WAIT_L(0); PG8_MMA(0, 0, At, B0); PG8_BAR; PG8_SCHED;
            PG8_LDB(B1, 0, 1); PG8_STAGE(PG8_SB(0, 0), b2, voffB);
            PG8_BAR; PG8_WAIT_L(0); PG8_MMA(0, 1, At, B1); PG8_BAR;
            PG8_LDA(At, 0, 1); PG8_STAGE(PG8_SA(0, 0), a2, voffA);
            PG8_BAR; PG8_WAIT_L(0); PG8_MMA(1, 0, At, B0); PG8_BAR; PG8_SCHED;
            PG8_STAGE(PG8_SB(0, 1), b2 + hstep, voffB);
            PG8_WAIT_V(6); PG8_BAR; PG8_MMA(1, 1, At, B1); PG8_BAR;
            PG8_LDB(B0, 1, 0); PG8_SCHED; PG8_LDA(At, 1, 0); PG8_STAGE(PG8_SA(0, 1), a2 + hstep, voffA);
            PG8_WAIT_L(8); PG8_BAR; PG8_WAIT_L(0); PG8_MMA(0, 0, At, B0); PG8_BAR; PG8_SCHED;
            PG8_LDB(B1, 1, 1); PG8_STAGE(PG8_SB(1, 0), b3, voffB);
            PG8_BAR; PG8_WAIT_L(0); PG8_MMA(0, 1, At, B1); PG8_BAR;
            PG8_LDA(At, 1, 1); PG8_STAGE(PG8_SA(1, 0), a3, voffA);
            PG8_BAR; PG8_WAIT_L(0); PG8_MMA(1, 0, At, B0); PG8_BAR; PG8_SCHED;
            PG8_STAGE(PG8_SB(1, 1), b3 + hstep, voffB);
            PG8_WAIT_V(6); PG8_BAR; PG8_MMA(1, 1, At, B1); PG8_BAR;
            }
        }
        if constexpr (ALIGN_EPI) { if (wr == 0) PG8_BAR; }
        { int lz = (int)__builtin_amdgcn_mbcnt_hi(~0u, __builtin_amdgcn_mbcnt_lo(~0u, 0u)); asm volatile("" : "+v"(lz));
          unsigned tk2 = 0x7fffffffu;
          if constexpr (DYN) { if (has_next && wid == 0 && lz == 0) tk2 = __hip_atomic_fetch_add(D.ctr, 1u, __ATOMIC_RELAXED, __HIP_MEMORY_SCOPE_AGENT) + (unsigned)D.base; }
          if constexpr (has_chain<Epi>::v) { if (cur.z == 0) E.scale(acc, cur, wr, wc, lz & 15, lz >> 4); else E(acc, cur, wr, wc, lz & 15, lz >> 4); }
          else E(acc, cur, wr, wc, lz & 15, lz >> 4);
          __builtin_amdgcn_s_waitcnt(0x0F70);
          if constexpr (DYN) { if (wid == 0) { int l2 = (int)__builtin_amdgcn_mbcnt_hi(~0u, __builtin_amdgcn_mbcnt_lo(~0u, 0u)); asm volatile("" : "+v"(l2)); if (l2 == 0) *D.slot = tk2; asm volatile("s_waitcnt lgkmcnt(0)" ::: "memory"); } } }
        if constexpr (DYN) {
            if (D.once != nullptr && !once_done && (!has_next || tn >= (unsigned)D.once_k)) {
                once_done = true;
                PG8_BAR;
                if (wid == 0) { int l4 = (int)__builtin_amdgcn_mbcnt_hi(~0u, __builtin_amdgcn_mbcnt_lo(~0u, 0u)); asm volatile("" : "+v"(l4));
                    if (l4 == 0) {
                        if (D.once_nloc <= 1u) { __builtin_amdgcn_fence(__ATOMIC_RELEASE, "agent"); (void)__hip_atomic_fetch_add(D.once, 1u, __ATOMIC_RELAXED, __HIP_MEMORY_SCOPE_AGENT); }
                        else if (__hip_atomic_fetch_add(D.once_x, 1u, __ATOMIC_RELAXED, __HIP_MEMORY_SCOPE_AGENT) + 1u == D.once_nloc) {
                            __builtin_amdgcn_fence(__ATOMIC_RELEASE, "agent"); (void)__hip_atomic_fetch_add(D.once, D.once_nloc, __ATOMIC_RELAXED, __HIP_MEMORY_SCOPE_AGENT); } } }
            }
        }
        if constexpr (has_sig<Epi>::v) {
            unsigned* const sp = E.sig_ptr(cur);
            if (sp != nullptr) {
                PG8_BAR;
                if (wid == 0) { int l3 = (int)__builtin_amdgcn_mbcnt_hi(~0u, __builtin_amdgcn_mbcnt_lo(~0u, 0u)); asm volatile("" : "+v"(l3));
                    if (l3 == 0) (void)__hip_atomic_fetch_add(sp, 1u, __ATOMIC_RELAXED, __HIP_MEMORY_SCOPE_AGENT); }
            }
        }
        if (!has_next) break;
        if (!(has_chain<Epi>::v && cur.z == 0)) {
#pragma unroll
        for (int a = 0; a < 2; ++a)
#pragma unroll
            for (int b = 0; b < 2; ++b)
#pragma unroll
                for (int m = 0; m < 4; ++m)
#pragma unroll
                    for (int n = 0; n < 2; ++n) acc[a][b][m][n] = (f32x4){0.f, 0.f, 0.f, 0.f};
        }
        cur = nxt; cA = nA; cB = nB; ++ui;
        if constexpr (DYN) PG8_BAR;
        if constexpr (ALIGN_EPI) { if (wr == 1) PG8_BAR; }
    }
    PG8_WAIT_V(0);
    if constexpr (!ALIGN_EPI) { if (wr == 0) PG8_BAR; }
    PG8_BAR;
#undef PG8_SA
#undef PG8_SB
#undef PG8_STAGE
#undef PG8_LDA
#undef PG8_LDB
#undef PG8_MMA
#undef PG8_WAIT_V
#undef PG8_WAIT_L
#undef PG8_BAR
#undef PG8_SCHED
}
}

#ifndef PG8_SP2
#define PG8_SP2 true
#endif
#ifndef PG8_ALIGN
#define PG8_ALIGN true
#endif

namespace sbk {
#define SB_LAS __attribute__((address_space(3)))
typedef unsigned short bf16;
typedef short bf16x8 __attribute__((ext_vector_type(8)));
typedef short s16x4 __attribute__((ext_vector_type(4)));
typedef float f32x16 __attribute__((ext_vector_type(16)));
typedef float f32x4 __attribute__((ext_vector_type(4)));
typedef unsigned u32x4 __attribute__((ext_vector_type(4)));
constexpr int WAVE_LDS = 16384;
#define SB_KSWZ(row, colB) ((row) * 256 + ((colB) ^ (((row) & 7) << 4)))
__device__ __forceinline__ int v_st(int k, int c) { const int kk = (k & ~0xC) | ((k & 4) << 1) | ((k & 8) >> 1); return ((kk >> 3) * 4 + (c >> 5)) * 512 + ((kk & 7) * 32 + (c & 31)) * 2; }
__device__ __forceinline__ int v_rd_base(int lane) { return ((lane & 3) << 3) | (((lane >> 2) & 3) << 6) | (((lane >> 4) & 1) << 5) | (((lane >> 5) & 1) << 8); }
__device__ __forceinline__ int crow(int r, int hi) { return (r & 3) + 8 * (r >> 2) + 4 * hi; }
__device__ __forceinline__ unsigned cvtpk(float lo, float hi) { return pg8::cvt_pk_bf16(lo, hi); }
__device__ __forceinline__ bf16x8 pack8(f32x4 a, f32x4 b) { u32x4 w = {cvtpk(a[0], a[1]), cvtpk(a[2], a[3]), cvtpk(b[0], b[1]), cvtpk(b[2], b[3])}; return __builtin_bit_cast(bf16x8, w); }

struct Args { const bf16 *Q, *K, *V, *SZA; unsigned char* YA8; const float *ck, *cv; unsigned* queue; };

__device__ __forceinline__ void tile_compute(SB_LAS char* wl, const bf16x8 (&qr)[8], f32x16 (&o)[4], float& R, const bool diag, const int r32, const int hi, const unsigned vb0) {
    f32x16 p = {};
    { const SB_LAS char* kb[4];
#pragma unroll
      for (int dd = 0; dd < 4; ++dd) kb[dd] = wl + SB_KSWZ(r32, (dd * 16 + hi * 8) * 2);
#pragma unroll
      for (int d0 = 0; d0 < 8; ++d0) { const bf16x8 kf = *(const SB_LAS bf16x8*)(kb[d0 & 3] + (d0 >> 2) * 128); p = __builtin_amdgcn_mfma_f32_32x32x16_bf16(kf, qr[d0], p, 0, 0, 0); } }
    if (diag) {
        const float NEG = -__builtin_inff();
#pragma unroll
        for (int r = 0; r < 16; ++r) if (crow(r, hi) >= r32) p[r] = NEG;
    }
    float s[16];
#pragma unroll
    for (int r = 0; r < 16; ++r) { const float z = p[r]; s[r] = fmaxf(z, 0.f) + __builtin_amdgcn_logf(1.0f + __builtin_amdgcn_exp2f(-__builtin_fabsf(z))); }
#pragma unroll
    for (int g = 0; g < 4; ++g) { s[4 * g + 2] += s[4 * g + 3]; s[4 * g + 1] += s[4 * g + 2]; s[4 * g] += s[4 * g + 1]; }
    float E[4], O[4];
#pragma unroll
    for (int g = 0; g < 4; ++g) { auto rr = __builtin_amdgcn_permlane32_swap(__float_as_uint(s[4 * g]), __float_as_uint(s[4 * g]), false, false); E[g] = __uint_as_float(rr[0]); O[g] = __uint_as_float(rr[1]); }
    float T[8]; T[7] = 0.f; T[6] = O[3]; T[5] = T[6] + E[3]; T[4] = T[5] + O[2]; T[3] = T[4] + E[2]; T[2] = T[3] + O[1]; T[1] = T[2] + E[1]; T[0] = T[1] + O[0];
    const float total = T[0] + E[0];
#pragma unroll
    for (int g = 0; g < 4; ++g) { const float base = R + (hi ? T[2 * g + 1] : T[2 * g]);
#pragma unroll
        for (int j = 0; j < 4; ++j) { const int r = 4 * g + j; p[r] = __builtin_amdgcn_exp2f(p[r] - (base + s[r])); } }
    R += total;
    bf16x8 pa0, pa1;
#define SB_PK4(P, B_, OUT) do { unsigned a0 = cvtpk(P[B_+0], P[B_+1]), a1 = cvtpk(P[B_+2], P[B_+3]); unsigned b0 = cvtpk(P[B_+4], P[B_+5]), b1 = cvtpk(P[B_+6], P[B_+7]); \
        auto r0 = __builtin_amdgcn_permlane32_swap(a0, b0, false, false); auto r1 = __builtin_amdgcn_permlane32_swap(a1, b1, false, false); \
        u32x4 w = {r0[0], r1[0], r0[1], r1[1]}; OUT = __builtin_bit_cast(bf16x8, w); } while (0)
    SB_PK4(p, 0, pa0); SB_PK4(p, 8, pa1);
#undef SB_PK4
#define SB_TRRD(dst, off) asm volatile("ds_read_b64_tr_b16 %0, %1 offset:%2" : "=&v"(dst) : "v"(vb0), "i"(off) : "memory")
#pragma unroll
    for (int d0 = 0; d0 < 4; ++d0) {
        s16x4 l0, h0, l1, h1;
        if (d0 == 0) { SB_TRRD(l0, 0); SB_TRRD(h0, 2048); SB_TRRD(l1, 4096); SB_TRRD(h1, 6144); }
        else if (d0 == 1) { SB_TRRD(l0, 512); SB_TRRD(h0, 512 + 2048); SB_TRRD(l1, 512 + 4096); SB_TRRD(h1, 512 + 6144); }
        else if (d0 == 2) { SB_TRRD(l0, 1024); SB_TRRD(h0, 1024 + 2048); SB_TRRD(l1, 1024 + 4096); SB_TRRD(h1, 1024 + 6144); }
        else { SB_TRRD(l0, 1536); SB_TRRD(h0, 1536 + 2048); SB_TRRD(l1, 1536 + 4096); SB_TRRD(h1, 1536 + 6144); }
        asm volatile("s_waitcnt lgkmcnt(0)" ::: "memory"); __builtin_amdgcn_sched_barrier(0);
        o[d0] = __builtin_amdgcn_mfma_f32_32x32x16_bf16(pa0, (bf16x8){l0[0], l0[1], l0[2], l0[3], h0[0], h0[1], h0[2], h0[3]}, o[d0], 0, 0, 0);
        o[d0] = __builtin_amdgcn_mfma_f32_32x32x16_bf16(pa1, (bf16x8){l1[0], l1[1], l1[2], l1[3], h1[0], h1[1], h1[2], h1[3]}, o[d0], 0, 0, 0);
    }
#undef SB_TRRD
}

constexpr int N_SAMPLE_UNITS = 32 * 16 * 2, N_PROMPT_UNITS = 4 * 16 * 64, N_UNITS = N_SAMPLE_UNITS + N_PROMPT_UNITS;
constexpr float PRUNE_LOG2 = 160.0f;

__device__ __forceinline__ void unit(const Args& A, const int id, SB_LAS char* wl, const int lane_in) {
    int lane = lane_in; asm volatile("" : "+v"(lane));
    const int r32 = lane & 31, hi = lane >> 5;
    const unsigned vb0 = (unsigned)(size_t)(wl + 8192) + (unsigned)v_rd_base(lane);
    int qrow0, h, nt_new, nt_cache, b; int krow0;
    if (id < N_SAMPLE_UNITS) { b = id >> 5; h = (id >> 1) & 15; const int half = id & 1; qrow0 = 8192 + b * 64 + half * 32; krow0 = 8192 + b * 64; nt_new = half + 1; nt_cache = 32; }
    else { const int j = id - N_SAMPLE_UNITS; const int g = 7 - (j >> 9), bh = (j & 511) >> 3, qb = g * 8 + (j & 7); b = bh >> 4; h = bh & 15; qrow0 = b * 2048 + qb * 32; krow0 = b * 2048; nt_new = qb + 1; nt_cache = 0; }
    bf16x8 qr[8];
#pragma unroll
    for (int d0 = 0; d0 < 8; ++d0) qr[d0] = *(const bf16x8*)(A.Q + (size_t)(qrow0 + r32) * 2048 + h * 128 + d0 * 16 + hi * 8);
    f32x16 o[4] = {}; float R = 0.f;
    const int NT = nt_new + nt_cache, srow = lane >> 4, sch = lane & 15;
    f32x4 raw[16];
    const unsigned lb16 = (unsigned)(srow * 2048 + sch * 8) * 2u, lb32 = lb16 * 2u;
    SB_LAS char* const kst0 = wl + SB_KSWZ(srow, sch * 16);
    SB_LAS char* const kst1 = wl + SB_KSWZ(4 + srow, sch * 16);
    SB_LAS char* const vst = wl + 8192 + ((sch * 8) >> 5) * 512 + srow * 64 + ((sch * 8) & 31) * 2;
#define SB_VOFF(i) ((((i) & 1) * 2048) + (((i) >> 2) * 4096) + ((((i) >> 1) & 1) * 256))
#define SB_KV_BF16(idx_) ((size_t)(krow0 + 32 * (nt_new - 1 - (idx_))) * 2048 + h * 128)
#define SB_KV_F32(idx_) (((size_t)(b * 1024 + 32 * (nt_cache - 1 - ((idx_) - nt_new))) * 16 + h) * 128)
#define SB_LD_BF16(idx_) do { const char* kt_ = (const char*)(A.K + SB_KV_BF16(idx_)); const char* vt_ = (const char*)(A.V + SB_KV_BF16(idx_)); _Pragma("unroll") for (int i = 0; i < 8; ++i) { \
        raw[i] = *(const f32x4*)(kt_ + (size_t)i * 16384 + lb16); raw[8 + i] = *(const f32x4*)(vt_ + (size_t)i * 16384 + lb16); } } while (0)
#define SB_LD_F32(P_, idx_) do { const char* t_ = (const char*)((P_) + SB_KV_F32(idx_)); _Pragma("unroll") for (int i = 0; i < 8; ++i) { \
        raw[2 * i] = *(const f32x4*)(t_ + (size_t)i * 32768 + lb32); raw[2 * i + 1] = *(const f32x4*)(t_ + (size_t)i * 32768 + lb32 + 16); } } while (0)
    bool live = true;
    if (live) SB_LD_BF16(0);
#pragma clang loop unroll(disable)
    for (int idx = 0; idx < NT && live; ++idx) {
        if (idx < nt_new) {
#pragma unroll
            for (int i = 0; i < 8; ++i) { *(SB_LAS f32x4*)(((i & 1) ? kst1 : kst0) + (i & ~1) * 1024) = raw[i]; *(SB_LAS f32x4*)(vst + SB_VOFF(i)) = raw[8 + i]; }
        } else {
#pragma unroll
            for (int i = 0; i < 8; ++i) *(SB_LAS bf16x8*)(((i & 1) ? kst1 : kst0) + (i & ~1) * 1024) = pack8(raw[2 * i], raw[2 * i + 1]);
            SB_LD_F32(A.cv, idx);
#pragma unroll
            for (int i = 0; i < 8; ++i) *(SB_LAS bf16x8*)(vst + SB_VOFF(i)) = pack8(raw[2 * i], raw[2 * i + 1]);
        }
        if (idx + 1 < NT) { if (idx + 1 < nt_new) SB_LD_BF16(idx + 1); else SB_LD_F32(A.ck, idx + 1); }
        tile_compute(wl, qr, o, R, idx == 0, r32, hi, vb0);
        if (SB_PRUNE) live = !__all(R > PRUNE_LOG2);
    }
#undef SB_VOFF
#undef SB_KV_BF16
#undef SB_KV_F32
#undef SB_LD_BF16
#undef SB_LD_F32
    asm volatile("s_waitcnt lgkmcnt(0)" ::: "memory");
    int lz = lane; asm volatile("" : "+v"(lz));
    { SB_LAS char* ob = wl + ((lz >> 5) * 4 * 128 + (lz & 31)) * 4;
#pragma unroll
      for (int d0 = 0; d0 < 4; ++d0)
#pragma unroll
        for (int r = 0; r < 16; ++r) *(SB_LAS float*)(ob + (((r & 3) + 8 * (r >> 2)) * 128 + d0 * 32) * 4) = o[d0][r]; }
    asm volatile("s_waitcnt lgkmcnt(0)" ::: "memory");
    const int rr = lz >> 4, ch = lz & 15;
#pragma unroll
    for (int i = 0; i < 8; ++i) { const int q = 4 * i + rr;
        const f32x4 a = *(const SB_LAS f32x4*)(wl + (q * 128 + ch * 8) * 4), c = *(const SB_LAS f32x4*)(wl + (q * 128 + ch * 8 + 4) * 4);
        const size_t go = (size_t)(qrow0 + q) * 2048 + h * 128 + ch * 8;
        const u32x4 z = *(const u32x4*)(A.SZA + go);
        const f32x4 ya = a * (f32x4){pg8::bf_lo(z.x), pg8::bf_hi(z.x), pg8::bf_lo(z.y), pg8::bf_hi(z.y)}, yc = c * (f32x4){pg8::bf_lo(z.z), pg8::bf_hi(z.z), pg8::bf_lo(z.w), pg8::bf_hi(z.w)};
        *(pg8::u32x2*)(A.YA8 + go) = pg8::pack8_fp8(ya * pg8::SC_Y, yc * pg8::SC_Y); }
    asm volatile("s_waitcnt lgkmcnt(0)" ::: "memory");
}

__device__ __forceinline__ void attn_phase(const Args& A, SB_LAS char* lds, const int wave, const int lane, unsigned* queue, const int id0, const int n) {
    SB_LAS char* wl = lds + wave * WAVE_LDS;
    for (;;) {
        unsigned id = 0;
        if (lane == 0) id = __hip_atomic_fetch_add(queue, 1u, __ATOMIC_RELAXED, __HIP_MEMORY_SCOPE_AGENT);
        id = (unsigned)__builtin_amdgcn_readfirstlane((int)id);
        if (id >= (unsigned)n) break;
        unit(A, id0 + (int)id, wl, lane);
    }
}
}

constexpr int NWAVES = 8;
constexpr int N_LAUNCHES = MK_N_LAUNCHES;
constexpr int PER_PHASE = 6;

constexpr int DM = 4096, NIN = 24576, WB = 2048;
constexpr int MP = 8192, MS = 2048, M = MP + MS;
constexpr int NB16 = 4096, NF8 = 20480;
constexpr float LN_EPS = 1e-5f;
constexpr float DN_ALPHA = 1.189207115002721f;

constexpr size_t MiB = 1u << 20;
constexpr size_t WS_CTL = 0, CTL_ZERO_BYTES = 1 * MiB;
constexpr size_t WS_WINB = 1 * MiB;
constexpr size_t WS_WCH = WS_WINB + 32 * MiB;
constexpr size_t WS_XG = WS_WCH + 32 * MiB;
constexpr size_t WS_WIN8 = WS_XG + 2 * MiB;
constexpr size_t WS_WA8 = WS_WIN8 + 80 * MiB;
constexpr size_t WS_WB8 = WS_WA8 + 8 * MiB;
constexpr size_t WS_WO8 = WS_WB8 + 8 * MiB;
constexpr size_t WS_XB = WS_WO8 + 16 * MiB;
constexpr size_t WS_X8 = WS_XB + 80 * MiB;
constexpr size_t WS_Q = WS_X8 + 40 * MiB, WS_K = WS_Q + 40 * MiB, WS_V = WS_K + 40 * MiB, WS_SZA = WS_V + 40 * MiB, WS_U = WS_SZA + 40 * MiB, WS_GT = WS_U + 40 * MiB;
constexpr size_t WS_SGA = WS_GT + 40 * MiB, WS_SGB = WS_SGA + 80 * MiB;
constexpr size_t WS_YA8 = WS_SGB + 80 * MiB, WS_YB8 = WS_YA8 + 20 * MiB;
constexpr size_t WS_M1 = WS_YB8 + 20 * MiB;
constexpr size_t WS_MG8 = WS_M1 + 80 * MiB;
constexpr size_t WS_PRE = WS_MG8 + 40 * MiB;
constexpr size_t WS_END = WS_PRE + 80 * MiB;
static_assert(WS_END < (size_t)0x7fffffff, "every GEMM operand must be addressable as a 31-bit byte offset from the workspace base");
constexpr int CW_TMO = 0, CW_CODE = 1, CW_QUEUE = 64;
constexpr int CW_ONCEX = 2880;
constexpr int CW_P1A = 1024, CW_P1B = 1536, CW_P0B = 2048, CW_PM = 2112, CW_QZ = 2752, CW_KV = 2816, CW_CONVQ = 128;
constexpr int CW_BAR = 4096;

constexpr int RING_OFF = 0, RING_BYTES = 131072;
constexpr int LDS_BYTES = 147456;
constexpr int LDSCTL_OFF = LDS_BYTES - 512, MISC_OFF = LDSCTL_OFF + 320;
constexpr int P0_WAVE_LDS = 128 * 33 * 4;
static_assert(8 * P0_WAVE_LDS <= LDSCTL_OFF, "LDS map");
static_assert(MISC_OFF + 128 <= LDS_BYTES, "LDS map");

#define GAS __attribute__((address_space(1)))
#define LAS __attribute__((address_space(3)))
typedef unsigned short bf16;
typedef unsigned v4u __attribute__((ext_vector_type(4)));
typedef unsigned v2u __attribute__((ext_vector_type(2)));
typedef float f32x4 __attribute__((ext_vector_type(4)));
typedef GAS unsigned gu32;
#define RLX_AGENT __ATOMIC_RELAXED, __HIP_MEMORY_SCOPE_AGENT
#define LDS_WAIT() asm volatile("s_waitcnt lgkmcnt(0)" ::: "memory")
#define VM_WAIT() asm volatile("s_waitcnt vmcnt(0)" ::: "memory")

#define XB_TMO      128
#define XB_XCNT(j)  (256  + 64 * (j))
#define XB_XSUB(j)  (1280 + 64 * (j))
#define XB_XGEN(j)  (2304 + 64 * (j))
#define XB_TOP      3328
#define XB_TOPGEN   3392
#define XCD_BAR_WORDS 3456
#define XB_SPIN_CAP (1u << 18)

__device__ __forceinline__ unsigned xb_ld(unsigned* p)              { return __hip_atomic_load(p, __ATOMIC_RELAXED, __HIP_MEMORY_SCOPE_AGENT); }
__device__ __forceinline__ unsigned xb_add(unsigned* p, unsigned v) { return __hip_atomic_fetch_add(p, v, __ATOMIC_RELAXED, __HIP_MEMORY_SCOPE_AGENT); }
__device__ __forceinline__ unsigned xb_xcc_id() { return (unsigned)__builtin_amdgcn_s_getreg((3 << 11) | 20) & 0xFu; }
#define XB_SPIN(cond, bar) do { unsigned _sp = 0; while (cond) { __builtin_amdgcn_s_sleep(1); \
    if ((++_sp & 255u) == 0u) { if (xb_ld(&(bar)[XB_TMO])) break; if (_sp > XB_SPIN_CAP) { atomicAdd(&(bar)[XB_TMO], 1u); break; } } } } while (0)

struct XcdBarrier {
    unsigned* bar; unsigned x;
    volatile LAS unsigned* st;
};
__device__ __forceinline__ XcdBarrier xcd_barrier_post(unsigned* bar, volatile LAS unsigned* st) {
    XcdBarrier b; b.bar = bar; b.x = xb_xcc_id(); b.st = st;
    if (threadIdx.x == 0) (void)xb_add(&bar[XB_XCNT(b.x)], 1u);
    return b;
}
__device__ __forceinline__ void xcd_barrier_complete(unsigned* bar, unsigned x, unsigned& nloc, unsigned& nx) {
    const unsigned G = gridDim.x * gridDim.y * gridDim.z;
    unsigned sum, cnt, mine, sp = 0u;
    for (;;) {
        sum = 0u; cnt = 0u; mine = 0u;
#pragma unroll
        for (unsigned j = 0; j < 16; ++j) { const unsigned c = xb_ld(&bar[XB_XCNT(j)]); sum += c; cnt += (c > 0u) ? 1u : 0u; mine = (j == x) ? c : mine; }
        if (sum == G) break;
        __builtin_amdgcn_s_sleep(1);
        if ((++sp & 255u) == 0u) { if (xb_ld(&bar[XB_TMO])) break; if (sp > XB_SPIN_CAP) { atomicAdd(&bar[XB_TMO], 1u); break; } }
    }
    nloc = mine > 0u ? mine : 1u; nx = cnt > 0u ? cnt : 1u;
}
__device__ __forceinline__ void xcd_barrier(const XcdBarrier& b) {
    asm volatile("s_waitcnt vmcnt(0)" ::: "memory");
    __syncthreads();
    if (threadIdx.x == 0) {
        unsigned* bar = b.bar;
        __builtin_amdgcn_s_waitcnt(0);
        unsigned nloc = b.st[0], nx = b.st[1];
        if (nloc == 0u) { xcd_barrier_complete(bar, b.x, nloc, nx); b.st[0] = nloc; b.st[1] = nx; }
        const unsigned old = xb_add(&bar[XB_XSUB(b.x)], 1u);
        const unsigned gen = old / nloc;
        if (old + 1u == (gen + 1u) * nloc) {
            __builtin_amdgcn_fence(__ATOMIC_RELEASE, "agent");
            asm volatile("s_waitcnt vmcnt(0)" ::: "memory");
            const unsigned og = xb_add(&bar[XB_TOP], 1u);
            const unsigned tg = og / nx;
            if (og + 1u == (tg + 1u) * nx) xb_add(&bar[XB_TOPGEN], 1u);
            else XB_SPIN(xb_ld(&bar[XB_TOPGEN]) == tg, bar);
            __builtin_amdgcn_fence(__ATOMIC_ACQUIRE, "agent");
            xb_add(&bar[XB_XGEN(b.x)], 1u);
            asm volatile("s_waitcnt vmcnt(0)" ::: "memory");
        } else {
            XB_SPIN(xb_ld(&bar[XB_XGEN(b.x)]) == gen, bar);
            __builtin_amdgcn_fence(__ATOMIC_ACQUIRE, "agent");
            asm volatile("s_waitcnt vmcnt(0)" ::: "memory");
        }
    }
    __syncthreads();
}

__device__ __forceinline__ float wave_sum(float v) {
#pragma unroll
    for (int o = 1; o < 64; o <<= 1) v += __shfl_xor(v, o);
    return v;
}
__device__ __forceinline__ void win_dest_row(int n, int& r8, int& r16, int& which) {
    r8 = -1; r16 = -1; which = 0;
    if (n < 2048) { r8 = n; return; }
    if (n < 4096) { r16 = n - 2048; return; }
    if (n < 6144) { r16 = 2048 + (n - 4096); return; }
    if (n < 8192) { r8 = 2048 + (n - 6144); return; }
    if (n < 16384) { const int sg = (n - 8192) >> 11, ch = (n - 8192) & 2047, i = ch >> 7, o = ch & 127;
        if (sg == 1 || sg == 2) { const int r = i * 256 + ((sg == 2) ? 128 : 0) + o; r8 = 4096 + r; r16 = r; which = 1; }
        else r8 = 8192 + i * 256 + ((sg == 3) ? 128 : 0) + o;
        return; }
    r8 = 12288 + (n - 16384);
}
struct P0Item { const float* src; int N, K, k0, n0, mode; unsigned char* dst; unsigned char* dstch; unsigned char* dst8; float scale; };
__device__ __forceinline__ void p0_load(const P0Item& d, f32x4 (&v)[16], int lane) {
    const int kr = lane >> 3, nq = lane & 7;
    const float* p = d.src + (size_t)(d.k0 + kr) * d.N + d.n0 + 4 * nq;
#pragma unroll
    for (int i = 0; i < 16; ++i) v[i] = __builtin_nontemporal_load((const f32x4*)(p + (size_t)(8 * i) * d.N));
}
__device__ __forceinline__ void p0_store(const P0Item& d, const f32x4 (&v)[16], LAS float* scr, int lane) {
    const int kr = lane >> 3, nq = lane & 7;
#pragma unroll
    for (int i = 0; i < 16; ++i) { LAS float* q = scr + (8 * i + kr) * 33 + 4 * nq; q[0] = v[i].x; q[1] = v[i].y; q[2] = v[i].z; q[3] = v[i].w; }
    LDS_WAIT(); asm volatile("" ::: "memory");
    const int c = lane & 15;
    int r8 = d.n0, r16 = -1, which = 0;
    if (d.mode == 2) win_dest_row(d.n0, r8, r16, which);
    bf16* const d16 = (bf16*)(which ? d.dstch : d.dst);
#pragma unroll
    for (int j = 0; j < 8; ++j) { const int n = (lane >> 4) + 4 * j; const LAS float* s = scr + (8 * c) * 33 + n;
        const f32x4 a = {s[0 * 33], s[1 * 33], s[2 * 33], s[3 * 33]}, b = {s[4 * 33], s[5 * 33], s[6 * 33], s[7 * 33]};
        if (r8 >= 0) *(GAS v2u*)(d.dst8 + (size_t)(r8 + n) * d.K + d.k0 + 8 * c) = pg8::pack8_fp8(a * d.scale, b * d.scale);
        if (r16 >= 0) *(GAS v4u*)(d16 + (size_t)(r16 + n) * d.K + d.k0 + 8 * c) = pg8::pack8(a, b); }
    LDS_WAIT(); asm volatile("" ::: "memory");
}

struct KArgs { const float* in[14]; float* out; unsigned char* ws; int ph_lo, ph_hi; };
typedef const KArgs __attribute__((address_space(4))) * KArgsPtr;
template <int SET> __device__ __forceinline__ P0Item p0_decode(int it, const float* w_in, const float* w_a, const float* w_b, const float* w_o, unsigned char* ws) {
    constexpr int KB = DM / 128, I_A = (WB / 128) * (DM / 32);
    P0Item d; int r = it, nb;
    d.src = w_in; d.N = NIN; d.K = DM; d.mode = 2; d.dst = ws + WS_WINB; d.dstch = ws + WS_WCH; d.dst8 = ws + WS_WIN8; d.scale = pg8::SC_WIN;
    if (SET == 0) { nb = r % 256; nb = nb < 128 ? 64 + nb : 320 + (nb - 128); d.k0 = 128 * (r / 256); d.n0 = 32 * nb; return d; }
    if (r < KB * 512) { nb = r % 512; nb = nb < 64 ? nb : nb < 192 ? 192 + (nb - 64) : 448 + (nb - 192); d.k0 = 128 * (r / 512); d.n0 = 32 * nb; return d; }
    r -= KB * 512; d.mode = 1; d.dst = nullptr; d.dstch = nullptr; d.N = DM;
    if (r < I_A) { d.src = w_a; d.K = WB; d.dst8 = ws + WS_WA8; d.scale = pg8::SC_WAB; }
    else if ((r -= I_A) < I_A) { d.src = w_b; d.K = WB; d.dst8 = ws + WS_WB8; d.scale = pg8::SC_WAB; }
    else { r -= I_A; d.src = w_o; d.K = DM; d.dst8 = ws + WS_WO8; d.scale = pg8::SC_WO; }
    d.k0 = 128 * (r / (DM / 32)); d.n0 = 32 * (r % (DM / 32)); return d;
}
template <int SET> __device__ __forceinline__ void p0_weights(KArgsPtr ap, unsigned char* ws, LAS float* scr, int lane, int w0, int wn) {
    constexpr int NITEMS = SET == 0 ? (DM / 128) * 256 : (DM / 128) * 512 + 2 * (WB / 128) * (DM / 32) + (DM / 128) * (DM / 32);
    const float *w_in = ap->in[5], *w_a = ap->in[9], *w_b = ap->in[10], *w_o = ap->in[11];
    f32x4 cur[16], nxt[16];
    int it = w0;
    if (it < NITEMS) { const P0Item d = p0_decode<SET>(it, w_in, w_a, w_b, w_o, ws); p0_load(d, cur, lane); }
    while (it < NITEMS) {
        const int itn = it + wn;
        if (itn < NITEMS) { const P0Item dn = p0_decode<SET>(itn, w_in, w_a, w_b, w_o, ws); p0_load(dn, nxt, lane); }
        { const P0Item d = p0_decode<SET>(it, w_in, w_a, w_b, w_o, ws); p0_store(d, cur, scr, lane); }
#pragma unroll
        for (int i = 0; i < 16; ++i) cur[i] = nxt[i];
        it = itn;
    }
}
template <int WHICH> __device__ __forceinline__ void p0_x(KArgsPtr ap, unsigned char* ws, size_t gt, size_t NT) {
    const float *x = ap->in[0], *xs = ap->in[1];
    const size_t NX = (size_t)M * DM / 16;
    for (size_t i0 = gt; i0 < NX; i0 += 4 * NT) {
        f32x4 a[4], b[4], c[4], d[4];
#pragma unroll
        for (int u = 0; u < 4; ++u) { const size_t i = i0 + u * NT; if (i < NX) { const size_t e = i * 16; const float* src = (e < (size_t)MP * DM) ? x + e : xs + (e - (size_t)MP * DM);
            a[u] = __builtin_nontemporal_load((const f32x4*)src); b[u] = __builtin_nontemporal_load((const f32x4*)(src + 4)); c[u] = __builtin_nontemporal_load((const f32x4*)(src + 8)); d[u] = __builtin_nontemporal_load((const f32x4*)(src + 12)); } }
#pragma unroll
        for (int u = 0; u < 4; ++u) { const size_t i = i0 + u * NT; if (i < NX) { const size_t e = i * 16;
            if (WHICH & 1) { *(pg8::u32x4*)((bf16*)(ws + WS_XB) + e) = pg8::pack8(a[u], b[u]); *(pg8::u32x4*)((bf16*)(ws + WS_XB) + e + 8) = pg8::pack8(c[u], d[u]); }
            if (WHICH & 2) { const pg8::u32x2 p = pg8::pack8_fp8(a[u], b[u]), q = pg8::pack8_fp8(c[u], d[u]); *(pg8::u32x4*)(ws + WS_X8 + e) = (pg8::u32x4){p.x, p.y, q.x, q.y}; } } }
    }
    if (WHICH & 1) {
        for (size_t i = gt; i < (size_t)256 * (DM / 8); i += NT) {
            const int row = (int)(i >> 9), c8 = (int)(i & 511) * 8;
            pg8::u32x4 w = {0u, 0u, 0u, 0u};
            if (row < 72) { const float* src = (row < 8) ? x + ((size_t)((row >> 1) * 2048 + 2046 + (row & 1))) * DM + c8 : xs + ((size_t)(((row - 8) >> 1) * 64 + 62 + (row & 1))) * DM + c8;
                w = pg8::pack8(*(const f32x4*)src, *(const f32x4*)(src + 4)); }
            *(pg8::u32x4*)((bf16*)(ws + WS_XG) + (size_t)row * DM + c8) = w;
        }
    }
}
#define PHASE_ARGS() KArgsPtr ap = (KArgsPtr)__builtin_amdgcn_kernarg_segment_ptr(); asm volatile("" : "+s"(ap)); unsigned char* const ws = ap->ws; \
    const __amdgpu_buffer_rsrc_t rsrc = __builtin_amdgcn_make_buffer_rsrc((void*)ws, 0, 0x7fffffff, 0x00020000)

__global__ void __launch_bounds__(NWAVES * 64, 2) mk_fwd(const KArgs args) {
    extern __shared__ __attribute__((aligned(16))) unsigned char lds_raw[];
    LAS unsigned char* const lds = (LAS unsigned char*)lds_raw;
    volatile LAS unsigned* const MISC = (volatile LAS unsigned*)(lds + MISC_OFF);
    const int wave = __builtin_amdgcn_readfirstlane((int)threadIdx.x >> 6);
#define LANE_TID() int lane = (int)__builtin_amdgcn_mbcnt_hi(~0u, __builtin_amdgcn_mbcnt_lo(~0u, 0u)); asm volatile("" : "+v"(lane)); const int tid = wave * 64 + lane; (void)tid
    int tid0 = threadIdx.x;
    const int G = gridDim.x, vcu = (G % 8 == 0) ? ((int)blockIdx.x % 8) * (G / 8) + (int)blockIdx.x / 8 : (int)blockIdx.x;
    gu32* const ctl = (gu32*)(args.ws + WS_CTL);
    for (int u = tid0; u < (LDS_BYTES - LDSCTL_OFF) / 4; u += NWAVES * 64) ((LAS unsigned*)(lds + LDSCTL_OFF))[u] = 0u;
    __syncthreads();
    XcdBarrier bar; bar.bar = (unsigned*)(ctl + CW_BAR); bar.x = 0; bar.st = nullptr;
    if (N_LAUNCHES != PER_PHASE) bar = xcd_barrier_post((unsigned*)(ctl + CW_BAR), MISC + 8);
#define GRID_BAR(seam) do { if (N_LAUNCHES == PER_PHASE) { if (threadIdx.x == 0) __hip_atomic_store(ctl + CW_TMO, 0xBADBA0u | (unsigned)(seam), RLX_AGENT); } else { xcd_barrier(bar); } } while (0)
    const int lo = args.ph_lo, hi = args.ph_hi;
#define IN(k) (lo <= (k) && (k) < hi)
#define BOTH(k) (IN(k) && IN((k) + 1))
    const int gw = vcu * NWAVES + wave, NGW = G * NWAVES;

    constexpr int NCX = 8;
    const bool dynp1 = (G == 32 * pg8::NXCD);
    const bool early_attn = dynp1 && (lo <= 1 && 2 < hi);
    if (IN(0)) {
        PHASE_ARGS(); (void)rsrc; LANE_TID();
        LAS float* scr = (LAS float*)(lds + wave * P0_WAVE_LDS);
        p0_weights<0>(ap, ws, scr, lane, gw, NGW);
        p0_x<3>(ap, ws, (size_t)blockIdx.x * (NWAVES * 64) + tid, (size_t)G * NWAVES * 64);
        if (!dynp1) p0_weights<1>(ap, ws, scr, lane, gw, NGW);
        if (BOTH(0)) GRID_BAR(0);
    }

    if (IN(1)) {
        if (dynp1) {
            const int xq = (int)blockIdx.x % pg8::NXCD, rho = (int)blockIdx.x / pg8::NXCD, NGX = 32 - NCX;
            gu32* const done = ctl + CW_P0B;
            if (rho >= NGX) {
                { PHASE_ARGS(); (void)rsrc; LANE_TID();
                  LAS float* scr = (LAS float*)(lds + wave * P0_WAVE_LDS);
                  const int cb = (rho - NGX) * pg8::NXCD + xq;
                  p0_weights<1>(ap, ws, scr, lane, cb * NWAVES + wave, NCX * pg8::NXCD * NWAVES); }
                asm volatile("s_waitcnt vmcnt(0)" ::: "memory");
                __syncthreads();
                { LANE_TID(); if (wave == 0 && lane == 0) { __builtin_amdgcn_fence(__ATOMIC_RELEASE, "agent"); asm volatile("s_waitcnt vmcnt(0)" ::: "memory"); (void)__hip_atomic_fetch_add(done, 1u, RLX_AGENT); } }
            } else {
                PHASE_ARGS();
                pg8::Sched S; S.init(M / 256, NB16 / 256, G, (int)blockIdx.x, 0, 0, WS_XB, WS_XG, WS_WINB, WS_WCH, DM * 2); S.nextra = 16;
                pg8::EpiProjB E{ap->in[6], (bf16*)(ws + WS_K), (bf16*)(ws + WS_V), ap->out, nullptr};
                const pg8::Dyn D{(unsigned*)(ctl + CW_P1A + 64 * xq), xq, rho, NGX, MISC + 16, nullptr, 0, nullptr, 1u};
                pg8::gemm_phase<pg8::EpiProjB, PG8_ALIGN, PG8_SP2, false, true>(lds + RING_OFF, wave, rsrc, DM * 2, DM * 2, S, E, D);
            }
            { LANE_TID(); if (wave == 0 && lane == 0) { unsigned sp = 0; while (__hip_atomic_load(done, RLX_AGENT) < (unsigned)(NCX * pg8::NXCD)) { __builtin_amdgcn_s_sleep(4); if (++sp > (1u << 22)) break; }
                  __builtin_amdgcn_fence(__ATOMIC_ACQUIRE, "agent"); } }
            __syncthreads();
            { PHASE_ARGS();
              pg8::Sched S; S.init(M / 256, NF8 / 256, G, (int)blockIdx.x, 0, 0, WS_X8, WS_X8, WS_WIN8, WS_WIN8, DM);
              S.il = 1;
              pg8::EpiProj8 E{ap->in[6], (bf16*)(ws + WS_Q), (bf16*)(ws + WS_SZA), (bf16*)(ws + WS_U), (bf16*)(ws + WS_GT), (bf16*)(ws + WS_SGA), (bf16*)(ws + WS_SGB), nullptr};
              const pg8::Dyn D{(unsigned*)(ctl + CW_P1B + 64 * xq), xq, rho, 32, MISC + 16, early_attn ? (unsigned*)(ctl + CW_QZ) : nullptr, 320, (unsigned*)(ctl + CW_ONCEX + 64 * (int)bar.x), (unsigned)MISC[8]};
              pg8::gemm_phase<pg8::EpiProj8, PG8_ALIGN, PG8_SP2, true, true>(lds + RING_OFF, wave, rsrc, DM, DM, S, E, D); }
            if (early_attn) { LANE_TID(); if (wave == 0 && lane == 0) { unsigned sp = 0;
                  while (__hip_atomic_load(ctl + CW_QZ, RLX_AGENT) < (unsigned)G) { __builtin_amdgcn_s_sleep(4); if (++sp > (1u << 22)) break; }
                  __builtin_amdgcn_fence(__ATOMIC_ACQUIRE, "agent"); } }
            __syncthreads();

        } else {
            { PHASE_ARGS();
              pg8::Sched S; S.init(M / 256, NB16 / 256, G, (int)blockIdx.x, 0, 0, WS_XB, WS_XG, WS_WINB, WS_WCH, DM * 2); S.nextra = 16;
              pg8::EpiProjB E{ap->in[6], (bf16*)(ws + WS_K), (bf16*)(ws + WS_V), ap->out, nullptr};
              pg8::gemm_phase<pg8::EpiProjB, PG8_ALIGN, PG8_SP2, false>(lds + RING_OFF, wave, rsrc, DM * 2, DM * 2, S, E); }
            { PHASE_ARGS();
              pg8::Sched S; S.init(M / 256, NF8 / 256, G, (int)blockIdx.x, 0, 0, WS_X8, WS_X8, WS_WIN8, WS_WIN8, DM);
              pg8::EpiProj8 E{ap->in[6], (bf16*)(ws + WS_Q), (bf16*)(ws + WS_SZA), (bf16*)(ws + WS_U), (bf16*)(ws + WS_GT), (bf16*)(ws + WS_SGA), (bf16*)(ws + WS_SGB), nullptr};
              pg8::gemm_phase<pg8::EpiProj8, PG8_ALIGN, PG8_SP2, true>(lds + RING_OFF, wave, rsrc, DM, DM, S, E); }
        }
        if (BOTH(1) && !early_attn) GRID_BAR(1);
    }

    if (IN(2)) {
        PHASE_ARGS(); (void)rsrc; LANE_TID();
        { const sbk::Args A{(const bf16*)(ws + WS_Q), (const bf16*)(ws + WS_K), (const bf16*)(ws + WS_V), (const bf16*)(ws + WS_SZA), ws + WS_YA8, ap->in[2], ap->in[3], (unsigned*)(ctl + CW_QUEUE)};
          SB_LAS char* wl = (LAS char*)(lds + RING_OFF) + wave * sbk::WAVE_LDS;
          bool passed = !early_attn;
          for (;;) {
              unsigned t = 0;
              if (lane == 0) t = __hip_atomic_fetch_add(A.queue, 1u, __ATOMIC_RELAXED, __HIP_MEMORY_SCOPE_AGENT);
              t = (unsigned)__builtin_amdgcn_readfirstlane((int)t);
              if (t >= (unsigned)sbk::N_PROMPT_UNITS && !passed) { GRID_BAR(1); passed = true; }
              if (t >= (unsigned)sbk::N_UNITS) break;
              sbk::unit(A, t < (unsigned)sbk::N_PROMPT_UNITS ? sbk::N_SAMPLE_UNITS + (int)t : (int)t - sbk::N_PROMPT_UNITS, wl, lane);
          } }
        const float *state_conv = ap->in[4], *conv_w = ap->in[7], *conv_b = ap->in[8];
        const bf16 *Ub = (const bf16*)(ws + WS_U), *GT = (const bf16*)(ws + WS_GT);
        if (early_attn) for (;;) {
            unsigned cq = 0; if (lane == 0) cq = __hip_atomic_fetch_add(ctl + CW_CONVQ, 1u, RLX_AGENT); cq = (unsigned)__builtin_amdgcn_readfirstlane((int)cq);
            if (cq >= (unsigned)(M / 4)) break;
            const int r0 = (int)cq * 4; const bool samp = r0 >= MP; const int t0 = samp ? ((r0 - MP) & 63) : (r0 & 2047), sb = samp ? ((r0 - MP) >> 6) : 0;
#pragma clang loop unroll(disable)
            for (int j = 0; j < 4; ++j) {
                const int c = (lane + 64 * j) * 8;
                pg8::u32x4 uu[6], gg[4];
#pragma unroll
                for (int k = 0; k < 4; ++k) { uu[2 + k] = *(const pg8::u32x4*)(Ub + (size_t)(r0 + k) * WB + c); gg[k] = *(const pg8::u32x4*)(GT + (size_t)(r0 + k) * WB + c); }
                f32x4 h1a = {0.f, 0.f, 0.f, 0.f}, h1b = h1a, h2a = h1a, h2b = h1a;
                if (t0 > 0) { uu[0] = *(const pg8::u32x4*)(Ub + (size_t)(r0 - 2) * WB + c); uu[1] = *(const pg8::u32x4*)(Ub + (size_t)(r0 - 1) * WB + c); }
                else { uu[0] = (pg8::u32x4){0u, 0u, 0u, 0u}; uu[1] = uu[0];
                    if (samp) { const float* sc = state_conv + (size_t)(sb * 2) * WB + c; h2a = *(const f32x4*)sc; h2b = *(const f32x4*)(sc + 4); h1a = *(const f32x4*)(sc + WB); h1b = *(const f32x4*)(sc + WB + 4); } }
                const f32x4 ba = *(const f32x4*)(conv_b + c), bb = *(const f32x4*)(conv_b + c + 4);
                const f32x4 w0a = *(const f32x4*)(conv_w + c), w0b = *(const f32x4*)(conv_w + c + 4), w1a = *(const f32x4*)(conv_w + WB + c), w1b = *(const f32x4*)(conv_w + WB + c + 4),
                            w2a = *(const f32x4*)(conv_w + 2 * WB + c), w2b = *(const f32x4*)(conv_w + 2 * WB + c + 4);
                f32x4 xa[6], xb[6];
#pragma unroll
                for (int k = 0; k < 6; ++k) { xa[k] = pg8::bf4_lo(uu[k]); xb[k] = pg8::bf4_hi(uu[k]); }
                if (t0 == 0) { xa[0] = h2a; xb[0] = h2b; xa[1] = h1a; xb[1] = h1b; }
#pragma unroll
                for (int k = 0; k < 4; ++k) {
                    const f32x4 ya = pg8::bf4_lo(gg[k]) * pg8::SC_Y * (ba + w0a * xa[k] + w1a * xa[k + 1] + w2a * xa[k + 2]), yb = pg8::bf4_hi(gg[k]) * pg8::SC_Y * (bb + w0b * xb[k] + w1b * xb[k + 1] + w2b * xb[k + 2]);
                    *(pg8::u32x2*)(ws + WS_YB8 + (size_t)(r0 + k) * WB + c) = pg8::pack8_fp8(ya, yb); }
            }
        }
        const size_t NI = (size_t)M * (WB / 8);
        size_t cbase = 0;
        if (!early_attn) for (;;) {
            size_t i;
            { i = (size_t)blockIdx.x * (NWAVES * 64) + tid + cbase; cbase += (size_t)G * NWAVES * 64; if (i >= NI) break; }
            const int row = (int)(i >> 8), c = (int)(i & 255) * 8;
            int t, sb = 0; const bool samp = row >= MP;
            if (samp) { t = (row - MP) & 63; sb = (row - MP) >> 6; } else t = row & 2047;
            const pg8::u32x4 u2 = *(const pg8::u32x4*)(Ub + (size_t)row * WB + c), gg = *(const pg8::u32x4*)(GT + (size_t)row * WB + c);
            float xm1[8], xm2[8], x0[8], g[8];
            const unsigned uw[4] = {u2.x, u2.y, u2.z, u2.w}, gw4[4] = {gg.x, gg.y, gg.z, gg.w};
#pragma unroll
            for (int k = 0; k < 4; ++k) { x0[2 * k] = pg8::bf_lo(uw[k]); x0[2 * k + 1] = pg8::bf_hi(uw[k]); g[2 * k] = pg8::bf_lo(gw4[k]); g[2 * k + 1] = pg8::bf_hi(gw4[k]); }
            if (t >= 1) { const pg8::u32x4 v = *(const pg8::u32x4*)(Ub + (size_t)(row - 1) * WB + c); const unsigned w[4] = {v.x, v.y, v.z, v.w};
#pragma unroll
                for (int k = 0; k < 4; ++k) { xm1[2 * k] = pg8::bf_lo(w[k]); xm1[2 * k + 1] = pg8::bf_hi(w[k]); } }
            else {
#pragma unroll
                for (int k = 0; k < 8; ++k) xm1[k] = samp ? state_conv[(size_t)(sb * 2 + 1) * WB + c + k] : 0.f; }
            if (t >= 2) { const pg8::u32x4 v = *(const pg8::u32x4*)(Ub + (size_t)(row - 2) * WB + c); const unsigned w[4] = {v.x, v.y, v.z, v.w};
#pragma unroll
                for (int k = 0; k < 4; ++k) { xm2[2 * k] = pg8::bf_lo(w[k]); xm2[2 * k + 1] = pg8::bf_hi(w[k]); } }
            else {
#pragma unroll
                for (int k = 0; k < 8; ++k) xm2[k] = samp ? state_conv[(size_t)(sb * 2 + t) * WB + c + k] : 0.f; }
            float y[8];
#pragma unroll
            for (int k = 0; k < 8; ++k) y[k] = pg8::SC_Y * g[k] * (conv_b[c + k] + conv_w[c + k] * xm2[k] + conv_w[WB + c + k] * xm1[k] + conv_w[2 * WB + c + k] * x0[k]);
            *(pg8::u32x2*)(ws + WS_YB8 + (size_t)row * WB + c) = pg8::pack8_fp8((f32x4){y[0], y[1], y[2], y[3]}, (f32x4){y[4], y[5], y[6], y[7]});
        }
        if (BOTH(2)) GRID_BAR(2);
    }

    const bool rm34 = dynp1 && BOTH(3);
    if (IN(3)) {
        PHASE_ARGS();
        pg8::Sched S; S.init(M / 256, DM / 256, G, (int)blockIdx.x, 1, 0, WS_YA8, WS_YB8, WS_WA8, WS_WB8, WB);
        if (rm34) { S.rm = 1; S.rho = (int)blockIdx.x / pg8::NXCD; S.xq = (int)blockIdx.x % pg8::NXCD; }
        pg8::EpiMerge E{(const bf16*)(ws + WS_SGA), (const bf16*)(ws + WS_SGB), (bf16*)(ws + WS_M1), ws + WS_MG8, rsrc, (unsigned)WS_MG8, rm34 ? (unsigned*)(ctl + CW_PM) : nullptr};
        pg8::gemm_phase<pg8::EpiMerge, PG8_ALIGN, PG8_SP2, true>(lds + RING_OFF, wave, rsrc, WB, WB, S, E);
        if (BOTH(3) && !rm34) GRID_BAR(3);
    }

    if (IN(4)) {
        PHASE_ARGS();
        pg8::Sched S; S.init(M / 256, DM / 256, G, (int)blockIdx.x, 0, 0, WS_MG8, WS_MG8, WS_WO8, WS_WO8, DM);
        if (rm34) {
            S.rm = 2; S.rho = (int)blockIdx.x / pg8::NXCD; S.xq = (int)blockIdx.x % pg8::NXCD;
            { LANE_TID(); if (wave == 0 && lane == 0) {
                  const int rho = (int)blockIdx.x / pg8::NXCD, xq = (int)blockIdx.x % pg8::NXCD, nu = rho >= 16 ? 3 : 2, p0 = rho >= 16 ? rho - 16 : 48 + rho;
                  for (int k = 0; k < nu; ++k) { const int pp = p0 + 16 * k, pm = pp < 64 ? 8 * (2 * (pp >> 5) + (xq >> 2)) + (pp & 7) : 32 + ((pp - 64) & 7); unsigned sp = 0;
                      while (__hip_atomic_load(ctl + CW_PM + 16 * pm, RLX_AGENT) < 16u) { __builtin_amdgcn_s_sleep(4); if (++sp > (1u << 22)) break; } }
                  __builtin_amdgcn_fence(__ATOMIC_ACQUIRE, "agent"); } }
            __syncthreads();
        }
        pg8::EpiOut E{(const bf16*)(ws + WS_XB), (bf16*)(ws + WS_PRE), DN_ALPHA};
        pg8::gemm_phase<pg8::EpiOut, PG8_ALIGN, PG8_SP2, true>(lds + RING_OFF, wave, rsrc, DM, DM, S, E);
        if (BOTH(4)) GRID_BAR(4);
    }

    if (IN(5)) {
        PHASE_ARGS(); (void)rsrc; LANE_TID();
        const float *ln_g = ap->in[12], *ln_b = ap->in[13]; float* out = ap->out;
        for (int m = gw; m < M; m += NGW) {
            const pg8::u32x4* rp = (const pg8::u32x4*)((const bf16*)(ws + WS_PRE) + (size_t)m * DM) + lane;
            f32x4 v[16]; float s = 0.f;
#pragma unroll
            for (int j = 0; j < 8; ++j) { const pg8::u32x4 w = rp[64 * j]; v[2 * j] = pg8::bf4_lo(w); v[2 * j + 1] = pg8::bf4_hi(w); }
#pragma unroll
            for (int j = 0; j < 16; ++j) s += (v[j].x + v[j].y) + (v[j].z + v[j].w);
            const float mean = wave_sum(s) * (1.f / DM); float s2 = 0.f;
#pragma unroll
            for (int j = 0; j < 16; ++j) { v[j] = v[j] - mean; s2 += (v[j].x * v[j].x + v[j].y * v[j].y) + (v[j].z * v[j].z + v[j].w * v[j].w); }
            const float rstd = 1.f / sqrtf(wave_sum(s2) * (1.f / DM) + LN_EPS);
            float* orow = out + pg8::OUT_Y + (size_t)m * DM;
#pragma unroll
            for (int j = 0; j < 16; ++j) { const int e = ((j >> 1) * 64 + lane) * 8 + (j & 1) * 4;
                const f32x4 g = *(const f32x4*)(ln_g + e), bb = *(const f32x4*)(ln_b + e); *(GAS f32x4*)(orow + e) = v[j] * rstd * g + bb; }
        }
    }
#undef IN
#undef BOTH
}

extern "C" void kernel_launch(void* const* d_in, const int* in_sizes, int n_in, void* d_out, int out_size, void* d_ws, size_t ws_size, hipStream_t stream) {
    static int grid = 0;
    if (grid == 0) {
        if (n_in != 14 || (size_t)out_size != pg8::OUT_TOTAL || ws_size < WS_END) { fprintf(stderr, "kernel_launch: unexpected problem (n_in %d, out %d, ws %zu; need ws >= %zu); nothing launched\n", n_in, out_size, ws_size, (size_t)WS_END); grid = -1; return; }
        int dev = 0, cus = 0, per_cu = 0;
        if (hipGetDevice(&dev) != hipSuccess || hipDeviceGetAttribute(&cus, hipDeviceAttributeMultiprocessorCount, dev) != hipSuccess) { fprintf(stderr, "kernel_launch: device query failed\n"); grid = -1; return; }
        if (hipFuncSetAttribute((const void*)mk_fwd, hipFuncAttributeMaxDynamicSharedMemorySize, LDS_BYTES) != hipSuccess) { fprintf(stderr, "kernel_launch: hipFuncSetAttribute failed\n"); grid = -1; return; }
        if (hipOccupancyMaxActiveBlocksPerMultiprocessor(&per_cu, (const void*)mk_fwd, NWAVES * 64, LDS_BYTES) != hipSuccess || per_cu < 1) { fprintf(stderr, "kernel_launch: occupancy query reports %d workgroups per CU\n", per_cu); }
        (void)hipGetLastError();
        grid = cus;
    }
    if (grid < 0) return;
    if (hipMemsetAsync((char*)d_ws + WS_CTL, 0, CTL_ZERO_BYTES, stream) != hipSuccess) { fprintf(stderr, "kernel_launch: hipMemsetAsync failed\n"); return; }
    KArgs a{};
    for (int i = 0; i < 14; ++i) a.in[i] = (const float*)d_in[i];
    a.out = (float*)d_out; a.ws = (unsigned char*)d_ws;
    if (N_LAUNCHES == 1) {
        a.ph_lo = 0; a.ph_hi = PER_PHASE;
        hipLaunchKernelGGL(mk_fwd, dim3(grid), dim3(NWAVES * 64), LDS_BYTES, stream, a);
    } else {
        for (int li = 0; li < PER_PHASE; ++li) { a.ph_lo = li; a.ph_hi = li + 1; hipLaunchKernelGGL(mk_fwd, dim3(grid), dim3(NWAVES * 64), LDS_BYTES, stream, a); }
    }
    const hipError_t le = hipPeekAtLastError();
    if (le != hipSuccess) fprintf(stderr, "kernel_launch: launch failed: %s\n", hipGetErrorName(le));
}
```
